# Optimizing an MI355X kernel written in HIP

```python
import math
import jax
import jax.numpy as jnp
from jax import lax
import numpy as np

D_MODEL = 1024
BATCH = 16
SEQ = 2048
DEPTH = 4

HEAD_DIM = 64
ROPE_THETA = 500000.0
ROT_DIM = HEAD_DIM // 4
NORM_EPS = 1e-6
BLOCK = 128
NEG_INF = -1e30

A_HEADS = 8
A_WIDTH = A_HEADS * HEAD_DIM
A_PATTERNS = ((128, 1), (512, 4), (2048, 16))

B_HEADS = 4
B_QK_DIM = 64
B_V_DIM = 128
B_CHUNK = 128
RET_THETA = 10000.0

MEM_TOKENS = 256
MEM_HEADS = 4
MEM_WIDTH = MEM_HEADS * HEAD_DIM

C_HEADS = 8
C_Q_RANK = 256
C_KV_RANK = 128
C_NOPE = 64
C_ROPE = 32
C_V = 64

D_HEADS = 8
D_HEAD = 64
D_WIDTH = D_HEADS * D_HEAD
D_DECAY_LORA = 64
D_AAA_LORA = 64
D_MV_LORA = 32
RWKV_LN_EPS = 64e-5

EVEN_MIX = A_WIDTH + B_HEADS * B_V_DIM + MEM_WIDTH
ODD_MIX = C_HEADS * C_V + D_WIDTH + MEM_WIDTH
EVEN_COLS = (A_WIDTH, A_WIDTH, A_WIDTH, B_HEADS * B_QK_DIM, B_HEADS * B_QK_DIM,
             B_HEADS * B_V_DIM, MEM_WIDTH, EVEN_MIX)

kernel_name = 'hybrid_dilated_retention_mla_rwkv7_trunk'


def split_cols(t, sizes):
    return jnp.split(t, np.cumsum(sizes)[:-1].tolist(), axis=-1)


def rms_norm(x, g):
    xf = x.astype(jnp.float32)
    y = xf * lax.rsqrt(jnp.mean(xf * xf, -1, keepdims=True) + NORM_EPS)
    return (y * g.astype(jnp.float32)).astype(x.dtype)


def rope_angles(positions, dim, theta):
    inv = jnp.exp(-math.log(theta) * jnp.arange(0, dim, 2, dtype=jnp.float32) / dim)
    ang = positions.astype(jnp.float32)[..., None] * inv
    return jnp.cos(ang), jnp.sin(ang)


def apply_rotary(x, cos, sin):
    half = x.shape[-1] // 2
    c = cos[:, :, None, :].astype(x.dtype)
    s = sin[:, :, None, :].astype(x.dtype)
    x1, x2 = x[..., :half], x[..., half:]
    return jnp.concatenate([x1 * c - x2 * s, x1 * s + x2 * c], -1)


def partial_rotary(x, cos, sin):
    return jnp.concatenate([apply_rotary(x[..., :ROT_DIM], cos, sin), x[..., ROT_DIM:]], -1)


def banded_window_attention(q, k, v, window):
    n, L, h, hd = q.shape
    blk = min(BLOCK, L)
    nb = -(-L // blk)
    pad = nb * blk - L
    if pad:
        q, k, v = (jnp.pad(t, ((0, 0), (0, pad), (0, 0), (0, 0))) for t in (q, k, v))
    qb, kb, vb = (t.reshape(n, nb, blk, h, hd) for t in (q, k, v))
    kk = jnp.concatenate([jnp.concatenate([jnp.zeros_like(kb[:, :1]), kb[:, :-1]], 1), kb], 2)
    vv = jnp.concatenate([jnp.concatenate([jnp.zeros_like(vb[:, :1]), vb[:, :-1]], 1), vb], 2)
    s = jnp.einsum('nbqhd,nbkhd->nbhqk', qb, kk).astype(jnp.float32) * hd ** -0.5
    qi = jnp.arange(blk)[:, None]
    kj = jnp.arange(2 * blk)[None, :] - blk
    dist = qi - kj
    kpos = (jnp.arange(nb) * blk)[:, None, None] + kj[None]
    mask = (dist >= 0)[None] & (dist <= window)[None] & (kpos >= 0)
    s = jnp.where(mask[None, :, None], s, NEG_INF)
    m = jnp.max(s, -1, keepdims=True)
    e = jnp.exp(s - m)
    den = jnp.sum(e, -1, keepdims=True)
    p = e / den
    lse = (m + jnp.log(den))[..., 0]
    o = jnp.einsum('nbhqk,nbkhd->nbqhd', p.astype(v.dtype), vv).reshape(n, nb * blk, h, hd)[:, :L]
    lse = lse.transpose(0, 1, 3, 2).reshape(n, nb * blk, h)[:, :L]
    return o, lse


def dilated_pattern(q, k, v, window, dilation):
    b, s, h, hd = q.shape
    L = s // dilation
    def to_sub(t):
        return t.reshape(b, L, dilation, h, hd).transpose(0, 2, 1, 3, 4).reshape(b * dilation, L, h, hd)
    o, lse = banded_window_attention(to_sub(q), to_sub(k), to_sub(v), window // dilation)
    o = o.reshape(b, dilation, L, h, hd).transpose(0, 2, 1, 3, 4).reshape(b, s, h, hd)
    lse = lse.reshape(b, dilation, L, h).transpose(0, 2, 1, 3).reshape(b, s, h)
    return o, lse


def dilated_mixture_attention(q, k, v):
    res = [dilated_pattern(q, k, v, w, d) for (w, d) in A_PATTERNS]
    outs = jnp.stack([r[0] for r in res], 0)
    wts = jax.nn.softmax(jnp.stack([r[1] for r in res], 0), axis=0)
    return jnp.einsum('pbsh,pbshd->bshd', wts.astype(q.dtype), outs)


def retention(q, k, v, rot):
    b, s, h, dk = q.shape
    dv = v.shape[-1]
    cos, sin = rot
    qf = apply_rotary(q, cos, sin).astype(jnp.float32)
    kf = apply_rotary(k, cos, sin).astype(jnp.float32) * dk ** -0.5
    vf = v.astype(jnp.float32)
    log_g = jnp.log1p(-jnp.exp2(-5.0 - jnp.arange(h, dtype=jnp.float32)))
    c = B_CHUNK
    n = s // c
    qc = qf.reshape(b, n, c, h, dk)
    kc = kf.reshape(b, n, c, h, dk)
    vc = vf.reshape(b, n, c, h, dv)
    idx = jnp.arange(c, dtype=jnp.float32)
    diff = idx[:, None] - idx[None, :]
    d_in = jnp.where(diff[None] >= 0, jnp.exp(jnp.maximum(diff, 0.0)[None] * log_g[:, None, None]), 0.0)
    scores = jnp.einsum('bnqhd,bnkhd->bnhqk', qc, kc) * d_in
    o_in = jnp.einsum('bnhqk,bnkhe->bnqhe', scores, vc)
    to_end = jnp.exp((c - 1.0 - idx)[:, None] * log_g[None])
    chunk_kv = jnp.einsum('bnkhd,kh,bnkhe->nbhde', kc, to_end, vc)
    g_chunk = jnp.exp(c * log_g)[None, :, None, None]
    def step(state, kv):
        return state * g_chunk + kv, state
    _, prev = lax.scan(step, jnp.zeros((b, h, dk, dv), jnp.float32), chunk_kv)
    from_start = jnp.exp((idx + 1.0)[:, None] * log_g[None])
    o_cross = jnp.einsum('bnqhd,nbhde->bnqhe', qc, prev) * from_start[None, None, :, :, None]
    o = (o_in + o_cross).reshape(b, s, h, dv)
    o = o * lax.rsqrt(jnp.mean(o * o, -1, keepdims=True) + NORM_EPS)
    return o.astype(v.dtype)


def causal_attention(q, k, v, scale):
    b, s, h, dq = q.shape
    nq = s // BLOCK
    qb = q.reshape(b, nq, BLOCK, h, dq).transpose(1, 0, 2, 3, 4)
    kpos = jnp.arange(s)
    def one(args):
        qblk, bi = args
        sc = jnp.einsum('bqhd,bkhd->bhqk', qblk, k).astype(jnp.float32) * scale
        qpos = bi * BLOCK + jnp.arange(BLOCK)
        sc = jnp.where((kpos[None, :] <= qpos[:, None])[None, None], sc, NEG_INF)
        p = jax.nn.softmax(sc, axis=-1)
        return jnp.einsum('bhqk,bkhd->bqhd', p.astype(v.dtype), v)
    o = lax.map(one, (qb, jnp.arange(nq)))
    return o.transpose(1, 0, 2, 3, 4).reshape(b, s, h, v.shape[-1])


def mla_attention(cq, ckv, k_rope, rot, q_norm, w_qb, kv_norm, w_kvb):
    b, s, _ = cq.shape
    cos, sin = rot
    q = (rms_norm(cq, q_norm) @ w_qb).reshape(b, s, C_HEADS, C_NOPE + C_ROPE)
    q = jnp.concatenate([q[..., :C_NOPE], apply_rotary(q[..., C_NOPE:], cos, sin)], -1)
    kv = (rms_norm(ckv, kv_norm) @ w_kvb).reshape(b, s, C_HEADS, C_NOPE + C_V)
    k_pe = apply_rotary(k_rope[:, :, None, :], cos, sin)
    k = jnp.concatenate([kv[..., :C_NOPE], jnp.broadcast_to(k_pe, (b, s, C_HEADS, C_ROPE))], -1)
    o = causal_attention(q, k, kv[..., C_NOPE:], (C_NOPE + C_ROPE) ** -0.5)
    return o.reshape(b, s, C_HEADS * C_V)


def memory_attention(qm, mem_n, w_mem_kv):
    b, s, _ = qm.shape
    kv = mem_n @ w_mem_kv
    km = kv[..., :MEM_WIDTH].reshape(b, MEM_TOKENS, MEM_HEADS, HEAD_DIM)
    vm = kv[..., MEM_WIDTH:].reshape(b, MEM_TOKENS, MEM_HEADS, HEAD_DIM)
    q = qm.reshape(b, s, MEM_HEADS, HEAD_DIM)
    sc = jnp.einsum('bshd,bmhd->bhsm', q, km).astype(jnp.float32) * HEAD_DIM ** -0.5
    p = jax.nn.softmax(sc, axis=-1)
    return jnp.einsum('bhsm,bmhd->bshd', p.astype(vm.dtype), vm).reshape(b, s, MEM_WIDTH)


def token_shift(h, mu):
    prev = jnp.pad(h, ((0, 0), (1, 0), (0, 0)))[:, :-1]
    return h + (prev - h) * mu


def wkv7_scan(r, w, k, v, a, bb):
    b, s, h, n = r.shape
    def step(state, inp):
        rt, wt, kt, vt, at, bt = inp
        sa = jnp.einsum('bhvk,bhk->bhv', state, at)
        state = state * wt[:, :, None, :] + sa[..., None] * bt[:, :, None, :] + vt[..., None] * kt[:, :, None, :]
        return state, jnp.einsum('bhvk,bhk->bhv', state, rt)
    xs = tuple(t.astype(jnp.float32).transpose(1, 0, 2, 3) for t in (r, w, k, v, a, bb))
    _, y = lax.scan(step, jnp.zeros((b, h, n, n), jnp.float32), xs)
    return y.transpose(1, 0, 2, 3)


def rwkv7_time_mix(shifted, v_first, w0, w2, a0, a2, v0, v2, k_k, k_a, r_k, lnx_w, lnx_b):
    b, s, _ = shifted.shape
    sizes = [D_WIDTH] * 3 + [D_DECAY_LORA, D_AAA_LORA] + ([D_MV_LORA] if v_first is not None else [])
    parts = split_cols(shifted, sizes)
    r, k, v, w_dn, a_dn = parts[:5]
    logw = -jax.nn.softplus(-(w0 + jnp.tanh(w_dn) @ w2).astype(jnp.float32)) - 0.5
    decay = jnp.exp(-jnp.exp(logw))
    a = jax.nn.sigmoid(a0 + a_dn @ a2)
    if v_first is None:
        v_first = v
    else:
        v = v + (v_first - v) * jax.nn.sigmoid(v0 + parts[5] @ v2)
    hd = lambda t: t.reshape(b, s, D_HEADS, D_HEAD)
    kk = hd(k * k_k).astype(jnp.float32)
    kk = kk / jnp.maximum(jnp.sqrt(jnp.sum(kk * kk, -1, keepdims=True)), 1e-12)
    k = k * (1.0 + (a - 1.0) * k_a)
    ah = hd(a).astype(jnp.float32)
    y = wkv7_scan(hd(r), hd(decay), hd(k), hd(v), -kk, kk * ah)
    mu = jnp.mean(y, -1, keepdims=True)
    var = jnp.mean((y - mu) ** 2, -1, keepdims=True)
    y = ((y - mu) * lax.rsqrt(var + RWKV_LN_EPS)).reshape(b, s, D_WIDTH) * lnx_w + lnx_b
    bonus = jnp.sum(hd(r) * hd(k) * r_k, -1, keepdims=True) * hd(v)
    return (y + bonus.reshape(b, s, D_WIDTH)).astype(shifted.dtype), v_first


def even_layer(x, mem_n, rot, ret_rot, norm, w_in, w_mem_kv, w_out):
    b, s, _ = x.shape
    h = rms_norm(x, norm)
    qa, ka, va, qr, kr, vr, qm, gate = split_cols(h @ w_in, EVEN_COLS)
    cos, sin = rot
    heads = lambda t, nh: t.reshape(b, s, nh, -1)
    a_out = dilated_mixture_attention(partial_rotary(heads(qa, A_HEADS), cos, sin),
                                      partial_rotary(heads(ka, A_HEADS), cos, sin), heads(va, A_HEADS))
    r_out = retention(heads(qr, B_HEADS), heads(kr, B_HEADS), heads(vr, B_HEADS), ret_rot)
    m_out = memory_attention(qm, mem_n, w_mem_kv)
    y = jnp.concatenate([a_out.reshape(b, s, A_WIDTH), r_out.reshape(b, s, B_HEADS * B_V_DIM), m_out], -1)
    return x + (y * jax.nn.silu(gate)) @ w_out


def odd_layer(x, mem_n, mla_rot, v_first, norm, w_in, q_norm, w_qb, kv_norm, w_kvb, mu_shift,
              w0, w2, a0, a2, v0, v2, k_k, k_a, r_k, lnx_w, lnx_b, w_mem_kv, w_out):
    h = rms_norm(x, norm)
    d_cols = mu_shift.shape[0]
    cq, ckv, krope, dproj, qm, gate = split_cols(
        h @ w_in, [C_Q_RANK, C_KV_RANK, C_ROPE, d_cols, MEM_WIDTH, ODD_MIX])
    c_out = mla_attention(cq, ckv, krope, mla_rot, q_norm, w_qb, kv_norm, w_kvb)
    d_out, v_first = rwkv7_time_mix(token_shift(dproj, mu_shift), v_first, w0, w2, a0, a2, v0, v2,
                                    k_k, k_a, r_k, lnx_w, lnx_b)
    m_out = memory_attention(qm, mem_n, w_mem_kv)
    y = jnp.concatenate([c_out, d_out, m_out], -1)
    return x + (y * jax.nn.silu(gate)) @ w_out, v_first


def setup_inputs(seed: int = 0):
    key = jax.random.key(seed)
    keys = iter(jax.random.split(key, 64 + 32 * DEPTH))
    f32 = jnp.float32
    def normal(shape, scale):
        return jax.random.normal(next(keys), shape, f32) * scale
    def gain(n):
        return 1.0 + 0.02 * jax.random.normal(next(keys), (n,), f32)
    def uniform(shape, lo, hi):
        return jax.random.uniform(next(keys), shape, f32, lo, hi)
    out_scale = (2.0 * DEPTH) ** -0.5
    p = {}
    p['x'] = normal((BATCH, SEQ, D_MODEL), 1.0)
    p['mem'] = normal((BATCH, MEM_TOKENS, D_MODEL), 1.0)
    offsets = jax.random.randint(next(keys), (BATCH, 1), 0, 4096, dtype=jnp.int32)
    p['positions'] = jnp.arange(SEQ, dtype=jnp.int32)[None, :] + offsets
    p['mem_norm'] = gain(D_MODEL)
    p['final_norm'] = gain(D_MODEL)
    for layer in range(DEPTH):
        pre = 'l%d_' % layer
        p[pre + 'norm'] = gain(D_MODEL)
        if layer % 2 == 0:
            p[pre + 'w_in'] = normal((D_MODEL, sum(EVEN_COLS)), D_MODEL ** -0.5)
            p[pre + 'w_mem_kv'] = normal((D_MODEL, 2 * MEM_WIDTH), D_MODEL ** -0.5)
            p[pre + 'w_out'] = normal((EVEN_MIX, D_MODEL), EVEN_MIX ** -0.5 * out_scale)
        else:
            vres = layer > 1
            d_cols = 3 * D_WIDTH + D_DECAY_LORA + D_AAA_LORA + (D_MV_LORA if vres else 0)
            odd_cols = C_Q_RANK + C_KV_RANK + C_ROPE + d_cols + MEM_WIDTH + ODD_MIX
            p[pre + 'w_in'] = normal((D_MODEL, odd_cols), D_MODEL ** -0.5)
            p[pre + 'q_norm'] = gain(C_Q_RANK)
            p[pre + 'w_qb'] = normal((C_Q_RANK, C_HEADS * (C_NOPE + C_ROPE)), C_Q_RANK ** -0.5)
            p[pre + 'kv_norm'] = gain(C_KV_RANK)
            p[pre + 'w_kvb'] = normal((C_KV_RANK, C_HEADS * (C_NOPE + C_V)), C_KV_RANK ** -0.5)
            p[pre + 'mu_shift'] = uniform((d_cols,), 0.0, 1.0)
            p[pre + 'w0'] = uniform((D_WIDTH,), -3.0, 1.0)
            p[pre + 'w2'] = normal((D_DECAY_LORA, D_WIDTH), 0.1 * D_DECAY_LORA ** -0.5)
            p[pre + 'a0'] = normal((D_WIDTH,), 0.1)
            p[pre + 'a2'] = normal((D_AAA_LORA, D_WIDTH), 0.1 * D_AAA_LORA ** -0.5)
            if vres:
                p[pre + 'v0'] = 1.0 + normal((D_WIDTH,), 0.1)
                p[pre + 'v2'] = normal((D_MV_LORA, D_WIDTH), 0.1 * D_MV_LORA ** -0.5)
            p[pre + 'k_k'] = 0.85 + normal((D_WIDTH,), 0.02)
            p[pre + 'k_a'] = 1.0 + normal((D_WIDTH,), 0.02)
            p[pre + 'r_k'] = normal((D_HEADS, D_HEAD), 0.1)
            p[pre + 'lnx_w'] = gain(D_WIDTH)
            p[pre + 'lnx_b'] = normal((D_WIDTH,), 0.02)
            p[pre + 'w_mem_kv'] = normal((D_MODEL, 2 * MEM_WIDTH), D_MODEL ** -0.5)
            p[pre + 'w_out'] = normal((ODD_MIX, D_MODEL), ODD_MIX ** -0.5 * out_scale)
    return p


def reference(x, mem, positions, mem_norm, final_norm,
              l0_norm, l0_w_in, l0_w_mem_kv, l0_w_out,
              l1_norm, l1_w_in, l1_q_norm, l1_w_qb, l1_kv_norm, l1_w_kvb, l1_mu_shift,
              l1_w0, l1_w2, l1_a0, l1_a2, l1_k_k, l1_k_a, l1_r_k, l1_lnx_w, l1_lnx_b,
              l1_w_mem_kv, l1_w_out,
              l2_norm, l2_w_in, l2_w_mem_kv, l2_w_out,
              l3_norm, l3_w_in, l3_q_norm, l3_w_qb, l3_kv_norm, l3_w_kvb, l3_mu_shift,
              l3_w0, l3_w2, l3_a0, l3_a2, l3_v0, l3_v2, l3_k_k, l3_k_a, l3_r_k, l3_lnx_w, l3_lnx_b,
              l3_w_mem_kv, l3_w_out):
    rot = rope_angles(positions, ROT_DIM, ROPE_THETA)
    ret_rot = rope_angles(positions, B_QK_DIM, RET_THETA)
    mla_rot = rope_angles(positions, C_ROPE, ROPE_THETA)
    mem_n = rms_norm(mem, mem_norm)
    layers = (
        dict(norm=l0_norm, w_in=l0_w_in, w_mem_kv=l0_w_mem_kv, w_out=l0_w_out),
        dict(norm=l1_norm, w_in=l1_w_in, q_norm=l1_q_norm, w_qb=l1_w_qb, kv_norm=l1_kv_norm,
             w_kvb=l1_w_kvb, mu_shift=l1_mu_shift, w0=l1_w0, w2=l1_w2, a0=l1_a0, a2=l1_a2,
             v0=None, v2=None, k_k=l1_k_k, k_a=l1_k_a, r_k=l1_r_k, lnx_w=l1_lnx_w, lnx_b=l1_lnx_b,
             w_mem_kv=l1_w_mem_kv, w_out=l1_w_out),
        dict(norm=l2_norm, w_in=l2_w_in, w_mem_kv=l2_w_mem_kv, w_out=l2_w_out),
        dict(norm=l3_norm, w_in=l3_w_in, q_norm=l3_q_norm, w_qb=l3_w_qb, kv_norm=l3_kv_norm,
             w_kvb=l3_w_kvb, mu_shift=l3_mu_shift, w0=l3_w0, w2=l3_w2, a0=l3_a0, a2=l3_a2,
             v0=l3_v0, v2=l3_v2, k_k=l3_k_k, k_a=l3_k_a, r_k=l3_r_k, lnx_w=l3_lnx_w, lnx_b=l3_lnx_b,
             w_mem_kv=l3_w_mem_kv, w_out=l3_w_out),
    )
    v_first = None
    for i in range(DEPTH):
        if i % 2 == 0:
            x = even_layer(x, mem_n, rot, ret_rot, **layers[i])
        else:
            x, v_first = odd_layer(x, mem_n, mla_rot, v_first, **layers[i])
    return rms_norm(x, final_norm)
```

```cpp
#include <hip/hip_runtime.h>
#include <stdint.h>
#include <cstdio>

typedef unsigned short bf16_t;
typedef unsigned u32x4 __attribute__((ext_vector_type(4)));
typedef float f32x4 __attribute__((ext_vector_type(4)));
#define DI __device__ __forceinline__

constexpr int BATCH = 16, SEQ = 2048, DM = 1024, MTOK = BATCH * SEQ, MEMT = 256, MROWS = BATCH * MEMT;
constexpr int PE = 4096, PO = 3840;
constexpr int E_QA = 0, E_KA = 512, E_VA = 1024, E_QR = 1536, E_KR = 1792, E_VR = 2048, E_QM = 2560, E_G = 2816;
constexpr int O_CQ = 0, O_CKV = 256, O_KR = 384, O_R = 512, O_K = 1024, O_V = 1536, O_WD = 2048, O_AD = 2112, O_MV = 2176, O_QM = 2304, O_G = 2560;
constexpr float NORM_EPS = 1e-6f, LOG2E = 1.4426950408889634f;
constexpr float QSCALE = 0.125f * LOG2E;
constexpr float QSCALE_MLA = 0.10206207261596575f * LOG2E;

constexpr size_t MiB = 1u << 20;
constexpr size_t WS_CTL = 0, WS_SSQ = 1 * MiB, WS_CQSQ = 3 * MiB, WS_CKVSQ = 3 * MiB + 512 * 1024, WS_MRSTD = 4 * MiB;
constexpr size_t WS_TABA = 8 * MiB, WS_TABR = 10 * MiB, WS_TABM = 18 * MiB;
constexpr size_t WS_WI0 = 24 * MiB, WS_WI1 = 32 * MiB, WS_WI2 = WS_WI1 + 7680 * 1024, WS_WI3 = WS_WI2 + 8 * MiB;
constexpr size_t WS_WO = 55 * MiB;
constexpr size_t WS_WMEM = 65 * MiB;
constexpr size_t WS_WQB = 69 * MiB;
constexpr size_t WS_WKVB = WS_WQB + 768 * 1024;
constexpr size_t WS_MEMB = 72 * MiB, WS_MEMKV = 80 * MiB, WS_VFIRST = 96 * MiB, WS_XB = 128 * MiB, WS_MLAQ = 192 * MiB, WS_PROJ = 240 * MiB;
constexpr size_t WS_END = 496 * MiB;

DI float bf2f(bf16_t v) { return __uint_as_float((unsigned)v << 16); }
DI bf16_t f2bf(float f) { unsigned u = __float_as_uint(f); return (bf16_t)((u + 0x7fffu + ((u >> 16) & 1u)) >> 16); }
DI unsigned pk2(float lo, float hi) { return (unsigned)f2bf(lo) | ((unsigned)f2bf(hi) << 16); }
DI float wave_sum(float v) {
#pragma unroll
    for (int o = 1; o < 64; o <<= 1) v += __shfl_xor(v, o);
    return v;
}
DI float siluf(float x) { return x / (1.f + __expf(-x)); }
DI float sigmoidf_(float x) { return 1.f / (1.f + __expf(-x)); }

DI int phys2log(int mapid, int p, int aux) {
    if (mapid == 1) {
        if (p < 1024) { const int pos = p & 63, base = p & ~63; return pos < 16 ? base + (pos & 1) * 8 + (pos >> 1) : p; }
        if (p >= 1536 && p < 2048) { const int pos = p & 63, base = p & ~63; return base + (pos & 1) * 32 + (pos >> 1); }
        return p;
    }
    if (mapid == 2) {
        if (p < 384) return p;
        if (p < 416) { const int pos = p - 384; return 384 + (pos & 1) * 16 + (pos >> 1); }
        if (p < 512) return -1;
        if (p < 2048) return 416 + (p - 512);
        if (p < 2176) return 416 + 1536 + (p - 2048);
        if (p < 2208) return aux > 1664 ? 416 + 1664 + (p - 2176) : -1;
        if (p < 2304) return -1;
        if (p < 2560) return 416 + aux + (p - 2304);
        return 416 + aux + 256 + (p - 2560);
    }
    if (mapid == 3) {
        const int hh = p / 96, pos = p % 96;
        if (pos < 64) return p;
        const int pp = pos - 64; return hh * 96 + 64 + (pp & 1) * 16 + (pp >> 1);
    }
    return p;
}

__global__ __launch_bounds__(256) void k_wconv(const float* __restrict__ W, int K, int Nsrc, bf16_t* __restrict__ dst, int Nphys, int row_off, int mapid, int aux, const float* __restrict__ gain) {
    __shared__ float scr_all[4][64 * 33];
    const int wave = threadIdx.x >> 6, lane = threadIdx.x & 63;
    float* scr = scr_all[wave];
    const int nblk = Nphys / 32, kblk = (K + 63) / 64, nitems = nblk * kblk;
    for (int item = blockIdx.x * 4 + wave; item < nitems; item += gridDim.x * 4) {
        const int kb = item / nblk, nb = item % nblk, k0 = 64 * kb, n0 = 32 * nb;
        const int nl = phys2log(mapid, n0 + (lane & 31), aux);
        for (int i = 0; i < 32; ++i) {
            const int kk = 2 * i + (lane >> 5);
            float v = 0.f;
            if (nl >= 0 && k0 + kk < K) { v = W[(size_t)(k0 + kk) * Nsrc + nl]; if (gain) v *= gain[k0 + kk]; }
            scr[kk * 33 + (lane & 31)] = v;
        }
        asm volatile("s_waitcnt lgkmcnt(0)" ::: "memory");
        const int c = lane & 7;
        if (k0 + 8 * c < K) {
            for (int j = 0; j < 4; ++j) {
                const int n = (lane >> 3) + 8 * j; const float* s = scr + (8 * c) * 33 + n;
                u32x4 o; o.x = pk2(s[0], s[33]); o.y = pk2(s[66], s[99]); o.z = pk2(s[132], s[165]); o.w = pk2(s[198], s[231]);
                *(u32x4*)(dst + (size_t)(row_off + n0 + n) * K + k0 + 8 * c) = o;
            }
        }
        asm volatile("s_waitcnt lgkmcnt(0)" ::: "memory");
    }
}

__global__ __launch_bounds__(256) void k_rows_prep(const float* __restrict__ x, bf16_t* __restrict__ xb, float* __restrict__ stat, int R, int mode) {
    const int lane = threadIdx.x & 63; const int gw = blockIdx.x * 4 + (threadIdx.x >> 6), ngw = gridDim.x * 4;
    for (int r = gw; r < R; r += ngw) {
        const f32x4* xr = (const f32x4*)(x + (size_t)r * DM) + lane;
        float s = 0.f;
        unsigned long long* o8 = (unsigned long long*)(xb + (size_t)r * DM) + lane;
#pragma unroll
        for (int j = 0; j < 4; ++j) { const f32x4 v = xr[64 * j]; s += v.x * v.x + v.y * v.y + v.z * v.z + v.w * v.w;
            o8[64 * j] = (unsigned long long)pk2(v.x, v.y) | ((unsigned long long)pk2(v.z, v.w) << 32); }
        s = wave_sum(s);
        if (mode == 0) { if (lane < 16) stat[(size_t)r * 16 + lane] = lane == 0 ? s : 0.f; }
        else if (lane == 0) stat[r] = rsqrtf(s * (1.f / DM) + NORM_EPS);
    }
}

__global__ __launch_bounds__(256) void k_tables(const int* __restrict__ positions, float2* __restrict__ tabA, float2* __restrict__ tabR, float2* __restrict__ tabM) {
    const int idx = blockIdx.x * 256 + threadIdx.x;
    const int row = idx >> 6, i = idx & 63;
    if (row >= MTOK) return;
    const float pos = (float)positions[row];
    float theta, dim; int j; float2* dst;
    if (i < 8) { theta = 500000.f; dim = 16.f; j = i; dst = tabA + (size_t)row * 8 + j; }
    else if (i < 40) { theta = 10000.f; dim = 64.f; j = i - 8; dst = tabR + (size_t)row * 32 + j; }
    else if (i < 56) { theta = 500000.f; dim = 32.f; j = i - 40; dst = tabM + (size_t)row * 16 + j; }
    else return;
    const float inv = expf((-logf(theta) * (float)(2 * j)) / dim);
    const float ang = pos * inv;
    *dst = make_float2((float)cos((double)ang), (float)sin((double)ang));
}

DI void store8(bf16_t* p, const float* v) { u32x4 o; o.x = pk2(v[0], v[1]); o.y = pk2(v[2], v[3]); o.z = pk2(v[4], v[5]); o.w = pk2(v[6], v[7]); *(u32x4*)p = o; }
DI void rot4(float* v, const float2* cs) {
#pragma unroll
    for (int j = 0; j < 4; ++j) { const float2 c = cs[j]; const float a = v[2 * j], b = v[2 * j + 1]; v[2 * j] = a * c.x - b * c.y; v[2 * j + 1] = a * c.y + b * c.x; }
}
DI float ssq16_rstd(const float* ssq, int row, float invn) {
    const f32x4* p = (const f32x4*)(ssq + (size_t)row * 16); const f32x4 a = p[0], b = p[1], c = p[2], d = p[3];
    const float s = (a.x + a.y + a.z + a.w) + (b.x + b.y + b.z + b.w) + (c.x + c.y + c.z + c.w) + (d.x + d.y + d.z + d.w);
    return rsqrtf(s * invn + NORM_EPS);
}
DI float ssq4_rstd(const float* ssq, int row, float invn) { const f32x4 a = *(const f32x4*)(ssq + (size_t)row * 4); return rsqrtf((a.x + a.y + a.z + a.w) * invn + NORM_EPS); }

struct EpiEvenIn {
    bf16_t* out; const float* ssq; const float2* tabA; const float2* tabR;
    DI float rowscale(int row) const { return ssq16_rstd(ssq, row, 1.f / DM); }
    DI float apply(int row, int c, float* v, float rs) const {
#pragma unroll
        for (int i = 0; i < 8; ++i) v[i] *= rs;
        if (c < E_VA) {
            const int pos = c & 63;
            if (pos < 16) rot4(v, tabA + (size_t)row * 8 + (pos >> 1));
            if (c < E_KA) {
#pragma unroll
                for (int i = 0; i < 8; ++i) v[i] *= QSCALE;
            }
        } else if (c >= E_QR && c < E_VR) {
            const int pos = c & 63, h = ((c - E_QR) & 255) >> 6;
            rot4(v, tabR + (size_t)row * 32 + (pos >> 1));
            const float lg = log2f(1.f - exp2f(-5.f - (float)h)), s = (float)(row & (SEQ - 1));
            const float f = c < E_KR ? exp2f(s * lg) : 0.125f * exp2f(-s * lg);
#pragma unroll
            for (int i = 0; i < 8; ++i) v[i] *= f;
        } else if (c >= E_QM && c < E_G) {
#pragma unroll
            for (int i = 0; i < 8; ++i) v[i] *= QSCALE;
        } else if (c >= E_G) {
#pragma unroll
            for (int i = 0; i < 8; ++i) v[i] = siluf(v[i]);
        }
        store8(out + (size_t)row * PE + c, v);
        return 0.f;
    }
};
struct EpiOddIn {
    bf16_t* out; const float* ssq; const float2* tabM;
    DI float rowscale(int row) const { return ssq16_rstd(ssq, row, 1.f / DM); }
    DI float apply(int row, int c, float* v, float rs) const {
        float ss = 0.f;
#pragma unroll
        for (int i = 0; i < 8; ++i) v[i] *= rs;
        if (c < O_KR) {
#pragma unroll
            for (int i = 0; i < 8; ++i) ss += v[i] * v[i];
        } else if (c < O_KR + 32) rot4(v, tabM + (size_t)row * 16 + ((c - O_KR) >> 1));
        else if (c >= O_QM && c < O_G) {
#pragma unroll
            for (int i = 0; i < 8; ++i) v[i] *= QSCALE;
        } else if (c >= O_G) {
#pragma unroll
            for (int i = 0; i < 8; ++i) v[i] = siluf(v[i]);
        }
        store8(out + (size_t)row * PO + c, v);
        return ss;
    }
};
struct EpiWOut {
    const float* resid; float* xo; bf16_t* xb;
    DI float rowscale(int) const { return 1.f; }
    DI float apply(int row, int c, float* v, float) const {
        const f32x4* r = (const f32x4*)(resid + (size_t)row * DM + c); const f32x4 r0 = r[0], r1 = r[1];
        v[0] += r0.x; v[1] += r0.y; v[2] += r0.z; v[3] += r0.w; v[4] += r1.x; v[5] += r1.y; v[6] += r1.z; v[7] += r1.w;
        f32x4* o = (f32x4*)(xo + (size_t)row * DM + c); o[0] = (f32x4){v[0], v[1], v[2], v[3]}; o[1] = (f32x4){v[4], v[5], v[6], v[7]};
        store8(xb + (size_t)row * DM + c, v);
        float ss = 0.f;
#pragma unroll
        for (int i = 0; i < 8; ++i) ss += v[i] * v[i];
        return ss;
    }
};
struct EpiMemKV {
    bf16_t* out; const float* rstd;
    DI float rowscale(int row) const { return rstd[row]; }
    DI float apply(int row, int c, float* v, float rs) const {
#pragma unroll
        for (int i = 0; i < 8; ++i) v[i] *= rs;
        store8(out + (size_t)row * 2048 + c, v); return 0.f;
    }
};
struct EpiMlaQ {
    bf16_t* out; const float* cqsq; const float2* tabM;
    DI float rowscale(int row) const { return ssq4_rstd(cqsq, row, 1.f / 256.f); }
    DI float apply(int row, int c, float* v, float rs) const {
        const int pos = c % 96;
        if (pos >= 64) rot4(v, tabM + (size_t)row * 16 + ((pos - 64) >> 1));
        const float f = rs * QSCALE_MLA;
#pragma unroll
        for (int i = 0; i < 8; ++i) v[i] *= f;
        store8(out + (size_t)row * 768 + c, v); return 0.f;
    }
};
struct EpiMlaKV {
    bf16_t* out; const float* ckvsq;
    DI float rowscale(int row) const { return ssq4_rstd(ckvsq, row, 1.f / 128.f); }
    DI float apply(int row, int c, float* v, float rs) const {
#pragma unroll
        for (int i = 0; i < 8; ++i) v[i] *= rs;
        store8(out + (size_t)row * 1024 + c, v); return 0.f;
    }
};

template <class Epi>
__global__ __launch_bounds__(256) void k_gemm_naive(const bf16_t* __restrict__ A, int lda, const bf16_t* __restrict__ Bt, int M, int N, int K, Epi epi) {
    __shared__ float As[32][132];
    __shared__ float Bs[32][68];
    const int tid = threadIdx.x, tx = tid & 7, ty = tid >> 3;
    const int ntn = N / 64; const int tm = blockIdx.x / ntn, tn = blockIdx.x % ntn;
    const int row0 = tm * 128, col0 = tn * 64;
    float acc[4][8];
#pragma unroll
    for (int i = 0; i < 4; ++i)
#pragma unroll
        for (int j = 0; j < 8; ++j) acc[i][j] = 0.f;
    for (int k0 = 0; k0 < K; k0 += 32) {
#pragma unroll
        for (int i = 0; i < 2; ++i) {
            const int e = tid + 256 * i, r = e >> 2, kc = (e & 3) * 8;
            const u32x4 w = *(const u32x4*)(A + (size_t)(row0 + r) * lda + k0 + kc);
            As[kc + 0][r] = __uint_as_float(w.x << 16); As[kc + 1][r] = __uint_as_float(w.x & 0xffff0000u);
            As[kc + 2][r] = __uint_as_float(w.y << 16); As[kc + 3][r] = __uint_as_float(w.y & 0xffff0000u);
            As[kc + 4][r] = __uint_as_float(w.z << 16); As[kc + 5][r] = __uint_as_float(w.z & 0xffff0000u);
            As[kc + 6][r] = __uint_as_float(w.w << 16); As[kc + 7][r] = __uint_as_float(w.w & 0xffff0000u);
        }
        {
            const int r = tid >> 2, kc = (tid & 3) * 8;
            const u32x4 w = *(const u32x4*)(Bt + (size_t)(col0 + r) * K + k0 + kc);
            Bs[kc + 0][r] = __uint_as_float(w.x << 16); Bs[kc + 1][r] = __uint_as_float(w.x & 0xffff0000u);
            Bs[kc + 2][r] = __uint_as_float(w.y << 16); Bs[kc + 3][r] = __uint_as_float(w.y & 0xffff0000u);
            Bs[kc + 4][r] = __uint_as_float(w.z << 16); Bs[kc + 5][r] = __uint_as_float(w.z & 0xffff0000u);
            Bs[kc + 6][r] = __uint_as_float(w.w << 16); Bs[kc + 7][r] = __uint_as_float(w.w & 0xffff0000u);
        }
        __syncthreads();
#pragma unroll 8
        for (int k = 0; k < 32; ++k) {
            const f32x4 a = *(const f32x4*)&As[k][ty * 4];
            const f32x4 b0 = *(const f32x4*)&Bs[k][tx * 8], b1 = *(const f32x4*)&Bs[k][tx * 8 + 4];
            const float av[4] = {a.x, a.y, a.z, a.w}; const float bv[8] = {b0.x, b0.y, b0.z, b0.w, b1.x, b1.y, b1.z, b1.w};
#pragma unroll
            for (int i = 0; i < 4; ++i)
#pragma unroll
                for (int j = 0; j < 8; ++j) acc[i][j] += av[i] * bv[j];
        }
        __syncthreads();
    }
#pragma unroll
    for (int i = 0; i < 4; ++i) { const int row = row0 + ty * 4 + i; epi.apply(row, col0 + tx * 8, acc[i], epi.rowscale(row)); }
}

__global__ __launch_bounds__(256) void k_rowssq_f32(const float* __restrict__ x, float* __restrict__ ssq) {
    const int lane = threadIdx.x & 63; const int r = blockIdx.x * 4 + (threadIdx.x >> 6);
    const f32x4* xr = (const f32x4*)(x + (size_t)r * DM) + lane; float s = 0.f;
#pragma unroll
    for (int j = 0; j < 4; ++j) { const f32x4 v = xr[64 * j]; s += v.x * v.x + v.y * v.y + v.z * v.z + v.w * v.w; }
    s = wave_sum(s);
    if (lane < 16) ssq[(size_t)r * 16 + lane] = lane == 0 ? s : 0.f;
}
__global__ __launch_bounds__(256) void k_rowssq_bf16(const bf16_t* __restrict__ p, int pitch, int col0, int ncols, float* __restrict__ out4) {
    const int lane = threadIdx.x & 63; const int r = blockIdx.x * 4 + (threadIdx.x >> 6); float s = 0.f;
    for (int c = lane; c < ncols; c += 64) { const float v = bf2f(p[(size_t)r * pitch + col0 + c]); s += v * v; }
    s = wave_sum(s);
    if (lane < 4) out4[(size_t)r * 4 + lane] = lane == 0 ? s : 0.f;
}

__global__ __launch_bounds__(256) void k_attnA_naive(bf16_t* __restrict__ proj) {
    const int lane = threadIdx.x & 63; const int gw = blockIdx.x * 4 + (threadIdx.x >> 6);
    const int row = gw >> 3, h = gw & 7, b = row >> 11, s = row & (SEQ - 1);
    const float q = bf2f(proj[(size_t)row * PE + E_QA + h * 64 + lane]);
    float lse[3], o[3];
#pragma unroll
    for (int p = 0; p < 3; ++p) {
        const int dil = p == 0 ? 1 : (p == 1 ? 4 : 16);
        const int ls = s / dil, r = s % dil, j0 = ls - 128 < 0 ? 0 : ls - 128;
        float m = -INFINITY, l = 0.f, acc = 0.f;
        for (int j = j0; j <= ls; ++j) {
            const size_t kr = (size_t)(b * SEQ + j * dil + r) * PE;
            const float sc = wave_sum(q * bf2f(proj[kr + E_KA + h * 64 + lane]));
            const float vv = bf2f(proj[kr + E_VA + h * 64 + lane]);
            const float mn = fmaxf(m, sc), al = exp2f(m - mn), pp = exp2f(sc - mn);
            l = l * al + pp; acc = acc * al + pp * vv; m = mn;
        }
        lse[p] = m + log2f(l); o[p] = acc / l;
    }
    const float mx = fmaxf(lse[0], fmaxf(lse[1], lse[2]));
    const float w0 = exp2f(lse[0] - mx), w1 = exp2f(lse[1] - mx), w2 = exp2f(lse[2] - mx);
    const float out = (w0 * o[0] + w1 * o[1] + w2 * o[2]) / (w0 + w1 + w2);
    bf16_t* g = proj + (size_t)row * PE + E_G + h * 64 + lane;
    *g = f2bf(out * bf2f(*g));
}
__global__ __launch_bounds__(256) void k_ret_naive(bf16_t* __restrict__ proj) {
    const int lane = threadIdx.x & 63; const int gw = blockIdx.x * 4 + (threadIdx.x >> 6);
    const int row = gw >> 2, h = gw & 3, b = row >> 11, s = row & (SEQ - 1);
    const float q = bf2f(proj[(size_t)row * PE + E_QR + h * 64 + lane]);
    float o0 = 0.f, o1 = 0.f;
    for (int j = 0; j <= s; ++j) {
        const size_t kr = (size_t)(b * SEQ + j) * PE;
        const float sc = wave_sum(q * bf2f(proj[kr + E_KR + h * 64 + lane]));
        o0 += sc * bf2f(proj[kr + E_VR + h * 128 + lane]); o1 += sc * bf2f(proj[kr + E_VR + h * 128 + 64 + lane]);
    }
    const float rn = rsqrtf(wave_sum(o0 * o0 + o1 * o1) * (1.f / 128.f) + NORM_EPS);
    bf16_t* g = proj + (size_t)row * PE + E_G + 512 + h * 128 + lane;
    g[0] = f2bf(o0 * rn * bf2f(g[0])); g[64] = f2bf(o1 * rn * bf2f(g[64]));
}
__global__ __launch_bounds__(256) void k_mem_naive(bf16_t* __restrict__ proj, int pitch, int qcol, int gcol, const bf16_t* __restrict__ memkv, int layer) {
    const int lane = threadIdx.x & 63; const int gw = blockIdx.x * 4 + (threadIdx.x >> 6);
    const int row = gw >> 2, h = gw & 3, b = row >> 11;
    const float q = bf2f(proj[(size_t)row * pitch + qcol + h * 64 + lane]);
    float m = -INFINITY, l = 0.f, acc = 0.f;
    for (int j = 0; j < MEMT; ++j) {
        const bf16_t* kv = memkv + (size_t)(b * MEMT + j) * 2048 + layer * 512 + h * 64 + lane;
        const float sc = wave_sum(q * bf2f(kv[0])), vv = bf2f(kv[256]);
        const float mn = fmaxf(m, sc), al = exp2f(m - mn), pp = exp2f(sc - mn);
        l = l * al + pp; acc = acc * al + pp * vv; m = mn;
    }
    bf16_t* g = proj + (size_t)row * pitch + gcol + h * 64 + lane;
    *g = f2bf(acc / l * bf2f(*g));
}
__global__ __launch_bounds__(256) void k_mla_naive(bf16_t* __restrict__ proj, const bf16_t* __restrict__ mq, const bf16_t* __restrict__ mkv) {
    const int lane = threadIdx.x & 63; const int gw = blockIdx.x * 4 + (threadIdx.x >> 6);
    const int row = gw >> 3, h = gw & 7, b = row >> 11, s = row & (SEQ - 1);
    const float qn = bf2f(mq[(size_t)row * 768 + h * 96 + lane]);
    const float qr = lane < 32 ? bf2f(mq[(size_t)row * 768 + h * 96 + 64 + lane]) : 0.f;
    float m = -INFINITY, l = 0.f, acc = 0.f;
    for (int j = 0; j <= s; ++j) {
        const size_t kr = (size_t)(b * SEQ + j);
        float pr = qn * bf2f(mkv[kr * 1024 + h * 128 + lane]);
        if (lane < 32) pr += qr * bf2f(proj[kr * PO + O_KR + lane]);
        const float sc = wave_sum(pr), vv = bf2f(mkv[kr * 1024 + h * 128 + 64 + lane]);
        const float mn = fmaxf(m, sc), al = exp2f(m - mn), pp = exp2f(sc - mn);
        l = l * al + pp; acc = acc * al + pp * vv; m = mn;
    }
    bf16_t* g = proj + (size_t)row * PO + O_G + h * 64 + lane;
    *g = f2bf(acc / l * bf2f(*g));
}
struct RwkvW { const float *mu, *w0, *w2, *a0, *a2, *v0, *v2, *k_k, *k_a, *r_k, *lnx_w, *lnx_b; };
__global__ __launch_bounds__(64) void k_rwkv_naive(bf16_t* __restrict__ proj, bf16_t* __restrict__ vfirst, RwkvW W, int vres) {
    __shared__ float sh[8][64];
    const int lane = threadIdx.x, b = blockIdx.x >> 3, h = blockIdx.x & 7, hc = h * 64 + lane;
    float S[64];
#pragma unroll
    for (int k = 0; k < 64; ++k) S[k] = 0.f;
    float pr = 0.f, pk = 0.f, pv = 0.f, pwd = 0.f, pad = 0.f, pmv = 0.f;
    const float mu_r = W.mu[hc], mu_k = W.mu[512 + hc], mu_v = W.mu[1024 + hc], mu_wd = W.mu[1536 + lane], mu_ad = W.mu[1600 + lane];
    const float mu_mv = (vres && lane < 32) ? W.mu[1664 + lane] : 0.f;
    const float w0 = W.w0[hc], a0 = W.a0[hc], v0 = vres ? W.v0[hc] : 0.f, k_k = W.k_k[hc], k_a = W.k_a[hc], r_k = W.r_k[hc], lw = W.lnx_w[hc], lb = W.lnx_b[hc];
    for (int t = 0; t < SEQ; ++t) {
        const size_t row = (size_t)b * SEQ + t; const bf16_t* pr_ = proj + row * PO;
        const float xr = bf2f(pr_[O_R + hc]), xk = bf2f(pr_[O_K + hc]), xv = bf2f(pr_[O_V + hc]), xwd = bf2f(pr_[O_WD + lane]), xad = bf2f(pr_[O_AD + lane]);
        const float xmv = (vres && lane < 32) ? bf2f(pr_[O_MV + lane]) : 0.f;
        const float rs = xr + (pr - xr) * mu_r, ks = xk + (pk - xk) * mu_k, vs = xv + (pv - xv) * mu_v;
        const float wds = xwd + (pwd - xwd) * mu_wd, ads = xad + (pad - xad) * mu_ad, mvs = xmv + (pmv - xmv) * mu_mv;
        pr = xr; pk = xk; pv = xv; pwd = xwd; pad = xad; pmv = xmv;
        __syncthreads();
        sh[0][lane] = tanhf(wds); sh[1][lane] = ads; sh[2][lane] = mvs;
        __syncthreads();
        float pw = w0, pa = a0, pvv = v0;
#pragma unroll 4
        for (int j = 0; j < 64; ++j) { pw += sh[0][j] * W.w2[j * 512 + hc]; pa += sh[1][j] * W.a2[j * 512 + hc]; }
        if (vres) {
#pragma unroll 4
            for (int j = 0; j < 32; ++j) pvv += sh[2][j] * W.v2[j * 512 + hc];
        }
        const float z = -pw, sp = fmaxf(z, 0.f) + log1pf(expf(-fabsf(z)));
        const float dec = expf(-expf(-sp - 0.5f));
        const float a = sigmoidf_(pa);
        float vv = vs;
        if (vres) vv = vs + (bf2f(vfirst[row * 512 + hc]) - vs) * sigmoidf_(pvv); else vfirst[row * 512 + hc] = f2bf(vs);
        float kk = ks * k_k; const float nrm = sqrtf(wave_sum(kk * kk)); kk = kk / fmaxf(nrm, 1e-12f);
        const float kx = ks * (1.f + (a - 1.f) * k_a);
        sh[3][lane] = -kk; sh[4][lane] = kk * a; sh[5][lane] = dec; sh[6][lane] = kx; sh[7][lane] = rs;
        __syncthreads();
        float sa = 0.f;
#pragma unroll
        for (int k = 0; k < 64; ++k) { sa += S[k] * sh[3][k]; if ((k & 7) == 7) asm volatile("" ::: "memory"); }
        float y = 0.f;
#pragma unroll
        for (int k = 0; k < 64; ++k) { S[k] = S[k] * sh[5][k] + sa * sh[4][k] + vv * sh[6][k]; y += S[k] * sh[7][k]; if ((k & 3) == 3) asm volatile("" ::: "memory"); }
        const float mean = wave_sum(y) * (1.f / 64.f), dy = y - mean, var = wave_sum(dy * dy) * (1.f / 64.f);
        const float yn = dy * rsqrtf(var + 64e-5f) * lw + lb;
        const float bonus = wave_sum(rs * kx * r_k) * vv;
        bf16_t* g = proj + row * PO + O_G + 512 + hc;
        *g = f2bf((yn + bonus) * bf2f(*g));
    }
}
__global__ __launch_bounds__(256) void k_final_norm(float* __restrict__ x, const float* __restrict__ g) {
    const int lane = threadIdx.x & 63; const int r = blockIdx.x * 4 + (threadIdx.x >> 6);
    f32x4* xr = (f32x4*)(x + (size_t)r * DM) + lane; const f32x4* gr = (const f32x4*)g + lane;
    f32x4 v[4]; float s = 0.f;
#pragma unroll
    for (int j = 0; j < 4; ++j) { v[j] = xr[64 * j]; s += v[j].x * v[j].x + v[j].y * v[j].y + v[j].z * v[j].z + v[j].w * v[j].w; }
    const float rn = rsqrtf(wave_sum(s) * (1.f / DM) + NORM_EPS);
#pragma unroll
    for (int j = 0; j < 4; ++j) { const f32x4 gg = gr[64 * j]; xr[64 * j] = (f32x4){v[j].x * rn * gg.x, v[j].y * rn * gg.y, v[j].z * rn * gg.z, v[j].w * rn * gg.w}; }
}

template <class Epi> static void gemm_naive(hipStream_t st, const bf16_t* A, int lda, const bf16_t* Bt, int M, int N, int K, Epi e) {
    hipLaunchKernelGGL(k_gemm_naive<Epi>, dim3((M / 128) * (N / 64)), dim3(256), 0, st, A, lda, Bt, M, N, K, e);
}
extern "C" void kernel_launch(void* const* d_in, const int* in_sizes, int n_in, void* d_out, int out_size, void* d_ws, size_t ws_size, hipStream_t stream) {
    if (n_in != 51 || ws_size < WS_END) { fprintf(stderr, "kernel_launch: unexpected n_in %d / ws %zu\n", n_in, ws_size); return; }
    auto F = [&](int i) { return (const float*)d_in[i]; };
    unsigned char* ws = (unsigned char*)d_ws;
    float* out = (float*)d_out;
    float* ssq = (float*)(ws + WS_SSQ); float* cqsq = (float*)(ws + WS_CQSQ); float* ckvsq = (float*)(ws + WS_CKVSQ); float* mrstd = (float*)(ws + WS_MRSTD);
    float2* tabA = (float2*)(ws + WS_TABA); float2* tabR = (float2*)(ws + WS_TABR); float2* tabM = (float2*)(ws + WS_TABM);
    bf16_t* wi[4] = {(bf16_t*)(ws + WS_WI0), (bf16_t*)(ws + WS_WI1), (bf16_t*)(ws + WS_WI2), (bf16_t*)(ws + WS_WI3)};
    bf16_t* wo[4]; for (int l = 0; l < 4; ++l) wo[l] = (bf16_t*)(ws + WS_WO + (size_t)l * 2560 * 1024);
    bf16_t* wmem = (bf16_t*)(ws + WS_WMEM);
    bf16_t* wqb[2] = {(bf16_t*)(ws + WS_WQB), (bf16_t*)(ws + WS_WQB + 384 * 1024)};
    bf16_t* wkvb[2] = {(bf16_t*)(ws + WS_WKVB), (bf16_t*)(ws + WS_WKVB + 256 * 1024)};
    bf16_t* memb = (bf16_t*)(ws + WS_MEMB); bf16_t* memkv = (bf16_t*)(ws + WS_MEMKV); bf16_t* vfirst = (bf16_t*)(ws + WS_VFIRST);
    bf16_t* xb = (bf16_t*)(ws + WS_XB); bf16_t* mlakv = xb; bf16_t* mlaq = (bf16_t*)(ws + WS_MLAQ); bf16_t* proj = (bf16_t*)(ws + WS_PROJ);
    const int L_NORM[4] = {5, 9, 27, 31}, L_WIN[4] = {6, 10, 28, 32}, L_WMEM[4] = {7, 25, 29, 49}, L_WOUT[4] = {8, 26, 30, 50};
    hipLaunchKernelGGL(k_tables, dim3(MTOK * 64 / 256), dim3(256), 0, stream, (const int*)d_in[2], tabA, tabR, tabM);
    hipLaunchKernelGGL(k_rows_prep, dim3(2048), dim3(256), 0, stream, F(0), xb, ssq, MTOK, 0);
    hipLaunchKernelGGL(k_rows_prep, dim3(1024), dim3(256), 0, stream, F(1), memb, mrstd, MROWS, 1);
    for (int l = 0; l < 4; ++l) {
        const bool odd = l & 1; const int dcols = l == 3 ? 1696 : 1664;
        hipLaunchKernelGGL(k_wconv, dim3(512), dim3(256), 0, stream, F(L_WIN[l]), 1024, odd ? 416 + dcols + 256 + 1280 : 4096, wi[l], odd ? PO : PE, 0, odd ? 2 : 1, dcols, F(L_NORM[l]));
        hipLaunchKernelGGL(k_wconv, dim3(160), dim3(256), 0, stream, F(L_WOUT[l]), 1280, 1024, wo[l], 1024, 0, 0, 0, (const float*)nullptr);
        hipLaunchKernelGGL(k_wconv, dim3(64), dim3(256), 0, stream, F(L_WMEM[l]), 1024, 512, wmem, 512, l * 512, 0, 0, F(3));
    }
    hipLaunchKernelGGL(k_wconv, dim3(24), dim3(256), 0, stream, F(12), 256, 768, wqb[0], 768, 0, 3, 0, F(11));
    hipLaunchKernelGGL(k_wconv, dim3(24), dim3(256), 0, stream, F(34), 256, 768, wqb[1], 768, 0, 3, 0, F(33));
    hipLaunchKernelGGL(k_wconv, dim3(16), dim3(256), 0, stream, F(14), 128, 1024, wkvb[0], 1024, 0, 0, 0, F(13));
    hipLaunchKernelGGL(k_wconv, dim3(16), dim3(256), 0, stream, F(36), 128, 1024, wkvb[1], 1024, 0, 0, 0, F(35));
    gemm_naive(stream, memb, DM, wmem, MROWS, 2048, DM, EpiMemKV{memkv, mrstd});
    for (int l = 0; l < 4; ++l) {
        const float* resid = l == 0 ? F(0) : out;
        if ((l & 1) == 0) {
            gemm_naive(stream, xb, DM, wi[l], MTOK, PE, DM, EpiEvenIn{proj, ssq, tabA, tabR});
            hipLaunchKernelGGL(k_attnA_naive, dim3(MTOK * 8 / 4), dim3(256), 0, stream, proj);
            hipLaunchKernelGGL(k_ret_naive, dim3(MTOK * 4 / 4), dim3(256), 0, stream, proj);
            hipLaunchKernelGGL(k_mem_naive, dim3(MTOK * 4 / 4), dim3(256), 0, stream, proj, PE, E_QM, E_G + 1024, memkv, l);
            gemm_naive(stream, proj + E_G, PE, wo[l], MTOK, DM, 1280, EpiWOut{resid, out, xb});
        } else {
            const int o = l >> 1;
            gemm_naive(stream, xb, DM, wi[l], MTOK, PO, DM, EpiOddIn{proj, ssq, tabM});
            hipLaunchKernelGGL(k_rowssq_bf16, dim3(MTOK / 4), dim3(256), 0, stream, proj, PO, O_CQ, 256, cqsq);
            hipLaunchKernelGGL(k_rowssq_bf16, dim3(MTOK / 4), dim3(256), 0, stream, proj, PO, O_CKV, 128, ckvsq);
            gemm_naive(stream, proj + O_CQ, PO, wqb[o], MTOK, 768, 256, EpiMlaQ{mlaq, cqsq, tabM});
            gemm_naive(stream, proj + O_CKV, PO, wkvb[o], MTOK, 1024, 128, EpiMlaKV{mlakv, ckvsq});
            hipLaunchKernelGGL(k_mla_naive, dim3(MTOK * 8 / 4), dim3(256), 0, stream, proj, mlaq, mlakv);
            RwkvW W;
            if (l == 1) W = RwkvW{F(15), F(16), F(17), F(18), F(19), nullptr, nullptr, F(20), F(21), F(22), F(23), F(24)};
            else W = RwkvW{F(37), F(38), F(39), F(40), F(41), F(42), F(43), F(44), F(45), F(46), F(47), F(48)};
            hipLaunchKernelGGL(k_rwkv_naive, dim3(BATCH * 8), dim3(64), 0, stream, proj, vfirst, W, l == 3 ? 1 : 0);
            hipLaunchKernelGGL(k_mem_naive, dim3(MTOK * 4 / 4), dim3(256), 0, stream, proj, PO, O_QM, O_G + 1024, memkv, l);
            gemm_naive(stream, proj + O_G, PO, wo[l], MTOK, DM, 1280, EpiWOut{resid, out, xb});
        }
        hipLaunchKernelGGL(k_rowssq_f32, dim3(MTOK / 4), dim3(256), 0, stream, out, ssq);
    }
    hipLaunchKernelGGL(k_final_norm, dim3(MTOK / 4), dim3(256), 0, stream, out, F(4));
}
```

```cpp
#include <hip/hip_runtime.h>
#include <hip/hip_cooperative_groups.h>
#include <stdint.h>
#include <cstdio>

typedef unsigned short bf16_t;
typedef unsigned u32x4 __attribute__((ext_vector_type(4)));
typedef float f32x4 __attribute__((ext_vector_type(4)));
#define DI __device__ __forceinline__

constexpr int BATCH = 16, SEQ = 2048, DM = 1024, MTOK = BATCH * SEQ, MEMT = 256, MROWS = BATCH * MEMT;
constexpr int PE = 4096, PO = 3840;
constexpr int E_QA = 0, E_KA = 512, E_VA = 1024, E_QR = 1536, E_KR = 1792, E_VR = 2048, E_QM = 2560, E_G = 2816;
constexpr int O_CQ = 0, O_CKV = 256, O_KR = 384, O_R = 512, O_K = 1024, O_V = 1536, O_WD = 2048, O_AD = 2112, O_MV = 2176, O_QM = 2304, O_G = 2560;
constexpr float NORM_EPS = 1e-6f, LOG2E = 1.4426950408889634f;
constexpr float QSCALE = 0.125f * LOG2E;
constexpr float QSCALE_MLA = 0.10206207261596575f * LOG2E;

constexpr size_t MiB = 1u << 20;
constexpr size_t WS_CTL = 0, WS_SSQ = 1 * MiB, WS_CQSQ = 3 * MiB, WS_CKVSQ = 3 * MiB + 512 * 1024, WS_MRSTD = 4 * MiB;
constexpr size_t WS_TABA = 8 * MiB, WS_TABR = 10 * MiB, WS_TABM = 18 * MiB;
constexpr size_t WS_WI0 = 24 * MiB, WS_WI1 = 32 * MiB, WS_WI2 = WS_WI1 + 7680 * 1024, WS_WI3 = WS_WI2 + 8 * MiB;
constexpr size_t WS_WO = 55 * MiB;
constexpr size_t WS_WMEM = 65 * MiB;
constexpr size_t WS_WQB = 69 * MiB;
constexpr size_t WS_WKVB = WS_WQB + 1024 * 1024;
constexpr size_t WS_MEMB = 72 * MiB, WS_MEMKV = 80 * MiB, WS_VFIRST = 96 * MiB, WS_XB = 128 * MiB, WS_MLAQ = 192 * MiB, WS_PROJ = 256 * MiB;
constexpr size_t WS_END = 512 * MiB;

DI int olane() { int l; asm volatile("v_and_b32 %0, 63, %1" : "=v"(l) : "v"(threadIdx.x)); return l; }
DI float bf2f(bf16_t v) { return __uint_as_float((unsigned)v << 16); }
DI bf16_t f2bf(float f) { unsigned u = __float_as_uint(f); return (bf16_t)((u + 0x7fffu + ((u >> 16) & 1u)) >> 16); }
DI unsigned pk2(float lo, float hi) { return (unsigned)f2bf(lo) | ((unsigned)f2bf(hi) << 16); }
DI float wave_sum(float v) {
#pragma unroll
    for (int o = 1; o < 64; o <<= 1) v += __shfl_xor(v, o);
    return v;
}
DI float siluf(float x) { return x / (1.f + __expf(-x)); }
DI float sigmoidf_(float x) { return 1.f / (1.f + __expf(-x)); }

DI int phys2log(int mapid, int p, int aux) {
    if (mapid == 1) {
        if (p < 1024) { const int pos = p & 63, base = p & ~63; return pos < 16 ? base + (pos & 1) * 8 + (pos >> 1) : p; }
        if (p >= 1536 && p < 2048) { const int pos = p & 63, base = p & ~63; return base + (pos & 1) * 32 + (pos >> 1); }
        return p;
    }
    if (mapid == 2) {
        if (p < 384) return p;
        if (p < 416) { const int pos = p - 384; return 384 + (pos & 1) * 16 + (pos >> 1); }
        if (p < 512) return -1;
        if (p < 2048) return 416 + (p - 512);
        if (p < 2176) return 416 + 1536 + (p - 2048);
        if (p < 2208) return aux > 1664 ? 416 + 1664 + (p - 2176) : -1;
        if (p < 2304) return -1;
        if (p < 2560) return 416 + aux + (p - 2304);
        return 416 + aux + 256 + (p - 2560);
    }
    if (mapid == 3) {
        const int hh = p >> 7, pos = p & 127;
        if (pos < 64) return hh * 96 + pos;
        if (pos >= 96) return -1;
        const int pp = pos - 64; return hh * 96 + 64 + (pp & 1) * 16 + (pp >> 1);
    }
    return p;
}


DI void wconv_job(float* scr, int gw, int ngw, int& base, const float* __restrict__ W, int K, int Nsrc, bf16_t* __restrict__ dst, int Nphys, int row_off, int mapid, int aux, const float* __restrict__ gain) {
    const int lane = olane();
    const int nblk = Nphys / 32, kblk = (K + 63) / 64, nitems = nblk * kblk;
    int first = (gw - base % ngw + ngw) % ngw; base += nitems;
    for (int item = first; item < nitems; item += ngw) {
        const int kb = item / nblk, nb = item % nblk, k0 = 64 * kb, n0 = 32 * nb;
        const int nl = phys2log(mapid, n0 + (lane & 31), aux);
#pragma unroll 8
        for (int i = 0; i < 32; ++i) {
            const int kk = 2 * i + (lane >> 5);
            float v = 0.f;
            if (nl >= 0 && k0 + kk < K) { v = W[(size_t)(k0 + kk) * Nsrc + nl]; if (gain) v *= gain[k0 + kk]; }
            scr[kk * 33 + (lane & 31)] = v;
        }
        asm volatile("s_waitcnt lgkmcnt(0)" ::: "memory");
        const int c = lane & 7;
        if (k0 + 8 * c < K) {
#pragma unroll
            for (int j = 0; j < 4; ++j) {
                const int n = (lane >> 3) + 8 * j; const float* s = scr + (8 * c) * 33 + n;
                u32x4 o; o.x = pk2(s[0], s[33]); o.y = pk2(s[66], s[99]); o.z = pk2(s[132], s[165]); o.w = pk2(s[198], s[231]);
                *(u32x4*)(dst + (size_t)(row_off + n0 + n) * K + k0 + 8 * c) = o;
            }
        }
        asm volatile("s_waitcnt lgkmcnt(0)" ::: "memory");
    }
}
DI void rows_prep(int gw, int ngw, const float* __restrict__ x, bf16_t* __restrict__ xb, float* __restrict__ stat, int R, int mode) {
    const int lane = olane();
    for (int r = gw; r < R; r += ngw) {
        const f32x4* xr = (const f32x4*)(x + (size_t)r * DM) + lane;
        float s = 0.f;
        unsigned long long* o8 = (unsigned long long*)(xb + (size_t)r * DM) + lane;
#pragma unroll
        for (int j = 0; j < 4; ++j) { const f32x4 v = xr[64 * j]; s += v.x * v.x + v.y * v.y + v.z * v.z + v.w * v.w;
            o8[64 * j] = (unsigned long long)pk2(v.x, v.y) | ((unsigned long long)pk2(v.z, v.w) << 32); }
        s = wave_sum(s);
        if (mode == 0) { if (lane < 16) stat[(size_t)r * 16 + lane] = lane == 0 ? s : 0.f; }
        else if (lane == 0) stat[r] = rsqrtf(s * (1.f / DM) + NORM_EPS);
    }
}
DI void tables_rows(int gw, int ngw, const int* __restrict__ positions, float2* __restrict__ tabA, float2* __restrict__ tabR, float2* __restrict__ tabM) {
    const int i = olane();
    float theta = 500000.f, dim = 16.f; int j = i, kind = 0;
    if (i >= 8 && i < 40) { theta = 10000.f; dim = 64.f; j = i - 8; kind = 1; }
    else if (i >= 40) { dim = 32.f; j = i - 40; kind = 2; }
    const float inv = expf((-logf(theta) * (float)(2 * j)) / dim);
    for (int row = gw; row < MTOK; row += ngw) {
        const float ang = (float)positions[row] * inv;
        float sn, cs; sincosf(ang, &sn, &cs);
        const float2 v = make_float2(cs, sn);
        if (kind == 0) tabA[(size_t)row * 8 + j] = v; else if (kind == 1) tabR[(size_t)row * 32 + j] = v; else if (i < 56) tabM[(size_t)row * 16 + j] = v;
    }
}

DI void store8(bf16_t* p, const float* v) { u32x4 o; o.x = pk2(v[0], v[1]); o.y = pk2(v[2], v[3]); o.z = pk2(v[4], v[5]); o.w = pk2(v[6], v[7]); *(u32x4*)p = o; }
DI void rot4(float* v, const float2* cs) {
#pragma unroll
    for (int j = 0; j < 4; ++j) { const float2 c = cs[j]; const float a = v[2 * j], b = v[2 * j + 1]; v[2 * j] = a * c.x - b * c.y; v[2 * j + 1] = a * c.y + b * c.x; }
}
DI float ssq16_rstd(const float* ssq, int row, float invn) {
    const f32x4* p = (const f32x4*)(ssq + (size_t)row * 16); const f32x4 a = p[0], b = p[1], c = p[2], d = p[3];
    const float s = (a.x + a.y + a.z + a.w) + (b.x + b.y + b.z + b.w) + (c.x + c.y + c.z + c.w) + (d.x + d.y + d.z + d.w);
    return rsqrtf(s * invn + NORM_EPS);
}
DI float ssq4_rstd(const float* ssq, int row, float invn) { const f32x4 a = *(const f32x4*)(ssq + (size_t)row * 4); return rsqrtf((a.x + a.y + a.z + a.w) * invn + NORM_EPS); }

struct EpiEvenIn {
    static constexpr bool HAS_SSQ = false; DI void put_ssq(int, int, int, float) const {}
    bf16_t* out; const float* ssq; const float2* tabA; const float2* tabR;
    DI float rowscale(int row) const { return ssq16_rstd(ssq, row, 1.f / DM); }
    DI float apply(int row, int c, float* v, float rs) const {
#pragma unroll
        for (int i = 0; i < 8; ++i) v[i] *= rs;
        if (c < E_VA) {
            const int pos = c & 63;
            if (pos < 16) rot4(v, tabA + (size_t)row * 8 + (pos >> 1));
            if (c < E_KA) {
#pragma unroll
                for (int i = 0; i < 8; ++i) v[i] *= QSCALE;
            }
        } else if (c >= E_QR && c < E_VR) {
            const int pos = c & 63, h = ((c - E_QR) & 255) >> 6;
            rot4(v, tabR + (size_t)row * 32 + (pos >> 1));
            const float lg = log2f(1.f - exp2f(-5.f - (float)h)), s = (float)(row & (SEQ - 1));
            const float f = c < E_KR ? exp2f(s * lg) : 0.125f * exp2f(-s * lg);
#pragma unroll
            for (int i = 0; i < 8; ++i) v[i] *= f;
        } else if (c >= E_QM && c < E_G) {
#pragma unroll
            for (int i = 0; i < 8; ++i) v[i] *= QSCALE;
        } else if (c >= E_G) {
#pragma unroll
            for (int i = 0; i < 8; ++i) v[i] = siluf(v[i]);
        }
        store8(out + (size_t)row * PE + c, v);
        return 0.f;
    }
};
struct EpiOddIn {
    static constexpr bool HAS_SSQ = true;
    bf16_t* out; const float* ssq; const float2* tabM; float* cqsq; float* ckvsq;
    DI void put_ssq(int row, int pn, int wc, float ss) const { if (pn == 0) cqsq[(size_t)row * 4 + wc] = ss; else if (pn == 1) ckvsq[(size_t)row * 4 + wc] = ss; }
    DI float rowscale(int row) const { return ssq16_rstd(ssq, row, 1.f / DM); }
    DI float apply(int row, int c, float* v, float rs) const {
        float ss = 0.f;
#pragma unroll
        for (int i = 0; i < 8; ++i) v[i] *= rs;
        if (c < O_KR) {
#pragma unroll
            for (int i = 0; i < 8; ++i) ss += v[i] * v[i];
        } else if (c < O_KR + 32) rot4(v, tabM + (size_t)row * 16 + ((c - O_KR) >> 1));
        else if (c >= O_QM && c < O_G) {
#pragma unroll
            for (int i = 0; i < 8; ++i) v[i] *= QSCALE;
        } else if (c >= O_G) {
#pragma unroll
            for (int i = 0; i < 8; ++i) v[i] = siluf(v[i]);
        }
        store8(out + (size_t)row * PO + c, v);
        return ss;
    }
};
struct EpiWOut {
    static constexpr bool HAS_SSQ = true;
    const float* resid; float* xo; bf16_t* xb; float* ssq;
    DI void put_ssq(int row, int pn, int wc, float ss) const { ssq[(size_t)row * 16 + pn * 4 + wc] = ss; }
    DI float rowscale(int) const { return 1.f; }
    DI float apply(int row, int c, float* v, float) const {
        const f32x4* r = (const f32x4*)(resid + (size_t)row * DM + c); const f32x4 r0 = r[0], r1 = r[1];
        v[0] += r0.x; v[1] += r0.y; v[2] += r0.z; v[3] += r0.w; v[4] += r1.x; v[5] += r1.y; v[6] += r1.z; v[7] += r1.w;
        f32x4* o = (f32x4*)(xo + (size_t)row * DM + c); o[0] = (f32x4){v[0], v[1], v[2], v[3]}; o[1] = (f32x4){v[4], v[5], v[6], v[7]};
        store8(xb + (size_t)row * DM + c, v);
        float ss = 0.f;
#pragma unroll
        for (int i = 0; i < 8; ++i) ss += v[i] * v[i];
        return ss;
    }
};
struct EpiMemKV {
    static constexpr bool HAS_SSQ = false; DI void put_ssq(int, int, int, float) const {}
    bf16_t* out; const float* rstd;
    DI float rowscale(int row) const { return rstd[row]; }
    DI float apply(int row, int c, float* v, float rs) const {
#pragma unroll
        for (int i = 0; i < 8; ++i) v[i] *= rs;
        store8(out + (size_t)row * 2048 + c, v); return 0.f;
    }
};
struct EpiMlaQ {
    static constexpr bool HAS_SSQ = false; DI void put_ssq(int, int, int, float) const {}
    bf16_t* out; const float* cqsq; const float2* tabM;
    DI float rowscale(int row) const { return ssq4_rstd(cqsq, row, 1.f / 256.f) * QSCALE_MLA; }
    DI float apply(int row, int c, float* v, float rs) const {
        const int pos = c & 127;
        if (pos >= 64 && pos < 96) rot4(v, tabM + (size_t)row * 16 + ((pos - 64) >> 1));
#pragma unroll
        for (int i = 0; i < 8; ++i) v[i] *= rs;
        store8(out + (size_t)row * 1024 + c, v); return 0.f;
    }
};
struct EpiMlaKV {
    static constexpr bool HAS_SSQ = false; DI void put_ssq(int, int, int, float) const {}
    bf16_t* out; const float* ckvsq;
    DI float rowscale(int row) const { return ssq4_rstd(ckvsq, row, 1.f / 128.f); }
    DI float apply(int row, int c, float* v, float rs) const {
#pragma unroll
        for (int i = 0; i < 8; ++i) v[i] *= rs;
        store8(out + (size_t)row * 1024 + c, v); return 0.f;
    }
};


namespace pg8 {
#define PG8_LAS __attribute__((address_space(3)))
typedef PG8_LAS unsigned char PG8_LAS_T;
typedef unsigned short bf16_t;
typedef short bf16x8 __attribute__((ext_vector_type(8)));
typedef float f32x4 __attribute__((ext_vector_type(4)));
typedef unsigned u32x4 __attribute__((ext_vector_type(4)));
constexpr int BM = 256, BK = 64, HALF = 128, HTB = HALF * BK * 2  , STAGE_BYTES = 8 * HTB, NXCD = 8, WGM = 8;

__host__ __device__ __forceinline__ int lds_byte(int r, int c) { const int st = (r >> 4) * 2 + (c >> 5), rr = r & 15, cc = c & 31, ob = rr * 64 + cc * 2; return st * 1024 + (ob ^ (((ob >> 9) & 1) << 5)); }
__host__ __device__ __forceinline__ void stage_rc(int b, int& R, int& C) { const int st = b / 1024, sb = b % 1024, swz = sb ^ (((sb >> 9) & 1) << 5); R = (st >> 1) * 16 + swz / 64; C = (st & 1) * 32 + (swz % 64) / 2; }
__host__ __device__ __forceinline__ int perm32(int rho) { const int n = rho >> 4, i = rho & 15; return 8 * (i >> 2) + 4 * n + (i & 3); }

struct Unit { int pm, pn; };
template <int M_, int N_, int K_, int LDA_> struct Gemm { const bf16_t* A; const bf16_t* Bt; static constexpr int M = M_, N = N_, K = K_, lda = LDA_; };

struct StaticOrder {
    int nM, nN, nwg, G, c;
    __host__ __device__ void init(int M, int N, int G_, int c_) { nM = M / BM; nN = N / BM; nwg = nM * nN; G = G_; c = c_; }
    __host__ __device__ bool next(int i, Unit& u) const {
        const long L = (long)i * G + c; if (L >= nwg) return false;
        int wgid = (int)L; { const int q = nwg / NXCD, r = nwg % NXCD, xcd = wgid % NXCD, off = wgid / NXCD; wgid = (xcd < r ? xcd * (q + 1) : r * (q + 1) + (xcd - r) * q) + off; }
        const int nig = WGM * nN, gid = wgid / nig, fm = gid * WGM, gsz = (nM - fm) < WGM ? (nM - fm) : WGM;
        u.pm = fm + ((wgid % nig) % gsz); u.pn = (wgid % nig) / gsz; return true;
    }
    __device__ __forceinline__ void a_ready(const Unit&) const {}
    __device__ __forceinline__ void done(const Unit&) const {}
};

template <class Epi, class Sched, bool ALIGN_EPI = false, bool SP2 = false, class GemmT>
__device__ __forceinline__ void gemm_phase(PG8_LAS unsigned char* lds, const GemmT g, const Sched& S, const Epi& E) {
    int tid_ = threadIdx.x; asm volatile("" : "+v"(tid_));
    const int tid = tid_, wid = __builtin_amdgcn_readfirstlane(tid >> 6), lane = tid & 63, wr = wid >> 2, wc = wid & 3, fr = lane & 15, fq = lane >> 4;
    const int K = g.K; int nt = K / BK; asm volatile("" : "+s"(nt));
    unsigned voffA[2], voffB[2];
#pragma unroll
    for (int i = 0; i < 2; ++i) { int R, C; stage_rc(tid * 16 + i * 8192, R, C); const int Rb = Epi::PERM ? ((R & ~31) + perm32(R & 31)) : R;
        voffA[i] = (unsigned)(R * g.lda + C) * 2u; voffB[i] = (unsigned)(Rb * K + C) * 2u; }
    const size_t kstep = (size_t)(BK * 2);
    const size_t hstepA = (size_t)HALF * g.lda * 2, hstepB = (size_t)HALF * K * 2;
    const size_t tstepA = 2 * hstepA, tstepB = 2 * hstepB;
    const unsigned ldsw = (unsigned)wid * 1024u;
    const int aoff = lds_byte(wr * 64 + fr, fq * 8), boff = lds_byte(wc * 32 + fr, fq * 8);
#define PG8_SA(b, h) (((b) * 2 + (h)) * HTB)
#define PG8_SB(b, h) ((4 + (b) * 2 + (h)) * HTB)
#define PG8_STAGE(bufoff, gbase, voff) do { _Pragma("unroll") for (int _i = 0; _i < 2; ++_i) \
        __builtin_amdgcn_global_load_lds((const unsigned*)((const char*)(gbase) + (voff)[_i]), (PG8_LAS unsigned*)(lds + (bufoff) + ldsw + _i * 8192), 16, 0, 0); } while (0)
#define PG8_LDA(dst, b, h) do { _Pragma("unroll") for (int m = 0; m < 4; ++m) _Pragma("unroll") for (int k = 0; k < 2; ++k) dst[m][k] = *(const PG8_LAS bf16x8*)(lds + PG8_SA(b, h) + aoff + m * 2048 + k * 1024); } while (0)
#define PG8_LDB(dst, b, h) do { _Pragma("unroll") for (int n = 0; n < 2; ++n) _Pragma("unroll") for (int k = 0; k < 2; ++k) dst[n][k] = *(const PG8_LAS bf16x8*)(lds + PG8_SB(b, h) + boff + n * 2048 + k * 1024); } while (0)
#define PG8_MMA(ai, bj, At, Bt) do { __builtin_amdgcn_s_setprio(1); _Pragma("unroll") for (int m = 0; m < 4; ++m) _Pragma("unroll") for (int n = 0; n < 2; ++n) _Pragma("unroll") for (int k = 0; k < 2; ++k) \
        acc[ai][bj][m][n] = __builtin_amdgcn_mfma_f32_16x16x32_bf16(Bt[n][k], At[m][k], acc[ai][bj][m][n], 0, 0, 0); __builtin_amdgcn_s_setprio(0); } while (0)
#define PG8_WAIT_V(n) asm volatile("s_waitcnt vmcnt(" #n ")" ::: "memory")
#define PG8_WAIT_L(n) asm volatile("s_waitcnt lgkmcnt(" #n ")" ::: "memory")
#define PG8_BAR __builtin_amdgcn_s_barrier()
#define PG8_SCHED __builtin_amdgcn_sched_barrier(0)
    Unit cur, nxt; int ui = 0;
    if (!S.next(0, cur)) return;
    f32x4 acc[2][2][4][2];
#pragma unroll
    for (int a = 0; a < 2; ++a)
#pragma unroll
        for (int b = 0; b < 2; ++b)
#pragma unroll
            for (int m = 0; m < 4; ++m)
#pragma unroll
                for (int n = 0; n < 2; ++n) acc[a][b][m][n] = (f32x4){0.f, 0.f, 0.f, 0.f};
    bf16x8 At[4][2], B0[2][2], B1[2][2];
    const char* cA = (const char*)g.A + (size_t)cur.pm * tstepA; const char* cB = (const char*)g.Bt + (size_t)cur.pn * tstepB;
    S.a_ready(cur);
    if constexpr (SP2) {
        PG8_STAGE(PG8_SB(0, 0), cB, voffB); PG8_STAGE(PG8_SB(0, 1), cB + hstepB, voffB); PG8_STAGE(PG8_SA(0, 0), cA, voffA); PG8_STAGE(PG8_SA(0, 1), cA + hstepA, voffA);
        if (wr == 1) PG8_BAR;
        PG8_WAIT_V(2); PG8_BAR;
        PG8_STAGE(PG8_SB(1, 0), cB + kstep, voffB); PG8_STAGE(PG8_SA(1, 0), cA + kstep, voffA); PG8_STAGE(PG8_SB(1, 1), cB + hstepB + kstep, voffB);
        PG8_WAIT_V(6); PG8_BAR;
    } else {
        PG8_STAGE(PG8_SB(0, 0), cB, voffB); PG8_STAGE(PG8_SA(0, 0), cA, voffA); PG8_STAGE(PG8_SB(0, 1), cB + hstepB, voffB); PG8_STAGE(PG8_SA(0, 1), cA + hstepA, voffA);
        if (wr == 1) PG8_BAR;
        PG8_WAIT_V(4); PG8_BAR;
        PG8_STAGE(PG8_SB(1, 0), cB + kstep, voffB); PG8_STAGE(PG8_SA(1, 0), cA + kstep, voffA); PG8_STAGE(PG8_SB(1, 1), cB + hstepB + kstep, voffB);
        PG8_WAIT_V(6); PG8_BAR;
    }
    for (;;) {
        const bool has_next = S.next(ui + 1, nxt);
        const char* nA = has_next ? (const char*)g.A + (size_t)nxt.pm * tstepA : cA; const char* nB = has_next ? (const char*)g.Bt + (size_t)nxt.pn * tstepB : cB;
        for (int t = 0; t < nt; t += 2) {
            const bool last = (t == nt - 2);
            const char* a1 = cA + (size_t)(t + 1) * kstep;
            const char* a2 = last ? nA : cA + (size_t)(t + 2) * kstep; const char* b2 = last ? nB : cB + (size_t)(t + 2) * kstep;
            const char* a3 = a2 + kstep; const char* b3 = b2 + kstep;
            if (last && has_next) S.a_ready(nxt);
            if constexpr (SP2) {
            PG8_LDB(B0, 0, 0); PG8_LDB(B1, 0, 1); PG8_SCHED; PG8_LDA(At, 0, 0); PG8_STAGE(PG8_SA(1, 1), a1 + hstepA, voffA);
            PG8_WAIT_V(8); PG8_WAIT_L(0); PG8_BAR; PG8_MMA(0, 0, At, B0); PG8_MMA(0, 1, At, B1); PG8_BAR; PG8_SCHED;
            PG8_LDA(At, 0, 1); PG8_STAGE(PG8_SB(0, 0), b2, voffB); PG8_STAGE(PG8_SB(0, 1), b2 + hstepB, voffB); PG8_STAGE(PG8_SA(0, 0), a2, voffA);
            PG8_WAIT_V(8); PG8_WAIT_L(0); PG8_BAR; PG8_MMA(1, 0, At, B0); PG8_MMA(1, 1, At, B1); PG8_BAR; PG8_SCHED;
            PG8_LDB(B0, 1, 0); PG8_LDB(B1, 1, 1); PG8_SCHED; PG8_LDA(At, 1, 0); PG8_STAGE(PG8_SA(0, 1), a2 + hstepA, voffA);
            PG8_WAIT_V(8); PG8_WAIT_L(0); PG8_BAR; PG8_MMA(0, 0, At, B0); PG8_MMA(0, 1, At, B1); PG8_BAR; PG8_SCHED;
            PG8_LDA(At, 1, 1); PG8_STAGE(PG8_SB(1, 0), b3, voffB); PG8_STAGE(PG8_SB(1, 1), b3 + hstepB, voffB); PG8_STAGE(PG8_SA(1, 0), a3, voffA);
            PG8_WAIT_V(8); PG8_WAIT_L(0); PG8_BAR; PG8_MMA(1, 0, At, B0); PG8_MMA(1, 1, At, B1); PG8_BAR; PG8_SCHED;
            } else {
            PG8_LDB(B0, 0, 0); PG8_SCHED; PG8_LDA(At, 0, 0); PG8_STAGE(PG8_SA(1, 1), a1 + hstepA, voffA);
            PG8_WAIT_L(8); PG8_BAR; PG8_WAIT_L(0); PG8_MMA(0, 0, At, B0); PG8_BAR; PG8_SCHED;
            PG8_LDB(B1, 0, 1); PG8_STAGE(PG8_SB(0, 0), b2, voffB);
            PG8_BAR; PG8_WAIT_L(0); PG8_MMA(0, 1, At, B1); PG8_BAR;
            PG8_LDA(At, 0, 1); PG8_STAGE(PG8_SA(0, 0), a2, voffA);
            PG8_BAR; PG8_WAIT_L(0); PG8_MMA(1, 0, At, B0); PG8_BAR; PG8_SCHED;
            PG8_STAGE(PG8_SB(0, 1), b2 + hstepB, voffB);
            PG8_WAIT_V(6); PG8_BAR; PG8_MMA(1, 1, At, B1); PG8_BAR;
            PG8_LDB(B0, 1, 0); PG8_SCHED; PG8_LDA(At, 1, 0); PG8_STAGE(PG8_SA(0, 1), a2 + hstepA, voffA);
            PG8_WAIT_L(8); PG8_BAR; PG8_WAIT_L(0); PG8_MMA(0, 0, At, B0); PG8_BAR; PG8_SCHED;
            PG8_LDB(B1, 1, 1); PG8_STAGE(PG8_SB(1, 0), b3, voffB);
            PG8_BAR; PG8_WAIT_L(0); PG8_MMA(0, 1, At, B1); PG8_BAR;
            PG8_LDA(At, 1, 1); PG8_STAGE(PG8_SA(1, 0), a3, voffA);
            PG8_BAR; PG8_WAIT_L(0); PG8_MMA(1, 0, At, B0); PG8_BAR; PG8_SCHED;
            PG8_STAGE(PG8_SB(1, 1), b3 + hstepB, voffB);
            PG8_WAIT_V(6); PG8_BAR; PG8_MMA(1, 1, At, B1); PG8_BAR;
            }
        }
        if constexpr (ALIGN_EPI) { if (wr == 0) PG8_BAR; }
        if constexpr (!Epi::AFTER_DRAIN) { E(acc, cur, wr, wc, fr, fq); S.done(cur); }
        if (!has_next) break;
#pragma unroll
        for (int a = 0; a < 2; ++a)
#pragma unroll
            for (int b = 0; b < 2; ++b)
#pragma unroll
                for (int m = 0; m < 4; ++m)
#pragma unroll
                    for (int n = 0; n < 2; ++n) acc[a][b][m][n] = (f32x4){0.f, 0.f, 0.f, 0.f};
        cur = nxt; cA = nA; cB = nB; ++ui;
        if constexpr (ALIGN_EPI) { if (wr == 1) PG8_BAR; }
    }
    PG8_WAIT_V(0);
    if constexpr (!ALIGN_EPI) { if (wr == 0) PG8_BAR; }
    PG8_BAR;
    if constexpr (Epi::AFTER_DRAIN) { E.fused(acc, cur, wr, wc, fr, fq, lds, wid, lane); S.done(cur); }
#undef PG8_SA
#undef PG8_SB
#undef PG8_STAGE
#undef PG8_LDA
#undef PG8_LDB
#undef PG8_MMA
#undef PG8_WAIT_V
#undef PG8_WAIT_L
#undef PG8_BAR
#undef PG8_SCHED
}
}

DI void attnA_naive_item(bf16_t* __restrict__ proj, int item) {
    const int lane = olane();
    const int row = item >> 3, h = item & 7, b = row >> 11, s = row & (SEQ - 1);
    const float q = bf2f(proj[(size_t)row * PE + E_QA + h * 64 + lane]);
    float lse[3], o[3];
#pragma unroll
    for (int p = 0; p < 3; ++p) {
        const int dil = p == 0 ? 1 : (p == 1 ? 4 : 16);
        const int ls = s / dil, r = s % dil, j0 = ls - 128 < 0 ? 0 : ls - 128;
        float m = -INFINITY, l = 0.f, acc = 0.f;
        for (int j = j0; j <= ls; ++j) {
            const size_t kr = (size_t)(b * SEQ + j * dil + r) * PE;
            const float sc = wave_sum(q * bf2f(proj[kr + E_KA + h * 64 + lane]));
            const float vv = bf2f(proj[kr + E_VA + h * 64 + lane]);
            const float mn = fmaxf(m, sc), al = exp2f(m - mn), pp = exp2f(sc - mn);
            l = l * al + pp; acc = acc * al + pp * vv; m = mn;
        }
        lse[p] = m + log2f(l); o[p] = acc / l;
    }
    const float mx = fmaxf(lse[0], fmaxf(lse[1], lse[2]));
    const float w0 = exp2f(lse[0] - mx), w1 = exp2f(lse[1] - mx), w2 = exp2f(lse[2] - mx);
    const float out = (w0 * o[0] + w1 * o[1] + w2 * o[2]) / (w0 + w1 + w2);
    bf16_t* g = proj + (size_t)row * PE + E_G + h * 64 + lane;
    *g = f2bf(out * bf2f(*g));
}
DI void ret_naive_item(bf16_t* __restrict__ proj, int item) {
    const int lane = olane();
    const int row = item >> 2, h = item & 3, b = row >> 11, s = row & (SEQ - 1);
    const float q = bf2f(proj[(size_t)row * PE + E_QR + h * 64 + lane]);
    float o0 = 0.f, o1 = 0.f;
    for (int j = 0; j <= s; ++j) {
        const size_t kr = (size_t)(b * SEQ + j) * PE;
        const float sc = wave_sum(q * bf2f(proj[kr + E_KR + h * 64 + lane]));
        o0 += sc * bf2f(proj[kr + E_VR + h * 128 + lane]); o1 += sc * bf2f(proj[kr + E_VR + h * 128 + 64 + lane]);
    }
    const float rn = rsqrtf(wave_sum(o0 * o0 + o1 * o1) * (1.f / 128.f) + NORM_EPS);
    bf16_t* g = proj + (size_t)row * PE + E_G + 512 + h * 128 + lane;
    g[0] = f2bf(o0 * rn * bf2f(g[0])); g[64] = f2bf(o1 * rn * bf2f(g[64]));
}
DI void mem_naive_item(bf16_t* __restrict__ proj, int pitch, int qcol, int gcol, const bf16_t* __restrict__ memkv, int layer, int item) {
    const int lane = olane();
    const int row = item >> 2, h = item & 3, b = row >> 11;
    const float q = bf2f(proj[(size_t)row * pitch + qcol + h * 64 + lane]);
    float m = -INFINITY, l = 0.f, acc = 0.f;
    for (int j = 0; j < MEMT; ++j) {
        const bf16_t* kv = memkv + (size_t)(b * MEMT + j) * 2048 + layer * 512 + h * 64 + lane;
        const float sc = wave_sum(q * bf2f(kv[0])), vv = bf2f(kv[256]);
        const float mn = fmaxf(m, sc), al = exp2f(m - mn), pp = exp2f(sc - mn);
        l = l * al + pp; acc = acc * al + pp * vv; m = mn;
    }
    bf16_t* g = proj + (size_t)row * pitch + gcol + h * 64 + lane;
    *g = f2bf(acc / l * bf2f(*g));
}
DI void mla_naive_item(bf16_t* __restrict__ proj, const bf16_t* __restrict__ mq, const bf16_t* __restrict__ mkv, int item) {
    const int lane = olane();
    const int row = item >> 3, h = item & 7, b = row >> 11, s = row & (SEQ - 1);
    const float qn = bf2f(mq[(size_t)row * 1024 + h * 128 + lane]);
    const float qr = lane < 32 ? bf2f(mq[(size_t)row * 1024 + h * 128 + 64 + lane]) : 0.f;
    float m = -INFINITY, l = 0.f, acc = 0.f;
    for (int j = 0; j <= s; ++j) {
        const size_t kr = (size_t)(b * SEQ + j);
        float pr = qn * bf2f(mkv[kr * 1024 + h * 128 + lane]);
        if (lane < 32) pr += qr * bf2f(proj[kr * PO + O_KR + lane]);
        const float sc = wave_sum(pr), vv = bf2f(mkv[kr * 1024 + h * 128 + 64 + lane]);
        const float mn = fmaxf(m, sc), al = exp2f(m - mn), pp = exp2f(sc - mn);
        l = l * al + pp; acc = acc * al + pp * vv; m = mn;
    }
    bf16_t* g = proj + (size_t)row * PO + O_G + h * 64 + lane;
    *g = f2bf(acc / l * bf2f(*g));
}
struct RwkvW { const float *mu, *w0, *w2, *a0, *a2, *v0, *v2, *k_k, *k_a, *r_k, *lnx_w, *lnx_b; };
#define WAVE_LDS_FENCE() asm volatile("s_waitcnt lgkmcnt(0)" ::: "memory")
DI void rwkv_naive_unit(float* sh  , bf16_t* __restrict__ proj, bf16_t* __restrict__ vfirst, const RwkvW& W, int vres, int unit) {
    const int lane = olane(), b = unit >> 3, h = unit & 7, hc = h * 64 + lane;
    float S[64];
#pragma unroll
    for (int k = 0; k < 64; ++k) S[k] = 0.f;
    float pr = 0.f, pk = 0.f, pv = 0.f, pwd = 0.f, pad = 0.f, pmv = 0.f;
    const float mu_r = W.mu[hc], mu_k = W.mu[512 + hc], mu_v = W.mu[1024 + hc], mu_wd = W.mu[1536 + lane], mu_ad = W.mu[1600 + lane];
    const float mu_mv = (vres && lane < 32) ? W.mu[1664 + lane] : 0.f;
    const float w0 = W.w0[hc], a0 = W.a0[hc], v0 = vres ? W.v0[hc] : 0.f, k_k = W.k_k[hc], k_a = W.k_a[hc], r_k = W.r_k[hc], lw = W.lnx_w[hc], lb = W.lnx_b[hc];
    for (int t = 0; t < SEQ; ++t) {
        const size_t row = (size_t)b * SEQ + t; const bf16_t* pr_ = proj + row * PO;
        const float xr = bf2f(pr_[O_R + hc]), xk = bf2f(pr_[O_K + hc]), xv = bf2f(pr_[O_V + hc]), xwd = bf2f(pr_[O_WD + lane]), xad = bf2f(pr_[O_AD + lane]);
        const float xmv = (vres && lane < 32) ? bf2f(pr_[O_MV + lane]) : 0.f;
        const float rs = xr + (pr - xr) * mu_r, ks = xk + (pk - xk) * mu_k, vs = xv + (pv - xv) * mu_v;
        const float wds = xwd + (pwd - xwd) * mu_wd, ads = xad + (pad - xad) * mu_ad, mvs = xmv + (pmv - xmv) * mu_mv;
        pr = xr; pk = xk; pv = xv; pwd = xwd; pad = xad; pmv = xmv;
        WAVE_LDS_FENCE();
        sh[0 * 64 + lane] = tanhf(wds); sh[1 * 64 + lane] = ads; sh[2 * 64 + lane] = mvs;
        WAVE_LDS_FENCE();
        float pw = w0, pa = a0, pvv = v0;
#pragma unroll 4
        for (int j = 0; j < 64; ++j) { pw += sh[j] * W.w2[j * 512 + hc]; pa += sh[64 + j] * W.a2[j * 512 + hc]; }
        if (vres) {
#pragma unroll 4
            for (int j = 0; j < 32; ++j) pvv += sh[128 + j] * W.v2[j * 512 + hc];
        }
        const float z = -pw, sp = fmaxf(z, 0.f) + log1pf(expf(-fabsf(z)));
        const float dec = expf(-expf(-sp - 0.5f));
        const float a = sigmoidf_(pa);
        float vv = vs;
        if (vres) vv = vs + (bf2f(vfirst[row * 512 + hc]) - vs) * sigmoidf_(pvv); else vfirst[row * 512 + hc] = f2bf(vs);
        float kk = ks * k_k; const float nrm = sqrtf(wave_sum(kk * kk)); kk = kk / fmaxf(nrm, 1e-12f);
        const float kx = ks * (1.f + (a - 1.f) * k_a);
        sh[3 * 64 + lane] = -kk; sh[4 * 64 + lane] = kk * a; sh[5 * 64 + lane] = dec; sh[6 * 64 + lane] = kx; sh[7 * 64 + lane] = rs;
        WAVE_LDS_FENCE();
        float sa = 0.f;
#pragma unroll
        for (int k = 0; k < 64; ++k) { sa += S[k] * sh[3 * 64 + k]; if ((k & 7) == 7) asm volatile("" ::: "memory"); }
        float y = 0.f;
#pragma unroll
        for (int k = 0; k < 64; ++k) { S[k] = S[k] * sh[5 * 64 + k] + sa * sh[4 * 64 + k] + vv * sh[6 * 64 + k]; y += S[k] * sh[7 * 64 + k]; if ((k & 3) == 3) asm volatile("" ::: "memory"); }
        const float mean = wave_sum(y) * (1.f / 64.f), dy = y - mean, var = wave_sum(dy * dy) * (1.f / 64.f);
        const float yn = dy * rsqrtf(var + 64e-5f) * lw + lb;
        const float bonus = wave_sum(rs * kx * r_k) * vv;
        bf16_t* g = proj + row * PO + O_G + 512 + hc;
        *g = f2bf((yn + bonus) * bf2f(*g));
    }
}
DI void final_norm_rows(int gw, int ngw, float* __restrict__ x, const float* __restrict__ g) {
    const int lane = olane();
    for (int r = gw; r < MTOK; r += ngw) {
        f32x4* xr = (f32x4*)(x + (size_t)r * DM) + lane; const f32x4* gr = (const f32x4*)g + lane;
        f32x4 v[4]; float s = 0.f;
#pragma unroll
        for (int j = 0; j < 4; ++j) { v[j] = xr[64 * j]; s += v[j].x * v[j].x + v[j].y * v[j].y + v[j].z * v[j].z + v[j].w * v[j].w; }
        const float rn = rsqrtf(wave_sum(s) * (1.f / DM) + NORM_EPS);
#pragma unroll
        for (int j = 0; j < 4; ++j) { const f32x4 gg = gr[64 * j]; xr[64 * j] = (f32x4){v[j].x * rn * gg.x, v[j].y * rn * gg.y, v[j].z * rn * gg.z, v[j].w * rn * gg.w}; }
    }
}

constexpr int NWAVES = 8, LDS_BYTES = 147456, GRID = 256;
template <class E> struct PgEpi {
    static constexpr bool PERM = true, AFTER_DRAIN = false;
    E e;
    DI void operator()(const pg8::f32x4 (&acc)[2][2][4][2], const pg8::Unit& u, int wr, int wc, int fr, int fq) const {
        const int row0 = u.pm * 256 + wr * 64 + fr, col0 = u.pn * 256 + wc * 32 + 8 * fq;
#pragma unroll
        for (int ai = 0; ai < 2; ++ai)
#pragma unroll
            for (int m = 0; m < 4; ++m) {
                const int row = row0 + ai * 128 + m * 16;
                const float rs = e.rowscale(row);
                float ss = 0.f;
#pragma unroll
                for (int bj = 0; bj < 2; ++bj) {
                    const pg8::f32x4 a0 = acc[ai][bj][m][0], a1 = acc[ai][bj][m][1];
                    float v[8] = {a0[0], a0[1], a0[2], a0[3], a1[0], a1[1], a1[2], a1[3]};
                    ss += e.apply(row, col0 + bj * 128, v, rs);
                }
                if (E::HAS_SSQ) { ss += __shfl_xor(ss, 16); ss += __shfl_xor(ss, 32); if (fq == 0) e.put_ssq(row, u.pn, wc, ss); }
                asm volatile("" ::: "memory");
            }
    }
};
template <int M, int N, int K, int LDA, class E> DI void run_gemm(pg8::PG8_LAS_T* lds, const bf16_t* A, const bf16_t* Bt, const E& e) {
    int bid = blockIdx.x; asm volatile("" : "+s"(bid));
    pg8::Gemm<M, N, K, LDA> g{A, Bt}; pg8::StaticOrder S; S.init(M, N, GRID, bid);
    PgEpi<E> pe{e};
    pg8::gemm_phase<PgEpi<E>, pg8::StaticOrder, true, true>(lds, g, S, pe);
}

namespace cg = cooperative_groups;

struct Args { const void* in[51]; float* out; unsigned char* ws; };
static_assert(sizeof(Args) == 53 * 8, "no padding");

__global__ void __launch_bounds__(NWAVES * 64, 2) mega(Args a) {
    extern __shared__ __attribute__((aligned(16))) unsigned char lds[];
    cg::grid_group grid = cg::this_grid();
    const int tid = threadIdx.x, wave = __builtin_amdgcn_readfirstlane(tid >> 6);
    const int G = gridDim.x, gw = blockIdx.x * NWAVES + wave, ngw = G * NWAVES;
    pg8::PG8_LAS_T* lds3 = (pg8::PG8_LAS_T*)lds;
#define WSB() ({ unsigned char* p_ = a.ws; asm volatile("" : "+s"(p_)); p_; })
#define ws WSB()
#define out ({ float* o_ = a.out; asm volatile("" : "+s"(o_)); o_; })
#define ssq ((float*)(ws + WS_SSQ))
#define cqsq ((float*)(ws + WS_CQSQ))
#define ckvsq ((float*)(ws + WS_CKVSQ))
#define mrstd ((float*)(ws + WS_MRSTD))
#define tabA ((float2*)(ws + WS_TABA))
#define tabR ((float2*)(ws + WS_TABR))
#define tabM ((float2*)(ws + WS_TABM))
#define wmem ((bf16_t*)(ws + WS_WMEM))
#define memb ((bf16_t*)(ws + WS_MEMB))
#define memkv ((bf16_t*)(ws + WS_MEMKV))
#define vfirst ((bf16_t*)(ws + WS_VFIRST))
#define xb ((bf16_t*)(ws + WS_XB))
#define mlakv ((bf16_t*)(ws + WS_XB))
#define mlaq ((bf16_t*)(ws + WS_MLAQ))
#define proj ((bf16_t*)(ws + WS_PROJ))
    const void* const* kin = (const void* const*)__builtin_amdgcn_kernarg_segment_ptr();
#define FIN(i) ((const float*)kin[i])
#define WI(l) ((bf16_t*)(ws + ((l) == 0 ? WS_WI0 : (l) == 1 ? WS_WI1 : (l) == 2 ? WS_WI2 : WS_WI3)))
#define WO(l) ((bf16_t*)(ws + WS_WO + (size_t)(l) * 2560 * 1024))
#define WQB(o) ((bf16_t*)(ws + WS_WQB + (size_t)(o) * 512 * 1024))
#define WKVB(o) ((bf16_t*)(ws + WS_WKVB + (size_t)(o) * 256 * 1024))

    {
        float* scr = (float*)lds + wave * (64 * 33);
        int base = 0;
#pragma unroll 1
        for (int l = 0; l < 4; ++l) {
            const bool odd = l & 1; const int dcols = l == 3 ? 1696 : 1664;
            const int i_norm = l == 0 ? 5 : l == 1 ? 9 : l == 2 ? 27 : 31, i_win = i_norm + 1;
            const int i_wmem = l == 0 ? 7 : l == 1 ? 25 : l == 2 ? 29 : 49, i_wout = i_wmem + 1;
            wconv_job(scr, gw, ngw, base, FIN(i_win), 1024, odd ? 416 + dcols + 256 + 1280 : 4096, WI(l), odd ? PO : PE, 0, odd ? 2 : 1, dcols, FIN(i_norm));
            wconv_job(scr, gw, ngw, base, FIN(i_wout), 1280, 1024, WO(l), 1024, 0, 0, 0, (const float*)nullptr);
            wconv_job(scr, gw, ngw, base, FIN(i_wmem), 1024, 512, wmem, 512, l * 512, 0, 0, FIN(3));
        }
#pragma unroll 1
        for (int o = 0; o < 2; ++o) {
            wconv_job(scr, gw, ngw, base, FIN(o ? 34 : 12), 256, 768, WQB(o), 1024, 0, 3, 0, FIN(o ? 33 : 11));
            wconv_job(scr, gw, ngw, base, FIN(o ? 36 : 14), 128, 1024, WKVB(o), 1024, 0, 0, 0, FIN(o ? 35 : 13));
        }
        tables_rows(gw, ngw, (const int*)kin[2], tabA, tabR, tabM);
        rows_prep(gw, ngw, FIN(0), xb, ssq, MTOK, 0);
        rows_prep(gw, ngw, FIN(1), memb, mrstd, MROWS, 1);
    }
    grid.sync();
    run_gemm<MROWS, 2048, DM, DM>(lds3, memb, wmem, EpiMemKV{memkv, mrstd});
#pragma unroll 1
    for (int l = 0; l < 4; ++l) {
        const float* resid = l == 0 ? FIN(0) : out;
        const int i_wmem = l == 0 ? 7 : l == 1 ? 25 : l == 2 ? 29 : 49;
        if ((l & 1) == 0) {
            run_gemm<MTOK, PE, DM, DM>(lds3, xb, WI(l), EpiEvenIn{proj, ssq, tabA, tabR});
            grid.sync();
            for (int it = gw; it < MTOK * 8; it += ngw) attnA_naive_item(proj, it);
            for (int it = gw; it < MTOK * 4; it += ngw) ret_naive_item(proj, it);
            for (int it = gw; it < MTOK * 4; it += ngw) mem_naive_item(proj, PE, E_QM, E_G + 1024, memkv, l, it);
            grid.sync();
            run_gemm<MTOK, DM, 1280, PE>(lds3, proj + E_G, WO(l), EpiWOut{resid, out, xb, ssq});
            grid.sync();
        } else {
            const int o = l >> 1;
            run_gemm<MTOK, PO, DM, DM>(lds3, xb, WI(l), EpiOddIn{proj, ssq, tabM, cqsq, ckvsq});
            grid.sync();
            run_gemm<MTOK, 1024, 256, PO>(lds3, proj + O_CQ, WQB(o), EpiMlaQ{mlaq, cqsq, tabM});
            run_gemm<MTOK, 1024, 128, PO>(lds3, proj + O_CKV, WKVB(o), EpiMlaKV{mlakv, ckvsq});
            grid.sync();
            if (blockIdx.x < 128 && wave == 0) {
                RwkvW W;
                if (l == 1) W = RwkvW{FIN(15), FIN(16), FIN(17), FIN(18), FIN(19), nullptr, nullptr, FIN(20), FIN(21), FIN(22), FIN(23), FIN(24)};
                else W = RwkvW{FIN(37), FIN(38), FIN(39), FIN(40), FIN(41), FIN(42), FIN(43), FIN(44), FIN(45), FIN(46), FIN(47), FIN(48)};
                rwkv_naive_unit((float*)lds, proj, vfirst, W, l == 3 ? 1 : 0, (int)blockIdx.x);
            }
            for (int it = gw; it < MTOK * 8; it += ngw) mla_naive_item(proj, mlaq, mlakv, it);
            for (int it = gw; it < MTOK * 4; it += ngw) mem_naive_item(proj, PO, O_QM, O_G + 1024, memkv, l, it);
            grid.sync();
            run_gemm<MTOK, DM, 1280, PO>(lds3, proj + O_G, WO(l), EpiWOut{resid, out, xb, ssq});
            grid.sync();
        }
    }
    final_norm_rows(gw, ngw, out, FIN(4));
}

#undef WSB
#undef ws
#undef out
#undef ssq
#undef cqsq
#undef ckvsq
#undef mrstd
#undef tabA
#undef tabR
#undef tabM
#undef wmem
#undef memb
#undef memkv
#undef vfirst
#undef xb
#undef mlakv
#undef mlaq
#undef proj
#undef FIN
#undef WI
#undef WO
#undef WQB
#undef WKVB
extern "C" void kernel_launch(void* const* d_in, const int* in_sizes, int n_in, void* d_out, int out_size, void* d_ws, size_t ws_size, hipStream_t stream) {
    static int grid = 0;
    if (grid == 0) {
        if (n_in != 51 || ws_size < WS_END) { fprintf(stderr, "kernel_launch: unexpected n_in %d / ws %zu\n", n_in, ws_size); grid = -1; return; }
        int dev = 0, cus = 0, per_cu = 0;
        hipGetDevice(&dev); hipDeviceGetAttribute(&cus, hipDeviceAttributeMultiprocessorCount, dev);
        hipFuncSetAttribute((const void*)mega, hipFuncAttributeMaxDynamicSharedMemorySize, LDS_BYTES);
        hipOccupancyMaxActiveBlocksPerMultiprocessor(&per_cu, (const void*)mega, NWAVES * 64, LDS_BYTES);
        if (per_cu < 1) { fprintf(stderr, "kernel_launch: occupancy query says %d blocks per CU\n", per_cu); per_cu = 1; }
        if (cus * per_cu < GRID) { fprintf(stderr, "kernel_launch: device holds %d x %d workgroups, kernel is built for %d\n", cus, per_cu, GRID); grid = -1; return; }
        grid = GRID;
    }
    if (grid < 0) return;
    Args a{};
    for (int i = 0; i < 51; ++i) a.in[i] = d_in[i];
    a.out = (float*)d_out; a.ws = (unsigned char*)d_ws;
    void* args[] = {&a};
    hipError_t e = hipLaunchCooperativeKernel((const void*)mega, dim3(grid), dim3(NWAVES * 64), args, LDS_BYTES, stream);
    if (e != hipSuccess) fprintf(stderr, "cooperative launch failed: %s (grid %d)\n", hipGetErrorString(e), grid);
}
```

```cpp
#include <hip/hip_runtime.h>
#include <hip/hip_cooperative_groups.h>
#include <stdint.h>
#include <cstdio>

typedef unsigned short bf16_t;
typedef unsigned u32x4 __attribute__((ext_vector_type(4)));
typedef float f32x4 __attribute__((ext_vector_type(4)));
#define DI __device__ __forceinline__

constexpr int BATCH = 16, SEQ = 2048, DM = 1024, MTOK = BATCH * SEQ, MEMT = 256, MROWS = BATCH * MEMT;
constexpr int PE = 4096, PO = 3840;
constexpr int E_QA = 0, E_KA = 512, E_VA = 1024, E_QR = 1536, E_KR = 1792, E_VR = 2048, E_QM = 2560, E_G = 2816;
constexpr int O_CQ = 0, O_CKV = 256, O_KR = 384, O_R = 512, O_K = 1024, O_V = 1536, O_WD = 2048, O_AD = 2112, O_MV = 2176, O_QM = 2304, O_G = 2560;
constexpr float NORM_EPS = 1e-6f, LOG2E = 1.4426950408889634f;
constexpr float QSCALE = 0.125f * LOG2E;
constexpr float QSCALE_MLA = 0.10206207261596575f * LOG2E;

constexpr size_t MiB = 1u << 20;
constexpr size_t WS_CTL = 0, WS_SSQ = 1 * MiB, WS_CQSQ = 3 * MiB, WS_CKVSQ = 3 * MiB + 512 * 1024, WS_MRSTD = 4 * MiB;
constexpr size_t WS_TABA = 8 * MiB, WS_TABR = 10 * MiB, WS_TABM = 18 * MiB;
constexpr size_t WS_WI0 = 24 * MiB, WS_WI1 = 32 * MiB, WS_WI2 = WS_WI1 + 7680 * 1024, WS_WI3 = WS_WI2 + 8 * MiB;
constexpr size_t WS_WO = 55 * MiB;
constexpr size_t WS_WMEM = 65 * MiB;
constexpr size_t WS_WQB = 69 * MiB;
constexpr size_t WS_WKVB = WS_WQB + 1024 * 1024;
constexpr size_t WS_MEMB = 72 * MiB, WS_MEMKV = 80 * MiB, WS_VFIRST = 96 * MiB, WS_XB = 128 * MiB, WS_MLAQ = 192 * MiB, WS_PROJ = 256 * MiB;
constexpr size_t WS_END = 512 * MiB;

DI int olane() { int l; asm volatile("v_and_b32 %0, 63, %1" : "=v"(l) : "v"(threadIdx.x)); return l; }
DI float bf2f(bf16_t v) { return __uint_as_float((unsigned)v << 16); }
DI bf16_t f2bf(float f) { unsigned u = __float_as_uint(f); return (bf16_t)((u + 0x7fffu + ((u >> 16) & 1u)) >> 16); }
DI unsigned pk2(float lo, float hi) { return (unsigned)f2bf(lo) | ((unsigned)f2bf(hi) << 16); }
DI float wave_sum(float v) {
#pragma unroll
    for (int o = 1; o < 64; o <<= 1) v += __shfl_xor(v, o);
    return v;
}
DI float siluf(float x) { return x / (1.f + __expf(-x)); }
DI float sigmoidf_(float x) { return 1.f / (1.f + __expf(-x)); }

DI int phys2log(int mapid, int p, int aux) {
    if (mapid == 1) {
        if (p < 1024) { const int pos = p & 63, base = p & ~63; return pos < 16 ? base + (pos & 1) * 8 + (pos >> 1) : p; }
        if (p >= 1536 && p < 2048) { const int pos = p & 63, base = p & ~63; return base + (pos & 1) * 32 + (pos >> 1); }
        return p;
    }
    if (mapid == 2) {
        if (p < 384) return p;
        if (p < 416) { const int pos = p - 384; return 384 + (pos & 1) * 16 + (pos >> 1); }
        if (p < 512) return -1;
        if (p < 2048) return 416 + (p - 512);
        if (p < 2176) return 416 + 1536 + (p - 2048);
        if (p < 2208) return aux > 1664 ? 416 + 1664 + (p - 2176) : -1;
        if (p < 2304) return -1;
        if (p < 2560) return 416 + aux + (p - 2304);
        return 416 + aux + 256 + (p - 2560);
    }
    if (mapid == 3) {
        const int hh = p >> 7, pos = p & 127;
        if (pos < 64) return hh * 96 + pos;
        if (pos >= 96) return -1;
        const int pp = pos - 64; return hh * 96 + 64 + (pp & 1) * 16 + (pp >> 1);
    }
    return p;
}


DI void wconv_job(float* scr, int gw, int ngw, int& base, const float* __restrict__ W, int K, int Nsrc, bf16_t* __restrict__ dst, int Nphys, int row_off, int mapid, int aux, const float* __restrict__ gain) {
    const int lane = olane();
    const int nblk = Nphys / 32, kblk = (K + 63) / 64, nitems = nblk * kblk;
    int first = (gw - base % ngw + ngw) % ngw; base += nitems;
    for (int item = first; item < nitems; item += ngw) {
        const int kb = item / nblk, nb = item % nblk, k0 = 64 * kb, n0 = 32 * nb;
        const int nl = phys2log(mapid, n0 + (lane & 31), aux);
#pragma unroll 8
        for (int i = 0; i < 32; ++i) {
            const int kk = 2 * i + (lane >> 5);
            float v = 0.f;
            if (nl >= 0 && k0 + kk < K) { v = W[(size_t)(k0 + kk) * Nsrc + nl]; if (gain) v *= gain[k0 + kk]; }
            scr[kk * 33 + (lane & 31)] = v;
        }
        asm volatile("s_waitcnt lgkmcnt(0)" ::: "memory");
        const int c = lane & 7;
        if (k0 + 8 * c < K) {
#pragma unroll
            for (int j = 0; j < 4; ++j) {
                const int n = (lane >> 3) + 8 * j; const float* s = scr + (8 * c) * 33 + n;
                u32x4 o; o.x = pk2(s[0], s[33]); o.y = pk2(s[66], s[99]); o.z = pk2(s[132], s[165]); o.w = pk2(s[198], s[231]);
                *(u32x4*)(dst + (size_t)(row_off + n0 + n) * K + k0 + 8 * c) = o;
            }
        }
        asm volatile("s_waitcnt lgkmcnt(0)" ::: "memory");
    }
}
DI void rows_prep(int gw, int ngw, const float* __restrict__ x, bf16_t* __restrict__ xb, float* __restrict__ stat, int R, int mode) {
    const int lane = olane();
    for (int r = gw; r < R; r += ngw) {
        const f32x4* xr = (const f32x4*)(x + (size_t)r * DM) + lane;
        float s = 0.f;
        unsigned long long* o8 = (unsigned long long*)(xb + (size_t)r * DM) + lane;
#pragma unroll
        for (int j = 0; j < 4; ++j) { const f32x4 v = xr[64 * j]; s += v.x * v.x + v.y * v.y + v.z * v.z + v.w * v.w;
            o8[64 * j] = (unsigned long long)pk2(v.x, v.y) | ((unsigned long long)pk2(v.z, v.w) << 32); }
        s = wave_sum(s);
        if (mode == 0) { if (lane < 16) stat[(size_t)r * 16 + lane] = lane == 0 ? s : 0.f; }
        else if (lane == 0) stat[r] = rsqrtf(s * (1.f / DM) + NORM_EPS);
    }
}
DI void tables_rows(int gw, int ngw, const int* __restrict__ positions, float2* __restrict__ tabA, float2* __restrict__ tabR, float2* __restrict__ tabM) {
    const int i = olane();
    float theta = 500000.f, dim = 16.f; int j = i, kind = 0;
    if (i >= 8 && i < 40) { theta = 10000.f; dim = 64.f; j = i - 8; kind = 1; }
    else if (i >= 40) { dim = 32.f; j = i - 40; kind = 2; }
    const float inv = expf((-logf(theta) * (float)(2 * j)) / dim);
    for (int row = gw; row < MTOK; row += ngw) {
        const float ang = (float)positions[row] * inv;
        float sn, cs; sincosf(ang, &sn, &cs);
        const float2 v = make_float2(cs, sn);
        if (kind == 0) tabA[(size_t)row * 8 + j] = v; else if (kind == 1) tabR[(size_t)row * 32 + j] = v; else if (i < 56) tabM[(size_t)row * 16 + j] = v;
    }
}

DI void store8(bf16_t* p, const float* v) { u32x4 o; o.x = pk2(v[0], v[1]); o.y = pk2(v[2], v[3]); o.z = pk2(v[4], v[5]); o.w = pk2(v[6], v[7]); *(u32x4*)p = o; }
DI void rot4(float* v, const float2* cs) {
#pragma unroll
    for (int j = 0; j < 4; ++j) { const float2 c = cs[j]; const float a = v[2 * j], b = v[2 * j + 1]; v[2 * j] = a * c.x - b * c.y; v[2 * j + 1] = a * c.y + b * c.x; }
}
DI float ssq16_rstd(const float* ssq, int row, float invn) {
    const f32x4* p = (const f32x4*)(ssq + (size_t)row * 16); const f32x4 a = p[0], b = p[1], c = p[2], d = p[3];
    const float s = (a.x + a.y + a.z + a.w) + (b.x + b.y + b.z + b.w) + (c.x + c.y + c.z + c.w) + (d.x + d.y + d.z + d.w);
    return rsqrtf(s * invn + NORM_EPS);
}
DI float ssq4_rstd(const float* ssq, int row, float invn) { const f32x4 a = *(const f32x4*)(ssq + (size_t)row * 4); return rsqrtf((a.x + a.y + a.z + a.w) * invn + NORM_EPS); }

struct EpiEvenIn {
    static constexpr bool HAS_SSQ = false; DI void put_ssq(int, int, int, float) const {}
    bf16_t* out; const float* ssq; const float2* tabA; const float2* tabR;
    DI float rowscale(int row) const { return ssq16_rstd(ssq, row, 1.f / DM); }
    DI float apply(int row, int c, float* v, float rs) const {
#pragma unroll
        for (int i = 0; i < 8; ++i) v[i] *= rs;
        if (c < E_VA) {
            const int pos = c & 63;
            if (pos < 16) rot4(v, tabA + (size_t)row * 8 + (pos >> 1));
            if (c < E_KA) {
#pragma unroll
                for (int i = 0; i < 8; ++i) v[i] *= QSCALE;
            }
        } else if (c >= E_QR && c < E_VR) {
            const int pos = c & 63, h = ((c - E_QR) & 255) >> 6;
            rot4(v, tabR + (size_t)row * 32 + (pos >> 1));
            const float lg = log2f(1.f - exp2f(-5.f - (float)h)), s = (float)(row & (SEQ - 1));
            const float f = c < E_KR ? exp2f(s * lg) : 0.125f * exp2f(-s * lg);
#pragma unroll
            for (int i = 0; i < 8; ++i) v[i] *= f;
        } else if (c >= E_QM && c < E_G) {
#pragma unroll
            for (int i = 0; i < 8; ++i) v[i] *= QSCALE;
        } else if (c >= E_G) {
#pragma unroll
            for (int i = 0; i < 8; ++i) v[i] = siluf(v[i]);
        }
        store8(out + (size_t)row * PE + c, v);
        return 0.f;
    }
};
struct EpiOddIn {
    static constexpr bool HAS_SSQ = true;
    bf16_t* out; const float* ssq; const float2* tabM; float* cqsq; float* ckvsq;
    DI void put_ssq(int row, int pn, int wc, float ss) const { if (pn == 0) cqsq[(size_t)row * 4 + wc] = ss; else if (pn == 1) ckvsq[(size_t)row * 4 + wc] = ss; }
    DI float rowscale(int row) const { return ssq16_rstd(ssq, row, 1.f / DM); }
    DI float apply(int row, int c, float* v, float rs) const {
        float ss = 0.f;
#pragma unroll
        for (int i = 0; i < 8; ++i) v[i] *= rs;
        if (c < O_KR) {
#pragma unroll
            for (int i = 0; i < 8; ++i) ss += v[i] * v[i];
        } else if (c < O_KR + 32) rot4(v, tabM + (size_t)row * 16 + ((c - O_KR) >> 1));
        else if (c >= O_QM && c < O_G) {
#pragma unroll
            for (int i = 0; i < 8; ++i) v[i] *= QSCALE;
        } else if (c >= O_G) {
#pragma unroll
            for (int i = 0; i < 8; ++i) v[i] = siluf(v[i]);
        }
        store8(out + (size_t)row * PO + c, v);
        return ss;
    }
};
struct EpiWOut {
    static constexpr bool HAS_SSQ = true;
    const float* resid; float* xo; bf16_t* xb; float* ssq;
    DI void put_ssq(int row, int pn, int wc, float ss) const { ssq[(size_t)row * 16 + pn * 4 + wc] = ss; }
    DI float rowscale(int) const { return 1.f; }
    DI float apply(int row, int c, float* v, float) const {
        const f32x4* r = (const f32x4*)(resid + (size_t)row * DM + c); const f32x4 r0 = r[0], r1 = r[1];
        v[0] += r0.x; v[1] += r0.y; v[2] += r0.z; v[3] += r0.w; v[4] += r1.x; v[5] += r1.y; v[6] += r1.z; v[7] += r1.w;
        f32x4* o = (f32x4*)(xo + (size_t)row * DM + c); o[0] = (f32x4){v[0], v[1], v[2], v[3]}; o[1] = (f32x4){v[4], v[5], v[6], v[7]};
        store8(xb + (size_t)row * DM + c, v);
        float ss = 0.f;
#pragma unroll
        for (int i = 0; i < 8; ++i) ss += v[i] * v[i];
        return ss;
    }
};
struct EpiMemKV {
    static constexpr bool HAS_SSQ = false; DI void put_ssq(int, int, int, float) const {}
    bf16_t* out; const float* rstd;
    DI float rowscale(int row) const { return rstd[row]; }
    DI float apply(int row, int c, float* v, float rs) const {
#pragma unroll
        for (int i = 0; i < 8; ++i) v[i] *= rs;
        store8(out + (size_t)row * 2048 + c, v); return 0.f;
    }
};
struct EpiMlaQ {
    static constexpr bool HAS_SSQ = false; DI void put_ssq(int, int, int, float) const {}
    bf16_t* out; const float* cqsq; const float2* tabM;
    DI float rowscale(int row) const { return ssq4_rstd(cqsq, row, 1.f / 256.f) * QSCALE_MLA; }
    DI float apply(int row, int c, float* v, float rs) const {
        const int pos = c & 127;
        if (pos >= 64 && pos < 96) rot4(v, tabM + (size_t)row * 16 + ((pos - 64) >> 1));
#pragma unroll
        for (int i = 0; i < 8; ++i) v[i] *= rs;
        store8(out + (size_t)row * 1024 + c, v); return 0.f;
    }
};
struct EpiMlaKV {
    static constexpr bool HAS_SSQ = false; DI void put_ssq(int, int, int, float) const {}
    bf16_t* out; const float* ckvsq;
    DI float rowscale(int row) const { return ssq4_rstd(ckvsq, row, 1.f / 128.f); }
    DI float apply(int row, int c, float* v, float rs) const {
#pragma unroll
        for (int i = 0; i < 8; ++i) v[i] *= rs;
        store8(out + (size_t)row * 1024 + c, v); return 0.f;
    }
};


namespace pg8 {
#define PG8_LAS __attribute__((address_space(3)))
typedef PG8_LAS unsigned char PG8_LAS_T;
typedef unsigned short bf16_t;
typedef short bf16x8 __attribute__((ext_vector_type(8)));
typedef float f32x4 __attribute__((ext_vector_type(4)));
typedef unsigned u32x4 __attribute__((ext_vector_type(4)));
constexpr int BM = 256, BK = 64, HALF = 128, HTB = HALF * BK * 2  , STAGE_BYTES = 8 * HTB, NXCD = 8, WGM = 8;

__host__ __device__ __forceinline__ int lds_byte(int r, int c) { const int st = (r >> 4) * 2 + (c >> 5), rr = r & 15, cc = c & 31, ob = rr * 64 + cc * 2; return st * 1024 + (ob ^ (((ob >> 9) & 1) << 5)); }
__host__ __device__ __forceinline__ void stage_rc(int b, int& R, int& C) { const int st = b / 1024, sb = b % 1024, swz = sb ^ (((sb >> 9) & 1) << 5); R = (st >> 1) * 16 + swz / 64; C = (st & 1) * 32 + (swz % 64) / 2; }
__host__ __device__ __forceinline__ int perm32(int rho) { const int n = rho >> 4, i = rho & 15; return 8 * (i >> 2) + 4 * n + (i & 3); }

struct Unit { int pm, pn; };
template <int M_, int N_, int K_, int LDA_> struct Gemm { const bf16_t* A; const bf16_t* Bt; static constexpr int M = M_, N = N_, K = K_, lda = LDA_; };

struct StaticOrder {
    int nM, nN, nwg, G, c;
    __host__ __device__ void init(int M, int N, int G_, int c_) { nM = M / BM; nN = N / BM; nwg = nM * nN; G = G_; c = c_; }
    __host__ __device__ bool next(int i, Unit& u) const {
        const long L = (long)i * G + c; if (L >= nwg) return false;
        int wgid = (int)L; { const int q = nwg / NXCD, r = nwg % NXCD, xcd = wgid % NXCD, off = wgid / NXCD; wgid = (xcd < r ? xcd * (q + 1) : r * (q + 1) + (xcd - r) * q) + off; }
        const int nig = WGM * nN, gid = wgid / nig, fm = gid * WGM, gsz = (nM - fm) < WGM ? (nM - fm) : WGM;
        u.pm = fm + ((wgid % nig) % gsz); u.pn = (wgid % nig) / gsz; return true;
    }
    __device__ __forceinline__ void a_ready(const Unit&) const {}
    __device__ __forceinline__ void done(const Unit&) const {}
};

template <class Epi, class Sched, bool ALIGN_EPI = false, bool SP2 = false, class GemmT>
__device__ __forceinline__ void gemm_phase(PG8_LAS unsigned char* lds, const GemmT g, const Sched& S, const Epi& E) {
    int tid_ = threadIdx.x; asm volatile("" : "+v"(tid_));
    const int tid = tid_, wid = __builtin_amdgcn_readfirstlane(tid >> 6), lane = tid & 63, wr = wid >> 2, wc = wid & 3, fr = lane & 15, fq = lane >> 4;
    const int K = g.K; int nt = K / BK; asm volatile("" : "+s"(nt));
    unsigned voffA[2], voffB[2];
#pragma unroll
    for (int i = 0; i < 2; ++i) { int R, C; stage_rc(tid * 16 + i * 8192, R, C); const int Rb = Epi::PERM ? ((R & ~31) + perm32(R & 31)) : R;
        voffA[i] = (unsigned)(R * g.lda + C) * 2u; voffB[i] = (unsigned)(Rb * K + C) * 2u; }
    const size_t kstep = (size_t)(BK * 2);
    const size_t hstepA = (size_t)HALF * g.lda * 2, hstepB = (size_t)HALF * K * 2;
    const size_t tstepA = 2 * hstepA, tstepB = 2 * hstepB;
    const unsigned ldsw = (unsigned)wid * 1024u;
    const int aoff = lds_byte(wr * 64 + fr, fq * 8), boff = lds_byte(wc * 32 + fr, fq * 8);
#define PG8_SA(b, h) (((b) * 2 + (h)) * HTB)
#define PG8_SB(b, h) ((4 + (b) * 2 + (h)) * HTB)
#define PG8_STAGE(bufoff, gbase, voff) do { _Pragma("unroll") for (int _i = 0; _i < 2; ++_i) \
        __builtin_amdgcn_global_load_lds((const unsigned*)((const char*)(gbase) + (voff)[_i]), (PG8_LAS unsigned*)(lds + (bufoff) + ldsw + _i * 8192), 16, 0, 0); } while (0)
#define PG8_LDA(dst, b, h) do { _Pragma("unroll") for (int m = 0; m < 4; ++m) _Pragma("unroll") for (int k = 0; k < 2; ++k) dst[m][k] = *(const PG8_LAS bf16x8*)(lds + PG8_SA(b, h) + aoff + m * 2048 + k * 1024); } while (0)
#define PG8_LDB(dst, b, h) do { _Pragma("unroll") for (int n = 0; n < 2; ++n) _Pragma("unroll") for (int k = 0; k < 2; ++k) dst[n][k] = *(const PG8_LAS bf16x8*)(lds + PG8_SB(b, h) + boff + n * 2048 + k * 1024); } while (0)
#define PG8_MMA(ai, bj, At, Bt) do { __builtin_amdgcn_s_setprio(1); _Pragma("unroll") for (int m = 0; m < 4; ++m) _Pragma("unroll") for (int n = 0; n < 2; ++n) _Pragma("unroll") for (int k = 0; k < 2; ++k) \
        acc[ai][bj][m][n] = __builtin_amdgcn_mfma_f32_16x16x32_bf16(Bt[n][k], At[m][k], acc[ai][bj][m][n], 0, 0, 0); __builtin_amdgcn_s_setprio(0); } while (0)
#define PG8_WAIT_V(n) asm volatile("s_waitcnt vmcnt(" #n ")" ::: "memory")
#define PG8_WAIT_L(n) asm volatile("s_waitcnt lgkmcnt(" #n ")" ::: "memory")
#define PG8_BAR __builtin_amdgcn_s_barrier()
#define PG8_SCHED __builtin_amdgcn_sched_barrier(0)
    Unit cur, nxt; int ui = 0;
    if (!S.next(0, cur)) return;
    f32x4 acc[2][2][4][2];
#pragma unroll
    for (int a = 0; a < 2; ++a)
#pragma unroll
        for (int b = 0; b < 2; ++b)
#pragma unroll
            for (int m = 0; m < 4; ++m)
#pragma unroll
                for (int n = 0; n < 2; ++n) acc[a][b][m][n] = (f32x4){0.f, 0.f, 0.f, 0.f};
    bf16x8 At[4][2], B0[2][2], B1[2][2];
    const char* cA = (const char*)g.A + (size_t)cur.pm * tstepA; const char* cB = (const char*)g.Bt + (size_t)cur.pn * tstepB;
    S.a_ready(cur);
    if constexpr (SP2) {
        PG8_STAGE(PG8_SB(0, 0), cB, voffB); PG8_STAGE(PG8_SB(0, 1), cB + hstepB, voffB); PG8_STAGE(PG8_SA(0, 0), cA, voffA); PG8_STAGE(PG8_SA(0, 1), cA + hstepA, voffA);
        if (wr == 1) PG8_BAR;
        PG8_WAIT_V(2); PG8_BAR;
        PG8_STAGE(PG8_SB(1, 0), cB + kstep, voffB); PG8_STAGE(PG8_SA(1, 0), cA + kstep, voffA); PG8_STAGE(PG8_SB(1, 1), cB + hstepB + kstep, voffB);
        PG8_WAIT_V(6); PG8_BAR;
    } else {
        PG8_STAGE(PG8_SB(0, 0), cB, voffB); PG8_STAGE(PG8_SA(0, 0), cA, voffA); PG8_STAGE(PG8_SB(0, 1), cB + hstepB, voffB); PG8_STAGE(PG8_SA(0, 1), cA + hstepA, voffA);
        if (wr == 1) PG8_BAR;
        PG8_WAIT_V(4); PG8_BAR;
        PG8_STAGE(PG8_SB(1, 0), cB + kstep, voffB); PG8_STAGE(PG8_SA(1, 0), cA + kstep, voffA); PG8_STAGE(PG8_SB(1, 1), cB + hstepB + kstep, voffB);
        PG8_WAIT_V(6); PG8_BAR;
    }
    for (;;) {
        const bool has_next = S.next(ui + 1, nxt);
        const char* nA = has_next ? (const char*)g.A + (size_t)nxt.pm * tstepA : cA; const char* nB = has_next ? (const char*)g.Bt + (size_t)nxt.pn * tstepB : cB;
        for (int t = 0; t < nt; t += 2) {
            const bool last = (t == nt - 2);
            const char* a1 = cA + (size_t)(t + 1) * kstep;
            const char* a2 = last ? nA : cA + (size_t)(t + 2) * kstep; const char* b2 = last ? nB : cB + (size_t)(t + 2) * kstep;
            const char* a3 = a2 + kstep; const char* b3 = b2 + kstep;
            if (last && has_next) S.a_ready(nxt);
            if constexpr (SP2) {
            PG8_LDB(B0, 0, 0); PG8_LDB(B1, 0, 1); PG8_SCHED; PG8_LDA(At, 0, 0); PG8_STAGE(PG8_SA(1, 1), a1 + hstepA, voffA);
            PG8_WAIT_V(8); PG8_WAIT_L(0); PG8_BAR; PG8_MMA(0, 0, At, B0); PG8_MMA(0, 1, At, B1); PG8_BAR; PG8_SCHED;
            PG8_LDA(At, 0, 1); PG8_STAGE(PG8_SB(0, 0), b2, voffB); PG8_STAGE(PG8_SB(0, 1), b2 + hstepB, voffB); PG8_STAGE(PG8_SA(0, 0), a2, voffA);
            PG8_WAIT_V(8); PG8_WAIT_L(0); PG8_BAR; PG8_MMA(1, 0, At, B0); PG8_MMA(1, 1, At, B1); PG8_BAR; PG8_SCHED;
            PG8_LDB(B0, 1, 0); PG8_LDB(B1, 1, 1); PG8_SCHED; PG8_LDA(At, 1, 0); PG8_STAGE(PG8_SA(0, 1), a2 + hstepA, voffA);
            PG8_WAIT_V(8); PG8_WAIT_L(0); PG8_BAR; PG8_MMA(0, 0, At, B0); PG8_MMA(0, 1, At, B1); PG8_BAR; PG8_SCHED;
            PG8_LDA(At, 1, 1); PG8_STAGE(PG8_SB(1, 0), b3, voffB); PG8_STAGE(PG8_SB(1, 1), b3 + hstepB, voffB); PG8_STAGE(PG8_SA(1, 0), a3, voffA);
            PG8_WAIT_V(8); PG8_WAIT_L(0); PG8_BAR; PG8_MMA(1, 0, At, B0); PG8_MMA(1, 1, At, B1); PG8_BAR; PG8_SCHED;
            } else {
            PG8_LDB(B0, 0, 0); PG8_SCHED; PG8_LDA(At, 0, 0); PG8_STAGE(PG8_SA(1, 1), a1 + hstepA, voffA);
            PG8_WAIT_L(8); PG8_BAR; PG8_WAIT_L(0); PG8_MMA(0, 0, At, B0); PG8_BAR; PG8_SCHED;
            PG8_LDB(B1, 0, 1); PG8_STAGE(PG8_SB(0, 0), b2, voffB);
            PG8_BAR; PG8_WAIT_L(0); PG8_MMA(0, 1, At, B1); PG8_BAR;
            PG8_LDA(At, 0, 1); PG8_STAGE(PG8_SA(0, 0), a2, voffA);
            PG8_BAR; PG8_WAIT_L(0); PG8_MMA(1, 0, At, B0); PG8_BAR; PG8_SCHED;
            PG8_STAGE(PG8_SB(0, 1), b2 + hstepB, voffB);
            PG8_WAIT_V(6); PG8_BAR; PG8_MMA(1, 1, At, B1); PG8_BAR;
            PG8_LDB(B0, 1, 0); PG8_SCHED; PG8_LDA(At, 1, 0); PG8_STAGE(PG8_SA(0, 1), a2 + hstepA, voffA);
            PG8_WAIT_L(8); PG8_BAR; PG8_WAIT_L(0); PG8_MMA(0, 0, At, B0); PG8_BAR; PG8_SCHED;
            PG8_LDB(B1, 1, 1); PG8_STAGE(PG8_SB(1, 0), b3, voffB);
            PG8_BAR; PG8_WAIT_L(0); PG8_MMA(0, 1, At, B1); PG8_BAR;
            PG8_LDA(At, 1, 1); PG8_STAGE(PG8_SA(1, 0), a3, voffA);
            PG8_BAR; PG8_WAIT_L(0); PG8_MMA(1, 0, At, B0); PG8_BAR; PG8_SCHED;
            PG8_STAGE(PG8_SB(1, 1), b3 + hstepB, voffB);
            PG8_WAIT_V(6); PG8_BAR; PG8_MMA(1, 1, At, B1); PG8_BAR;
            }
        }
        if constexpr (ALIGN_EPI) { if (wr == 0) PG8_BAR; }
        if constexpr (!Epi::AFTER_DRAIN) { E(acc, cur, wr, wc, fr, fq); S.done(cur); }
        if (!has_next) break;
#pragma unroll
        for (int a = 0; a < 2; ++a)
#pragma unroll
            for (int b = 0; b < 2; ++b)
#pragma unroll
                for (int m = 0; m < 4; ++m)
#pragma unroll
                    for (int n = 0; n < 2; ++n) acc[a][b][m][n] = (f32x4){0.f, 0.f, 0.f, 0.f};
        cur = nxt; cA = nA; cB = nB; ++ui;
        if constexpr (ALIGN_EPI) { if (wr == 1) PG8_BAR; }
    }
    PG8_WAIT_V(0);
    if constexpr (!ALIGN_EPI) { if (wr == 0) PG8_BAR; }
    PG8_BAR;
    if constexpr (Epi::AFTER_DRAIN) { E.fused(acc, cur, wr, wc, fr, fq, lds, wid, lane); S.done(cur); }
#undef PG8_SA
#undef PG8_SB
#undef PG8_STAGE
#undef PG8_LDA
#undef PG8_LDB
#undef PG8_MMA
#undef PG8_WAIT_V
#undef PG8_WAIT_L
#undef PG8_BAR
#undef PG8_SCHED
}
}

DI void attnA_naive_item(bf16_t* __restrict__ proj, int item) {
    const int lane = olane();
    const int row = item >> 3, h = item & 7, b = row >> 11, s = row & (SEQ - 1);
    const float q = bf2f(proj[(size_t)row * PE + E_QA + h * 64 + lane]);
    float lse[3], o[3];
#pragma unroll
    for (int p = 0; p < 3; ++p) {
        const int dil = p == 0 ? 1 : (p == 1 ? 4 : 16);
        const int ls = s / dil, r = s % dil, j0 = ls - 128 < 0 ? 0 : ls - 128;
        float m = -INFINITY, l = 0.f, acc = 0.f;
        for (int j = j0; j <= ls; ++j) {
            const size_t kr = (size_t)(b * SEQ + j * dil + r) * PE;
            const float sc = wave_sum(q * bf2f(proj[kr + E_KA + h * 64 + lane]));
            const float vv = bf2f(proj[kr + E_VA + h * 64 + lane]);
            const float mn = fmaxf(m, sc), al = exp2f(m - mn), pp = exp2f(sc - mn);
            l = l * al + pp; acc = acc * al + pp * vv; m = mn;
        }
        lse[p] = m + log2f(l); o[p] = acc / l;
    }
    const float mx = fmaxf(lse[0], fmaxf(lse[1], lse[2]));
    const float w0 = exp2f(lse[0] - mx), w1 = exp2f(lse[1] - mx), w2 = exp2f(lse[2] - mx);
    const float out = (w0 * o[0] + w1 * o[1] + w2 * o[2]) / (w0 + w1 + w2);
    bf16_t* g = proj + (size_t)row * PE + E_G + h * 64 + lane;
    *g = f2bf(out * bf2f(*g));
}
DI void ret_naive_item(bf16_t* __restrict__ proj, int item) {
    const int lane = olane();
    const int row = item >> 2, h = item & 3, b = row >> 11, s = row & (SEQ - 1);
    const float q = bf2f(proj[(size_t)row * PE + E_QR + h * 64 + lane]);
    float o0 = 0.f, o1 = 0.f;
    for (int j = 0; j <= s; ++j) {
        const size_t kr = (size_t)(b * SEQ + j) * PE;
        const float sc = wave_sum(q * bf2f(proj[kr + E_KR + h * 64 + lane]));
        o0 += sc * bf2f(proj[kr + E_VR + h * 128 + lane]); o1 += sc * bf2f(proj[kr + E_VR + h * 128 + 64 + lane]);
    }
    const float rn = rsqrtf(wave_sum(o0 * o0 + o1 * o1) * (1.f / 128.f) + NORM_EPS);
    bf16_t* g = proj + (size_t)row * PE + E_G + 512 + h * 128 + lane;
    g[0] = f2bf(o0 * rn * bf2f(g[0])); g[64] = f2bf(o1 * rn * bf2f(g[64]));
}
DI void mem_naive_item(bf16_t* __restrict__ proj, int pitch, int qcol, int gcol, const bf16_t* __restrict__ memkv, int layer, int item) {
    const int lane = olane();
    const int row = item >> 2, h = item & 3, b = row >> 11;
    const float q = bf2f(proj[(size_t)row * pitch + qcol + h * 64 + lane]);
    float m = -INFINITY, l = 0.f, acc = 0.f;
    for (int j = 0; j < MEMT; ++j) {
        const bf16_t* kv = memkv + (size_t)(b * MEMT + j) * 2048 + layer * 512 + h * 64 + lane;
        const float sc = wave_sum(q * bf2f(kv[0])), vv = bf2f(kv[256]);
        const float mn = fmaxf(m, sc), al = exp2f(m - mn), pp = exp2f(sc - mn);
        l = l * al + pp; acc = acc * al + pp * vv; m = mn;
    }
    bf16_t* g = proj + (size_t)row * pitch + gcol + h * 64 + lane;
    *g = f2bf(acc / l * bf2f(*g));
}
DI void mla_naive_item(bf16_t* __restrict__ proj, const bf16_t* __restrict__ mq, const bf16_t* __restrict__ mkv, int item) {
    const int lane = olane();
    const int row = item >> 3, h = item & 7, b = row >> 11, s = row & (SEQ - 1);
    const float qn = bf2f(mq[(size_t)row * 1024 + h * 128 + lane]);
    const float qr = lane < 32 ? bf2f(mq[(size_t)row * 1024 + h * 128 + 64 + lane]) : 0.f;
    float m = -INFINITY, l = 0.f, acc = 0.f;
    for (int j = 0; j <= s; ++j) {
        const size_t kr = (size_t)(b * SEQ + j);
        float pr = qn * bf2f(mkv[kr * 1024 + h * 128 + lane]);
        if (lane < 32) pr += qr * bf2f(proj[kr * PO + O_KR + lane]);
        const float sc = wave_sum(pr), vv = bf2f(mkv[kr * 1024 + h * 128 + 64 + lane]);
        const float mn = fmaxf(m, sc), al = exp2f(m - mn), pp = exp2f(sc - mn);
        l = l * al + pp; acc = acc * al + pp * vv; m = mn;
    }
    bf16_t* g = proj + (size_t)row * PO + O_G + h * 64 + lane;
    *g = f2bf(acc / l * bf2f(*g));
}
struct RwkvW { const float *mu, *w0, *w2, *a0, *a2, *v0, *v2, *k_k, *k_a, *r_k, *lnx_w, *lnx_b; };
#define WAVE_LDS_FENCE() asm volatile("s_waitcnt lgkmcnt(0)" ::: "memory")
DI void rwkv_naive_unit(float* sh  , bf16_t* __restrict__ proj, bf16_t* __restrict__ vfirst, const RwkvW& W, int vres, int unit) {
    const int lane = olane(), b = unit >> 3, h = unit & 7, hc = h * 64 + lane;
    float S[64];
#pragma unroll
    for (int k = 0; k < 64; ++k) S[k] = 0.f;
    float pr = 0.f, pk = 0.f, pv = 0.f, pwd = 0.f, pad = 0.f, pmv = 0.f;
    const float mu_r = W.mu[hc], mu_k = W.mu[512 + hc], mu_v = W.mu[1024 + hc], mu_wd = W.mu[1536 + lane], mu_ad = W.mu[1600 + lane];
    const float mu_mv = (vres && lane < 32) ? W.mu[1664 + lane] : 0.f;
    const float w0 = W.w0[hc], a0 = W.a0[hc], v0 = vres ? W.v0[hc] : 0.f, k_k = W.k_k[hc], k_a = W.k_a[hc], r_k = W.r_k[hc], lw = W.lnx_w[hc], lb = W.lnx_b[hc];
    for (int t = 0; t < SEQ; ++t) {
        const size_t row = (size_t)b * SEQ + t; const bf16_t* pr_ = proj + row * PO;
        const float xr = bf2f(pr_[O_R + hc]), xk = bf2f(pr_[O_K + hc]), xv = bf2f(pr_[O_V + hc]), xwd = bf2f(pr_[O_WD + lane]), xad = bf2f(pr_[O_AD + lane]);
        const float xmv = (vres && lane < 32) ? bf2f(pr_[O_MV + lane]) : 0.f;
        const float rs = xr + (pr - xr) * mu_r, ks = xk + (pk - xk) * mu_k, vs = xv + (pv - xv) * mu_v;
        const float wds = xwd + (pwd - xwd) * mu_wd, ads = xad + (pad - xad) * mu_ad, mvs = xmv + (pmv - xmv) * mu_mv;
        pr = xr; pk = xk; pv = xv; pwd = xwd; pad = xad; pmv = xmv;
        WAVE_LDS_FENCE();
        sh[0 * 64 + lane] = tanhf(wds); sh[1 * 64 + lane] = ads; sh[2 * 64 + lane] = mvs;
        WAVE_LDS_FENCE();
        float pw = w0, pa = a0, pvv = v0;
#pragma unroll 4
        for (int j = 0; j < 64; ++j) { pw += sh[j] * W.w2[j * 512 + hc]; pa += sh[64 + j] * W.a2[j * 512 + hc]; }
        if (vres) {
#pragma unroll 4
            for (int j = 0; j < 32; ++j) pvv += sh[128 + j] * W.v2[j * 512 + hc];
        }
        const float z = -pw, sp = fmaxf(z, 0.f) + log1pf(expf(-fabsf(z)));
        const float dec = expf(-expf(-sp - 0.5f));
        const float a = sigmoidf_(pa);
        float vv = vs;
        if (vres) vv = vs + (bf2f(vfirst[row * 512 + hc]) - vs) * sigmoidf_(pvv); else vfirst[row * 512 + hc] = f2bf(vs);
        float kk = ks * k_k; const float nrm = sqrtf(wave_sum(kk * kk)); kk = kk / fmaxf(nrm, 1e-12f);
        const float kx = ks * (1.f + (a - 1.f) * k_a);
        sh[3 * 64 + lane] = -kk; sh[4 * 64 + lane] = kk * a; sh[5 * 64 + lane] = dec; sh[6 * 64 + lane] = kx; sh[7 * 64 + lane] = rs;
        WAVE_LDS_FENCE();
        float sa = 0.f;
#pragma unroll
        for (int k = 0; k < 64; ++k) { sa += S[k] * sh[3 * 64 + k]; if ((k & 7) == 7) asm volatile("" ::: "memory"); }
        float y = 0.f;
#pragma unroll
        for (int k = 0; k < 64; ++k) { S[k] = S[k] * sh[5 * 64 + k] + sa * sh[4 * 64 + k] + vv * sh[6 * 64 + k]; y += S[k] * sh[7 * 64 + k]; if ((k & 3) == 3) asm volatile("" ::: "memory"); }
        const float mean = wave_sum(y) * (1.f / 64.f), dy = y - mean, var = wave_sum(dy * dy) * (1.f / 64.f);
        const float yn = dy * rsqrtf(var + 64e-5f) * lw + lb;
        const float bonus = wave_sum(rs * kx * r_k) * vv;
        bf16_t* g = proj + row * PO + O_G + 512 + hc;
        *g = f2bf((yn + bonus) * bf2f(*g));
    }
}
DI void final_norm_rows(int gw, int ngw, float* __restrict__ x, const float* __restrict__ g) {
    const int lane = olane();
    for (int r = gw; r < MTOK; r += ngw) {
        f32x4* xr = (f32x4*)(x + (size_t)r * DM) + lane; const f32x4* gr = (const f32x4*)g + lane;
        f32x4 v[4]; float s = 0.f;
#pragma unroll
        for (int j = 0; j < 4; ++j) { v[j] = xr[64 * j]; s += v[j].x * v[j].x + v[j].y * v[j].y + v[j].z * v[j].z + v[j].w * v[j].w; }
        const float rn = rsqrtf(wave_sum(s) * (1.f / DM) + NORM_EPS);
#pragma unroll
        for (int j = 0; j < 4; ++j) { const f32x4 gg = gr[64 * j]; xr[64 * j] = (f32x4){v[j].x * rn * gg.x, v[j].y * rn * gg.y, v[j].z * rn * gg.z, v[j].w * rn * gg.w}; }
    }
}

typedef short bf16x8 __attribute__((ext_vector_type(8)));
typedef short s16x4 __attribute__((ext_vector_type(4)));
typedef float f32x16 __attribute__((ext_vector_type(16)));
#define LAS __attribute__((address_space(3)))
DI int crow(int r, int hi) { return (r & 3) + 8 * (r >> 2) + 4 * hi; }
DI s16x4 vtr(const LAS unsigned char* p) { return __builtin_bit_cast(s16x4, __builtin_amdgcn_ds_read_tr16_b64_v4i16((LAS s16x4*)p)); }
DI unsigned cvtpk(float lo, float hi) { typedef float f2 __attribute__((ext_vector_type(2))); typedef __bf16 b2 __attribute__((ext_vector_type(2))); f2 v = {lo, hi}; return __builtin_bit_cast(unsigned, __builtin_convertvector(v, b2)); }

struct KVSrc {
    const bf16_t* k; const bf16_t* k2; const bf16_t* v; int ldk, ldk2, ldv, kstride, koff, jmax;
};
struct MaskBand { DI bool operator()(int qi, int kj) const { return kj >= 0 && kj <= qi && qi - kj <= 128; } };
struct MaskDil4 { DI bool operator()(int qi, int kj) const { return kj <= qi && ((qi - kj) & 3) == 0; } };
struct MaskCausal { DI bool operator()(int qi, int kj) const { return kj <= qi; } };
struct MaskNone { DI bool operator()(int, int) const { return true; } };

template <int NDQ, int NDB, bool SOFTMAX> struct AttnWave {
    bf16x8 qf[NDQ]; f32x16 o[NDB]; float m, l;
    DI void init() {
#pragma unroll
        for (int d = 0; d < NDB; ++d)
#pragma unroll
            for (int r = 0; r < 16; ++r) o[d][r] = 0.f;
        m = -INFINITY; l = 0.f;
    }
    template <int NDQ1, class Mask> DI void segment(LAS unsigned char* vbuf, const KVSrc& S, int k0, int t0, int t1, int tf0, int tf1, int qi, const Mask& mask, int lane) {
        if (t0 >= t1) return;
        const int r32 = lane & 31, hi = lane >> 5;
        constexpr int VCH = NDB * 4;
        constexpr int VLD = NDB * 2;
        const int vrow = lane / VCH, vch = lane % VCH;
        const int vdst = (vch >> 2) * 2048 + vrow * 64 + (vch & 3) * 16;
        const LAS unsigned char* vb = vbuf + (4 * hi + ((lane & 15) >> 2)) * 64 + ((lane >> 4) & 1) * 32 + (lane & 3) * 8;
        bf16x8 kf[NDQ], kfn[NDQ]; u32x4 vr[VLD], vrn[VLD];
        auto loadk = [&](bf16x8 (&dst)[NDQ], int t) {
            int j = k0 + 32 * t + r32; j = j < 0 ? 0 : (j > S.jmax ? S.jmax : j);
            const size_t row = (size_t)(j * S.kstride + S.koff);
#pragma unroll
            for (int d = 0; d < NDQ; ++d) dst[d] = d < NDQ1 ? *(const bf16x8*)(S.k + row * S.ldk + 16 * d + 8 * hi) : *(const bf16x8*)(S.k2 + row * S.ldk2 + 16 * (d - NDQ1) + 8 * hi);
        };
        auto loadv = [&](u32x4 (&dst)[VLD], int t) {
#pragma unroll
            for (int i = 0; i < VLD; ++i) { int j = k0 + 32 * t + vrow + (64 / VCH) * i; j = j < 0 ? 0 : (j > S.jmax ? S.jmax : j);
                dst[i] = *(const u32x4*)(S.v + (size_t)(j * S.kstride + S.koff) * S.ldv + vch * 8); }
        };
        loadk(kf, t0); loadv(vr, t0);
        for (int t = t0; t < t1; ++t) {
#pragma unroll
            for (int i = 0; i < VLD; ++i) *(LAS u32x4*)(vbuf + vdst + i * (64 / VCH) * 64) = vr[i];
            asm volatile("" ::: "memory");
            if (t + 1 < t1) { loadk(kfn, t + 1); loadv(vrn, t + 1); }
            f32x16 s;
#pragma unroll
            for (int r = 0; r < 16; ++r) s[r] = 0.f;
#pragma unroll
            for (int d = 0; d < NDQ; ++d) s = __builtin_amdgcn_mfma_f32_32x32x16_bf16(kf[d], qf[d], s, 0, 0, 0);
            if (t < tf0 || t >= tf1) {
                const int kb = k0 + 32 * t + 4 * hi;
#pragma unroll
                for (int r = 0; r < 16; ++r) if (!mask(qi, kb + (r & 3) + 8 * (r >> 2))) s[r] = SOFTMAX ? -INFINITY : 0.f;
            }
            if (SOFTMAX) {
                float mx = s[0];
#pragma unroll
                for (int r = 1; r < 16; ++r) mx = fmaxf(mx, s[r]);
                mx = fmaxf(mx, __shfl_xor(mx, 32));
                const float mn = fmaxf(m, mx), mu = mn == -INFINITY ? 0.f : mn;
                const float al = __builtin_amdgcn_exp2f(m - mu);
                float ps = 0.f;
#pragma unroll
                for (int r = 0; r < 16; ++r) { s[r] = __builtin_amdgcn_exp2f(s[r] - mu); ps += s[r]; }
                l = l * al + ps; m = mn;
                if (__any(al != 1.f)) {
#pragma unroll
                    for (int d = 0; d < NDB; ++d)
#pragma unroll
                        for (int r = 0; r < 16; ++r) o[d][r] *= al;
                }
            }
            bf16x8 pb[2];
#pragma unroll
            for (int st = 0; st < 2; ++st) { u32x4 w; w.x = cvtpk(s[8 * st], s[8 * st + 1]); w.y = cvtpk(s[8 * st + 2], s[8 * st + 3]); w.z = cvtpk(s[8 * st + 4], s[8 * st + 5]); w.w = cvtpk(s[8 * st + 6], s[8 * st + 7]);
                pb[st] = __builtin_bit_cast(bf16x8, w); }
#pragma unroll
            for (int d = 0; d < NDB; ++d)
#pragma unroll
                for (int st = 0; st < 2; ++st) {
                    const s16x4 lo = vtr(vb + d * 2048 + st * 1024), hh = vtr(vb + d * 2048 + st * 1024 + 512);
                    const bf16x8 vf = {lo[0], lo[1], lo[2], lo[3], hh[0], hh[1], hh[2], hh[3]};
                    o[d] = __builtin_amdgcn_mfma_f32_32x32x16_bf16(vf, pb[st], o[d], 0, 0, 0);
                }
            asm volatile("" ::: "memory");
#pragma unroll
            for (int d = 0; d < NDQ; ++d) kf[d] = kfn[d];
#pragma unroll
            for (int i = 0; i < VLD; ++i) vr[i] = vrn[i];
        }
    }
    DI void finish_store(bf16_t* yrow  , int lane) {
        const int hi = lane >> 5;
        float sc;
        if (SOFTMAX) { const float lt = l + __shfl_xor(l, 32); sc = 1.f / lt; }
        else { float ss = 0.f;
#pragma unroll
            for (int d = 0; d < NDB; ++d)
#pragma unroll
                for (int r = 0; r < 16; ++r) ss += o[d][r] * o[d][r];
            ss += __shfl_xor(ss, 32); sc = rsqrtf(ss * (1.f / (32 * NDB)) + NORM_EPS); }
#pragma unroll
        for (int d = 0; d < NDB; ++d)
#pragma unroll
            for (int g = 0; g < 4; ++g) {
                unsigned long long* p = (unsigned long long*)(yrow + 32 * d + 8 * g + 4 * hi);
                const unsigned long long gv = *p; const unsigned g0 = (unsigned)gv, g1 = (unsigned)(gv >> 32);
                const float a0 = o[d][4 * g] * sc * __uint_as_float(g0 << 16), a1 = o[d][4 * g + 1] * sc * __uint_as_float(g0 & 0xffff0000u);
                const float a2 = o[d][4 * g + 2] * sc * __uint_as_float(g1 << 16), a3 = o[d][4 * g + 3] * sc * __uint_as_float(g1 & 0xffff0000u);
                *p = (unsigned long long)cvtpk(a0, a1) | ((unsigned long long)cvtpk(a2, a3) << 32);
            }
    }
};

DI void unitA(LAS unsigned char* vbuf, bf16_t* __restrict__ proj, int b, int h, int r4, int lb) {
    const int lane = olane(), r32 = lane & 31, hi = lane >> 5, l0 = 32 * lb;
    const int lq = l0 + r32, tq = 4 * lq + r4;
    const size_t rowq = (size_t)b * SEQ + tq;
    AttnWave<4, 2, true> W; W.init();
#pragma unroll
    for (int d = 0; d < 4; ++d) W.qf[d] = *(const bf16x8*)(proj + rowq * PE + E_QA + h * 64 + 16 * d + 8 * hi);
    const bf16_t* kb = proj + (size_t)b * SEQ * PE + E_KA + h * 64; const bf16_t* vb = proj + (size_t)b * SEQ * PE + E_VA + h * 64;
    {
        KVSrc S{kb, kb, vb, PE, PE, PE, 1, 0, SEQ - 1}; const int k0 = 4 * l0 + r4 - 128;
        const int ts = k0 + 31 < 0 ? (-k0) >> 5 : 0;
        W.template segment<4>(vbuf, S, k0, ts, 8, 0, 0, tq, MaskBand{}, lane);
    }
    {
        KVSrc S{kb, kb, vb, PE, PE, PE, 4, r4, SEQ / 4 - 1}; const int k0 = l0 - 128;
        const int ts = k0 + 31 < 0 ? (-k0) >> 5 : 0;
        W.template segment<4>(vbuf, S, k0, ts, 5, ts > 1 ? ts : 1, 4, lq, MaskBand{}, lane);
        W.template segment<4>(vbuf, S, 0, 0, lb + 1, 0, 0, lq, MaskDil4{}, lane);
    }
    W.finish_store(proj + rowq * PE + E_G + h * 64, lane);
}
DI void unitRet(LAS unsigned char* vbuf, bf16_t* __restrict__ proj, int b, int h, int qb) {
    const int lane = olane(), r32 = lane & 31, hi = lane >> 5;
    const int sq = 32 * qb + r32; const size_t rowq = (size_t)b * SEQ + sq;
    AttnWave<4, 4, false> W; W.init();
#pragma unroll
    for (int d = 0; d < 4; ++d) W.qf[d] = *(const bf16x8*)(proj + rowq * PE + E_QR + h * 64 + 16 * d + 8 * hi);
    const bf16_t* kb = proj + (size_t)b * SEQ * PE + E_KR + h * 64;
    KVSrc S{kb, kb, proj + (size_t)b * SEQ * PE + E_VR + h * 128, PE, PE, PE, 1, 0, SEQ - 1};
    W.template segment<4>(vbuf, S, 0, 0, qb + 1, 0, qb, sq, MaskCausal{}, lane);
    W.finish_store(proj + rowq * PE + E_G + 512 + h * 128, lane);
}
DI void unitMem(LAS unsigned char* vbuf, bf16_t* __restrict__ proj, int pitch, int qcol, int gcol, const bf16_t* __restrict__ memkv, int layer, int b, int h, int sb) {
    const int lane = olane(), r32 = lane & 31, hi = lane >> 5;
    const size_t rowq = (size_t)b * SEQ + 32 * sb + r32;
    AttnWave<4, 2, true> W; W.init();
#pragma unroll
    for (int d = 0; d < 4; ++d) W.qf[d] = *(const bf16x8*)(proj + rowq * pitch + qcol + h * 64 + 16 * d + 8 * hi);
    const bf16_t* kb = memkv + (size_t)b * MEMT * 2048 + layer * 512 + h * 64;
    KVSrc S{kb, kb, kb + 256, 2048, 2048, 2048, 1, 0, MEMT - 1};
    W.template segment<4>(vbuf, S, 0, 0, 8, 0, 8, 0, MaskNone{}, lane);
    W.finish_store(proj + rowq * pitch + gcol + h * 64, lane);
}
DI void unitMla(LAS unsigned char* vbuf, bf16_t* __restrict__ proj, const bf16_t* __restrict__ mq, const bf16_t* __restrict__ mkv, int b, int h, int qb) {
    const int lane = olane(), r32 = lane & 31, hi = lane >> 5;
    const int sq = 32 * qb + r32; const size_t rowq = (size_t)b * SEQ + sq;
    AttnWave<6, 2, true> W; W.init();
#pragma unroll
    for (int d = 0; d < 6; ++d) W.qf[d] = *(const bf16x8*)(mq + rowq * 1024 + h * 128 + 16 * d + 8 * hi);
    const bf16_t* kb = mkv + (size_t)b * SEQ * 1024 + h * 128;
    KVSrc S{kb, proj + (size_t)b * SEQ * PO + O_KR, kb + 64, 1024, PO, 1024, 1, 0, SEQ - 1};
    W.template segment<4>(vbuf, S, 0, 0, qb + 1, 0, qb, sq, MaskCausal{}, lane);
    W.finish_store(proj + rowq * PO + O_G + h * 64, lane);
}

constexpr int LDS_VBUF = 0, LDS_SLOT = 65536;
DI int next_chunk(unsigned* counter, LAS unsigned* slot) {
    __syncthreads();
    if (threadIdx.x == 0) *slot = atomicAdd(counter, 1u);
    __syncthreads();
    return (int)*slot;
}
constexpr int NWAVES = 8, LDS_BYTES = 147456, GRID = 256;
template <class E> struct PgEpi {
    static constexpr bool PERM = true, AFTER_DRAIN = false;
    E e;
    DI void operator()(const pg8::f32x4 (&acc)[2][2][4][2], const pg8::Unit& u, int wr, int wc, int fr, int fq) const {
        const int row0 = u.pm * 256 + wr * 64 + fr, col0 = u.pn * 256 + wc * 32 + 8 * fq;
#pragma unroll
        for (int ai = 0; ai < 2; ++ai)
#pragma unroll
            for (int m = 0; m < 4; ++m) {
                const int row = row0 + ai * 128 + m * 16;
                const float rs = e.rowscale(row);
                float ss = 0.f;
#pragma unroll
                for (int bj = 0; bj < 2; ++bj) {
                    const pg8::f32x4 a0 = acc[ai][bj][m][0], a1 = acc[ai][bj][m][1];
                    float v[8] = {a0[0], a0[1], a0[2], a0[3], a1[0], a1[1], a1[2], a1[3]};
                    ss += e.apply(row, col0 + bj * 128, v, rs);
                }
                if (E::HAS_SSQ) { ss += __shfl_xor(ss, 16); ss += __shfl_xor(ss, 32); if (fq == 0) e.put_ssq(row, u.pn, wc, ss); }
                asm volatile("" ::: "memory");
            }
    }
};
template <int M, int N, int K, int LDA, class E> DI void run_gemm(pg8::PG8_LAS_T* lds, const bf16_t* A, const bf16_t* Bt, const E& e) {
    int bid = blockIdx.x; asm volatile("" : "+s"(bid));
    pg8::Gemm<M, N, K, LDA> g{A, Bt}; pg8::StaticOrder S; S.init(M, N, GRID, bid);
    PgEpi<E> pe{e};
    pg8::gemm_phase<PgEpi<E>, pg8::StaticOrder, true, true>(lds, g, S, pe);
}

namespace cg = cooperative_groups;

struct Args { const void* in[51]; float* out; unsigned char* ws; };
static_assert(sizeof(Args) == 53 * 8, "no padding");

__global__ void __launch_bounds__(NWAVES * 64, 2) mega(Args a) {
    extern __shared__ __attribute__((aligned(16))) unsigned char lds[];
    cg::grid_group grid = cg::this_grid();
    const int tid = threadIdx.x, wave = __builtin_amdgcn_readfirstlane(tid >> 6);
    const int G = gridDim.x, gw = blockIdx.x * NWAVES + wave, ngw = G * NWAVES;
    pg8::PG8_LAS_T* lds3 = (pg8::PG8_LAS_T*)lds;
#define WSB() ({ unsigned char* p_ = a.ws; asm volatile("" : "+s"(p_)); p_; })
#define ws WSB()
#define out ({ float* o_ = a.out; asm volatile("" : "+s"(o_)); o_; })
#define ssq ((float*)(ws + WS_SSQ))
#define cqsq ((float*)(ws + WS_CQSQ))
#define ckvsq ((float*)(ws + WS_CKVSQ))
#define mrstd ((float*)(ws + WS_MRSTD))
#define tabA ((float2*)(ws + WS_TABA))
#define tabR ((float2*)(ws + WS_TABR))
#define tabM ((float2*)(ws + WS_TABM))
#define wmem ((bf16_t*)(ws + WS_WMEM))
#define memb ((bf16_t*)(ws + WS_MEMB))
#define memkv ((bf16_t*)(ws + WS_MEMKV))
#define vfirst ((bf16_t*)(ws + WS_VFIRST))
#define xb ((bf16_t*)(ws + WS_XB))
#define mlakv ((bf16_t*)(ws + WS_XB))
#define mlaq ((bf16_t*)(ws + WS_MLAQ))
#define proj ((bf16_t*)(ws + WS_PROJ))
    const void* const* kin = (const void* const*)__builtin_amdgcn_kernarg_segment_ptr();
#define FIN(i) ((const float*)kin[i])
#define WI(l) ((bf16_t*)(ws + ((l) == 0 ? WS_WI0 : (l) == 1 ? WS_WI1 : (l) == 2 ? WS_WI2 : WS_WI3)))
#define WO(l) ((bf16_t*)(ws + WS_WO + (size_t)(l) * 2560 * 1024))
#define WQB(o) ((bf16_t*)(ws + WS_WQB + (size_t)(o) * 512 * 1024))
#define WKVB(o) ((bf16_t*)(ws + WS_WKVB + (size_t)(o) * 256 * 1024))

    {
        float* scr = (float*)lds + wave * (64 * 33);
        int base = 0;
#pragma unroll 1
        for (int l = 0; l < 4; ++l) {
            const bool odd = l & 1; const int dcols = l == 3 ? 1696 : 1664;
            const int i_norm = l == 0 ? 5 : l == 1 ? 9 : l == 2 ? 27 : 31, i_win = i_norm + 1;
            const int i_wmem = l == 0 ? 7 : l == 1 ? 25 : l == 2 ? 29 : 49, i_wout = i_wmem + 1;
            wconv_job(scr, gw, ngw, base, FIN(i_win), 1024, odd ? 416 + dcols + 256 + 1280 : 4096, WI(l), odd ? PO : PE, 0, odd ? 2 : 1, dcols, FIN(i_norm));
            wconv_job(scr, gw, ngw, base, FIN(i_wout), 1280, 1024, WO(l), 1024, 0, 0, 0, (const float*)nullptr);
            wconv_job(scr, gw, ngw, base, FIN(i_wmem), 1024, 512, wmem, 512, l * 512, 0, 0, FIN(3));
        }
#pragma unroll 1
        for (int o = 0; o < 2; ++o) {
            wconv_job(scr, gw, ngw, base, FIN(o ? 34 : 12), 256, 768, WQB(o), 1024, 0, 3, 0, FIN(o ? 33 : 11));
            wconv_job(scr, gw, ngw, base, FIN(o ? 36 : 14), 128, 1024, WKVB(o), 1024, 0, 0, 0, FIN(o ? 35 : 13));
        }
        tables_rows(gw, ngw, (const int*)kin[2], tabA, tabR, tabM);
        rows_prep(gw, ngw, FIN(0), xb, ssq, MTOK, 0);
        rows_prep(gw, ngw, FIN(1), memb, mrstd, MROWS, 1);
    }
    grid.sync();
    run_gemm<MROWS, 2048, DM, DM>(lds3, memb, wmem, EpiMemKV{memkv, mrstd});
#pragma unroll 1
    for (int l = 0; l < 4; ++l) {
        const float* resid = l == 0 ? FIN(0) : out;
        const int i_wmem = l == 0 ? 7 : l == 1 ? 25 : l == 2 ? 29 : 49;
        if ((l & 1) == 0) {
            run_gemm<MTOK, PE, DM, DM>(lds3, xb, WI(l), EpiEvenIn{proj, ssq, tabA, tabR});
            grid.sync();
            {
                LAS unsigned char* vbuf = (LAS unsigned char*)lds + LDS_VBUF + wave * 8192; LAS unsigned* slot = (LAS unsigned*)((LAS unsigned char*)lds + LDS_SLOT);
                for (;;) {
                    const int c = next_chunk((unsigned*)(ws + WS_CTL) + 64 * (1 + l), slot);
                    if (c >= 2048) break;
                    if (c < 512) unitRet(vbuf, proj, 2 * (c & 7) + (wave >> 2), wave & 3, 63 - (c >> 3));
                    else if (c < 1536) { const int c2 = c - 512; unitA(vbuf, proj, (c2 & 63) >> 2, wave, c2 & 3, 15 - (c2 >> 6)); }
                    else { const int c3 = c - 1536; unitMem(vbuf, proj, PE, E_QM, E_G + 1024, memkv, l, c3 >> 5, wave & 3, 2 * (c3 & 31) + (wave >> 2)); }
                }
            }
            grid.sync();
            run_gemm<MTOK, DM, 1280, PE>(lds3, proj + E_G, WO(l), EpiWOut{resid, out, xb, ssq});
            grid.sync();
        } else {
            const int o = l >> 1;
            run_gemm<MTOK, PO, DM, DM>(lds3, xb, WI(l), EpiOddIn{proj, ssq, tabM, cqsq, ckvsq});
            grid.sync();
            run_gemm<MTOK, 1024, 256, PO>(lds3, proj + O_CQ, WQB(o), EpiMlaQ{mlaq, cqsq, tabM});
            run_gemm<MTOK, 1024, 128, PO>(lds3, proj + O_CKV, WKVB(o), EpiMlaKV{mlakv, ckvsq});
            grid.sync();
            if (blockIdx.x < 128 && wave == 0) {
                RwkvW W;
                if (l == 1) W = RwkvW{FIN(15), FIN(16), FIN(17), FIN(18), FIN(19), nullptr, nullptr, FIN(20), FIN(21), FIN(22), FIN(23), FIN(24)};
                else W = RwkvW{FIN(37), FIN(38), FIN(39), FIN(40), FIN(41), FIN(42), FIN(43), FIN(44), FIN(45), FIN(46), FIN(47), FIN(48)};
                rwkv_naive_unit((float*)lds, proj, vfirst, W, l == 3 ? 1 : 0, (int)blockIdx.x);
            }
            {
                LAS unsigned char* vbuf = (LAS unsigned char*)lds + LDS_VBUF + wave * 8192; LAS unsigned* slot = (LAS unsigned*)((LAS unsigned char*)lds + LDS_SLOT);
                for (;;) {
                    const int c = next_chunk((unsigned*)(ws + WS_CTL) + 64 * (1 + l), slot);
                    if (c >= 1536) break;
                    if (c < 1024) unitMla(vbuf, proj, mlaq, mlakv, c & 15, wave, 63 - (c >> 4));
                    else { const int c3 = c - 1024; unitMem(vbuf, proj, PO, O_QM, O_G + 1024, memkv, l, c3 >> 5, wave & 3, 2 * (c3 & 31) + (wave >> 2)); }
                }
            }
            grid.sync();
            run_gemm<MTOK, DM, 1280, PO>(lds3, proj + O_G, WO(l), EpiWOut{resid, out, xb, ssq});
            grid.sync();
        }
    }
    final_norm_rows(gw, ngw, out, FIN(4));
}

#undef WSB
#undef ws
#undef out
#undef ssq
#undef cqsq
#undef ckvsq
#undef mrstd
#undef tabA
#undef tabR
#undef tabM
#undef wmem
#undef memb
#undef memkv
#undef vfirst
#undef xb
#undef mlakv
#undef mlaq
#undef proj
#undef FIN
#undef WI
#undef WO
#undef WQB
#undef WKVB
extern "C" void kernel_launch(void* const* d_in, const int* in_sizes, int n_in, void* d_out, int out_size, void* d_ws, size_t ws_size, hipStream_t stream) {
    static int grid = 0;
    if (grid == 0) {
        if (n_in != 51 || ws_size < WS_END) { fprintf(stderr, "kernel_launch: unexpected n_in %d / ws %zu\n", n_in, ws_size); grid = -1; return; }
        int dev = 0, cus = 0, per_cu = 0;
        hipGetDevice(&dev); hipDeviceGetAttribute(&cus, hipDeviceAttributeMultiprocessorCount, dev);
        hipFuncSetAttribute((const void*)mega, hipFuncAttributeMaxDynamicSharedMemorySize, LDS_BYTES);
        hipOccupancyMaxActiveBlocksPerMultiprocessor(&per_cu, (const void*)mega, NWAVES * 64, LDS_BYTES);
        if (per_cu < 1) { fprintf(stderr, "kernel_launch: occupancy query says %d blocks per CU\n", per_cu); per_cu = 1; }
        if (cus * per_cu < GRID) { fprintf(stderr, "kernel_launch: device holds %d x %d workgroups, kernel is built for %d\n", cus, per_cu, GRID); grid = -1; return; }
        grid = GRID;
    }
    if (grid < 0) return;
    if (hipMemsetAsync((char*)d_ws + WS_CTL, 0, 4096, stream) != hipSuccess) { fprintf(stderr, "kernel_launch: memset failed\n"); return; }
    Args a{};
    for (int i = 0; i < 51; ++i) a.in[i] = d_in[i];
    a.out = (float*)d_out; a.ws = (unsigned char*)d_ws;
    void* args[] = {&a};
    hipError_t e = hipLaunchCooperativeKernel((const void*)mega, dim3(grid), dim3(NWAVES * 64), args, LDS_BYTES, stream);
    if (e != hipSuccess) fprintf(stderr, "cooperative launch failed: %s (grid %d)\n", hipGetErrorString(e), grid);
}
```

```cpp
#include <hip/hip_runtime.h>
#include <hip/hip_cooperative_groups.h>
#include <stdint.h>
#include <cstdio>

typedef unsigned short bf16_t;
typedef unsigned u32x4 __attribute__((ext_vector_type(4)));
typedef float f32x4 __attribute__((ext_vector_type(4)));
#define DI __device__ __forceinline__

constexpr int BATCH = 16, SEQ = 2048, DM = 1024, MTOK = BATCH * SEQ, MEMT = 256, MROWS = BATCH * MEMT;
constexpr int PE = 4096, PO = 3840;
constexpr int E_QA = 0, E_KA = 512, E_VA = 1024, E_QR = 1536, E_KR = 1792, E_VR = 2048, E_QM = 2560, E_G = 2816;
constexpr int O_CQ = 0, O_CKV = 256, O_KR = 384, O_R = 512, O_K = 1024, O_V = 1536, O_WD = 2048, O_AD = 2112, O_MV = 2176, O_QM = 2304, O_G = 2560;
constexpr float NORM_EPS = 1e-6f, LOG2E = 1.4426950408889634f;
constexpr float QSCALE = 0.125f * LOG2E;
constexpr float QSCALE_MLA = 0.10206207261596575f * LOG2E;

constexpr size_t MiB = 1u << 20;
constexpr size_t WS_LORA = 5 * MiB;
constexpr size_t WS_CTL = 0, WS_SSQ = 1 * MiB, WS_CQSQ = 3 * MiB, WS_CKVSQ = 3 * MiB + 512 * 1024, WS_MRSTD = 4 * MiB;
constexpr size_t WS_TABA = 8 * MiB, WS_TABR = 10 * MiB, WS_TABM = 18 * MiB;
constexpr size_t WS_WI0 = 24 * MiB, WS_WI1 = 32 * MiB, WS_WI2 = WS_WI1 + 7680 * 1024, WS_WI3 = WS_WI2 + 8 * MiB;
constexpr size_t WS_WO = 55 * MiB;
constexpr size_t WS_WMEM = 65 * MiB;
constexpr size_t WS_WQB = 69 * MiB;
constexpr size_t WS_WKVB = WS_WQB + 1024 * 1024;
constexpr size_t WS_MEMB = 72 * MiB, WS_MEMKV = 80 * MiB, WS_VFIRST = 96 * MiB, WS_XB = 128 * MiB, WS_MLAQ = 192 * MiB, WS_PROJ = 256 * MiB;
constexpr size_t WS_END = 512 * MiB;

DI int olane() { int l; asm volatile("v_and_b32 %0, 63, %1" : "=v"(l) : "v"(threadIdx.x)); return l; }
DI float bf2f(bf16_t v) { return __uint_as_float((unsigned)v << 16); }
DI bf16_t f2bf(float f) { unsigned u = __float_as_uint(f); return (bf16_t)((u + 0x7fffu + ((u >> 16) & 1u)) >> 16); }
DI unsigned pk2(float lo, float hi) { return (unsigned)f2bf(lo) | ((unsigned)f2bf(hi) << 16); }
DI float wave_sum(float v) {
#pragma unroll
    for (int o = 1; o < 64; o <<= 1) v += __shfl_xor(v, o);
    return v;
}
DI float siluf(float x) { return x / (1.f + __expf(-x)); }
DI float sigmoidf_(float x) { return 1.f / (1.f + __expf(-x)); }

DI int phys2log(int mapid, int p, int aux) {
    if (mapid == 1) {
        if (p < 1024) { const int pos = p & 63, base = p & ~63; return pos < 16 ? base + (pos & 1) * 8 + (pos >> 1) : p; }
        if (p >= 1536 && p < 2048) { const int pos = p & 63, base = p & ~63; return base + (pos & 1) * 32 + (pos >> 1); }
        return p;
    }
    if (mapid == 2) {
        if (p < 384) return p;
        if (p < 416) { const int pos = p - 384; return 384 + (pos & 1) * 16 + (pos >> 1); }
        if (p < 512) return -1;
        if (p < 2048) return 416 + (p - 512);
        if (p < 2176) return 416 + 1536 + (p - 2048);
        if (p < 2208) return aux > 1664 ? 416 + 1664 + (p - 2176) : -1;
        if (p < 2304) return -1;
        if (p < 2560) return 416 + aux + (p - 2304);
        return 416 + aux + 256 + (p - 2560);
    }
    if (mapid == 3) {
        const int hh = p >> 7, pos = p & 127;
        if (pos < 64) return hh * 96 + pos;
        if (pos >= 96) return -1;
        const int pp = pos - 64; return hh * 96 + 64 + (pp & 1) * 16 + (pp >> 1);
    }
    return p;
}


DI void wconv_job(float* scr, int gw, int ngw, int& base, const float* __restrict__ W, int K, int Nsrc, bf16_t* __restrict__ dst, int Nphys, int row_off, int mapid, int aux, const float* __restrict__ gain) {
    const int lane = olane();
    const int nblk = Nphys / 32, kblk = (K + 63) / 64, nitems = nblk * kblk;
    int first = (gw - base % ngw + ngw) % ngw; base += nitems;
    for (int item = first; item < nitems; item += ngw) {
        const int kb = item / nblk, nb = item % nblk, k0 = 64 * kb, n0 = 32 * nb;
        const int nl = phys2log(mapid, n0 + (lane & 31), aux);
#pragma unroll 8
        for (int i = 0; i < 32; ++i) {
            const int kk = 2 * i + (lane >> 5);
            float v = 0.f;
            if (nl >= 0 && k0 + kk < K) { v = W[(size_t)(k0 + kk) * Nsrc + nl]; if (gain) v *= gain[k0 + kk]; }
            scr[kk * 33 + (lane & 31)] = v;
        }
        asm volatile("s_waitcnt lgkmcnt(0)" ::: "memory");
        const int c = lane & 7;
        if (k0 + 8 * c < K) {
#pragma unroll
            for (int j = 0; j < 4; ++j) {
                const int n = (lane >> 3) + 8 * j; const float* s = scr + (8 * c) * 33 + n;
                u32x4 o; o.x = pk2(s[0], s[33]); o.y = pk2(s[66], s[99]); o.z = pk2(s[132], s[165]); o.w = pk2(s[198], s[231]);
                *(u32x4*)(dst + (size_t)(row_off + n0 + n) * K + k0 + 8 * c) = o;
            }
        }
        asm volatile("s_waitcnt lgkmcnt(0)" ::: "memory");
    }
}
DI void rows_prep(int gw, int ngw, const float* __restrict__ x, bf16_t* __restrict__ xb, float* __restrict__ stat, int R, int mode) {
    const int lane = olane();
    for (int r = gw; r < R; r += ngw) {
        const f32x4* xr = (const f32x4*)(x + (size_t)r * DM) + lane;
        float s = 0.f;
        unsigned long long* o8 = (unsigned long long*)(xb + (size_t)r * DM) + lane;
#pragma unroll
        for (int j = 0; j < 4; ++j) { const f32x4 v = xr[64 * j]; s += v.x * v.x + v.y * v.y + v.z * v.z + v.w * v.w;
            o8[64 * j] = (unsigned long long)pk2(v.x, v.y) | ((unsigned long long)pk2(v.z, v.w) << 32); }
        s = wave_sum(s);
        if (mode == 0) { if (lane < 16) stat[(size_t)r * 16 + lane] = lane == 0 ? s : 0.f; }
        else if (lane == 0) stat[r] = rsqrtf(s * (1.f / DM) + NORM_EPS);
    }
}
DI void tables_rows(int gw, int ngw, const int* __restrict__ positions, float2* __restrict__ tabA, float2* __restrict__ tabR, float2* __restrict__ tabM) {
    const int i = olane();
    float theta = 500000.f, dim = 16.f; int j = i, kind = 0;
    if (i >= 8 && i < 40) { theta = 10000.f; dim = 64.f; j = i - 8; kind = 1; }
    else if (i >= 40) { dim = 32.f; j = i - 40; kind = 2; }
    const float inv = expf((-logf(theta) * (float)(2 * j)) / dim);
    for (int row = gw; row < MTOK; row += ngw) {
        const float ang = (float)positions[row] * inv;
        float sn, cs; sincosf(ang, &sn, &cs);
        const float2 v = make_float2(cs, sn);
        if (kind == 0) tabA[(size_t)row * 8 + j] = v; else if (kind == 1) tabR[(size_t)row * 32 + j] = v; else if (i < 56) tabM[(size_t)row * 16 + j] = v;
    }
}

DI void store8(bf16_t* p, const float* v) { u32x4 o; o.x = pk2(v[0], v[1]); o.y = pk2(v[2], v[3]); o.z = pk2(v[4], v[5]); o.w = pk2(v[6], v[7]); *(u32x4*)p = o; }
DI void rot4(float* v, const float2* cs) {
#pragma unroll
    for (int j = 0; j < 4; ++j) { const float2 c = cs[j]; const float a = v[2 * j], b = v[2 * j + 1]; v[2 * j] = a * c.x - b * c.y; v[2 * j + 1] = a * c.y + b * c.x; }
}
DI float ssq16_rstd(const float* ssq, int row, float invn) {
    const f32x4* p = (const f32x4*)(ssq + (size_t)row * 16); const f32x4 a = p[0], b = p[1], c = p[2], d = p[3];
    const float s = (a.x + a.y + a.z + a.w) + (b.x + b.y + b.z + b.w) + (c.x + c.y + c.z + c.w) + (d.x + d.y + d.z + d.w);
    return rsqrtf(s * invn + NORM_EPS);
}
DI float ssq4_rstd(const float* ssq, int row, float invn) { const f32x4 a = *(const f32x4*)(ssq + (size_t)row * 4); return rsqrtf((a.x + a.y + a.z + a.w) * invn + NORM_EPS); }

struct EpiEvenIn {
    static constexpr bool HAS_SSQ = false; DI void put_ssq(int, int, int, float) const {}
    bf16_t* out; const float* ssq; const float2* tabA; const float2* tabR;
    DI float rowscale(int row) const { return ssq16_rstd(ssq, row, 1.f / DM); }
    DI float apply(int row, int c, float* v, float rs) const {
#pragma unroll
        for (int i = 0; i < 8; ++i) v[i] *= rs;
        if (c < E_VA) {
            const int pos = c & 63;
            if (pos < 16) rot4(v, tabA + (size_t)row * 8 + (pos >> 1));
            if (c < E_KA) {
#pragma unroll
                for (int i = 0; i < 8; ++i) v[i] *= QSCALE;
            }
        } else if (c >= E_QR && c < E_VR) {
            const int pos = c & 63, h = ((c - E_QR) & 255) >> 6;
            rot4(v, tabR + (size_t)row * 32 + (pos >> 1));
            const float lg = log2f(1.f - exp2f(-5.f - (float)h)), s = (float)(row & (SEQ - 1));
            const float f = c < E_KR ? exp2f(s * lg) : 0.125f * exp2f(-s * lg);
#pragma unroll
            for (int i = 0; i < 8; ++i) v[i] *= f;
        } else if (c >= E_QM && c < E_G) {
#pragma unroll
            for (int i = 0; i < 8; ++i) v[i] *= QSCALE;
        } else if (c >= E_G) {
#pragma unroll
            for (int i = 0; i < 8; ++i) v[i] = siluf(v[i]);
        }
        store8(out + (size_t)row * PE + c, v);
        return 0.f;
    }
};
struct EpiOddIn {
    static constexpr bool HAS_SSQ = true;
    bf16_t* out; const float* ssq; const float2* tabM; float* cqsq; float* ckvsq;
    DI void put_ssq(int row, int pn, int wc, float ss) const { if (pn == 0) cqsq[(size_t)row * 4 + wc] = ss; else if (pn == 1) ckvsq[(size_t)row * 4 + wc] = ss; }
    DI float rowscale(int row) const { return ssq16_rstd(ssq, row, 1.f / DM); }
    DI float apply(int row, int c, float* v, float rs) const {
        float ss = 0.f;
#pragma unroll
        for (int i = 0; i < 8; ++i) v[i] *= rs;
        if (c < O_KR) {
#pragma unroll
            for (int i = 0; i < 8; ++i) ss += v[i] * v[i];
        } else if (c < O_KR + 32) rot4(v, tabM + (size_t)row * 16 + ((c - O_KR) >> 1));
        else if (c >= O_QM && c < O_G) {
#pragma unroll
            for (int i = 0; i < 8; ++i) v[i] *= QSCALE;
        } else if (c >= O_G) {
#pragma unroll
            for (int i = 0; i < 8; ++i) v[i] = siluf(v[i]);
        }
        store8(out + (size_t)row * PO + c, v);
        return ss;
    }
};
struct EpiWOut {
    static constexpr bool HAS_SSQ = true;
    const float* resid; float* xo; bf16_t* xb; float* ssq;
    DI void put_ssq(int row, int pn, int wc, float ss) const { ssq[(size_t)row * 16 + pn * 4 + wc] = ss; }
    DI float rowscale(int) const { return 1.f; }
    DI float apply(int row, int c, float* v, float) const {
        const f32x4* r = (const f32x4*)(resid + (size_t)row * DM + c); const f32x4 r0 = r[0], r1 = r[1];
        v[0] += r0.x; v[1] += r0.y; v[2] += r0.z; v[3] += r0.w; v[4] += r1.x; v[5] += r1.y; v[6] += r1.z; v[7] += r1.w;
        f32x4* o = (f32x4*)(xo + (size_t)row * DM + c); o[0] = (f32x4){v[0], v[1], v[2], v[3]}; o[1] = (f32x4){v[4], v[5], v[6], v[7]};
        store8(xb + (size_t)row * DM + c, v);
        float ss = 0.f;
#pragma unroll
        for (int i = 0; i < 8; ++i) ss += v[i] * v[i];
        return ss;
    }
};
struct EpiMemKV {
    static constexpr bool HAS_SSQ = false; DI void put_ssq(int, int, int, float) const {}
    bf16_t* out; const float* rstd;
    DI float rowscale(int row) const { return rstd[row]; }
    DI float apply(int row, int c, float* v, float rs) const {
#pragma unroll
        for (int i = 0; i < 8; ++i) v[i] *= rs;
        store8(out + (size_t)row * 2048 + c, v); return 0.f;
    }
};
struct EpiMlaQ {
    static constexpr bool HAS_SSQ = false; DI void put_ssq(int, int, int, float) const {}
    bf16_t* out; const float* cqsq; const float2* tabM;
    DI float rowscale(int row) const { return ssq4_rstd(cqsq, row, 1.f / 256.f) * QSCALE_MLA; }
    DI float apply(int row, int c, float* v, float rs) const {
        const int pos = c & 127;
        if (pos >= 64 && pos < 96) rot4(v, tabM + (size_t)row * 16 + ((pos - 64) >> 1));
#pragma unroll
        for (int i = 0; i < 8; ++i) v[i] *= rs;
        store8(out + (size_t)row * 1024 + c, v); return 0.f;
    }
};
struct EpiMlaKV {
    static constexpr bool HAS_SSQ = false; DI void put_ssq(int, int, int, float) const {}
    bf16_t* out; const float* ckvsq;
    DI float rowscale(int row) const { return ssq4_rstd(ckvsq, row, 1.f / 128.f); }
    DI float apply(int row, int c, float* v, float rs) const {
#pragma unroll
        for (int i = 0; i < 8; ++i) v[i] *= rs;
        store8(out + (size_t)row * 1024 + c, v); return 0.f;
    }
};


namespace pg8 {
#define PG8_LAS __attribute__((address_space(3)))
typedef PG8_LAS unsigned char PG8_LAS_T;
typedef unsigned short bf16_t;
typedef short bf16x8 __attribute__((ext_vector_type(8)));
typedef float f32x4 __attribute__((ext_vector_type(4)));
typedef unsigned u32x4 __attribute__((ext_vector_type(4)));
constexpr int BM = 256, BK = 64, HALF = 128, HTB = HALF * BK * 2  , STAGE_BYTES = 8 * HTB, NXCD = 8, WGM = 8;

__host__ __device__ __forceinline__ int lds_byte(int r, int c) { const int st = (r >> 4) * 2 + (c >> 5), rr = r & 15, cc = c & 31, ob = rr * 64 + cc * 2; return st * 1024 + (ob ^ (((ob >> 9) & 1) << 5)); }
__host__ __device__ __forceinline__ void stage_rc(int b, int& R, int& C) { const int st = b / 1024, sb = b % 1024, swz = sb ^ (((sb >> 9) & 1) << 5); R = (st >> 1) * 16 + swz / 64; C = (st & 1) * 32 + (swz % 64) / 2; }
__host__ __device__ __forceinline__ int perm32(int rho) { const int n = rho >> 4, i = rho & 15; return 8 * (i >> 2) + 4 * n + (i & 3); }

struct Unit { int pm, pn; };
template <int M_, int N_, int K_, int LDA_> struct Gemm { const bf16_t* A; const bf16_t* Bt; static constexpr int M = M_, N = N_, K = K_, lda = LDA_; };

struct StaticOrder {
    int nM, nN, nwg, G, c;
    __host__ __device__ void init(int M, int N, int G_, int c_) { nM = M / BM; nN = N / BM; nwg = nM * nN; G = G_; c = c_; }
    __host__ __device__ bool next(int i, Unit& u) const {
        const long L = (long)i * G + c; if (L >= nwg) return false;
        int wgid = (int)L; { const int q = nwg / NXCD, r = nwg % NXCD, xcd = wgid % NXCD, off = wgid / NXCD; wgid = (xcd < r ? xcd * (q + 1) : r * (q + 1) + (xcd - r) * q) + off; }
        const int nig = WGM * nN, gid = wgid / nig, fm = gid * WGM, gsz = (nM - fm) < WGM ? (nM - fm) : WGM;
        u.pm = fm + ((wgid % nig) % gsz); u.pn = (wgid % nig) / gsz; return true;
    }
    __device__ __forceinline__ void a_ready(const Unit&) const {}
    __device__ __forceinline__ void done(const Unit&) const {}
};

template <class Epi, class Sched, bool ALIGN_EPI = false, bool SP2 = false, class GemmT>
__device__ __forceinline__ void gemm_phase(PG8_LAS unsigned char* lds, const GemmT g, const Sched& S, const Epi& E) {
    int tid_ = threadIdx.x; asm volatile("" : "+v"(tid_));
    const int tid = tid_, wid = __builtin_amdgcn_readfirstlane(tid >> 6), lane = tid & 63, wr = wid >> 2, wc = wid & 3, fr = lane & 15, fq = lane >> 4;
    const int K = g.K; int nt = K / BK; asm volatile("" : "+s"(nt));
    unsigned voffA[2], voffB[2];
#pragma unroll
    for (int i = 0; i < 2; ++i) { int R, C; stage_rc(tid * 16 + i * 8192, R, C); const int Rb = Epi::PERM ? ((R & ~31) + perm32(R & 31)) : R;
        voffA[i] = (unsigned)(R * g.lda + C) * 2u; voffB[i] = (unsigned)(Rb * K + C) * 2u; }
    const size_t kstep = (size_t)(BK * 2);
    const size_t hstepA = (size_t)HALF * g.lda * 2, hstepB = (size_t)HALF * K * 2;
    const size_t tstepA = 2 * hstepA, tstepB = 2 * hstepB;
    const unsigned ldsw = (unsigned)wid * 1024u;
    const int aoff = lds_byte(wr * 64 + fr, fq * 8), boff = lds_byte(wc * 32 + fr, fq * 8);
#define PG8_SA(b, h) (((b) * 2 + (h)) * HTB)
#define PG8_SB(b, h) ((4 + (b) * 2 + (h)) * HTB)
#define PG8_STAGE(bufoff, gbase, voff) do { _Pragma("unroll") for (int _i = 0; _i < 2; ++_i) \
        __builtin_amdgcn_global_load_lds((const unsigned*)((const char*)(gbase) + (voff)[_i]), (PG8_LAS unsigned*)(lds + (bufoff) + ldsw + _i * 8192), 16, 0, 0); } while (0)
#define PG8_LDA(dst, b, h) do { _Pragma("unroll") for (int m = 0; m < 4; ++m) _Pragma("unroll") for (int k = 0; k < 2; ++k) dst[m][k] = *(const PG8_LAS bf16x8*)(lds + PG8_SA(b, h) + aoff + m * 2048 + k * 1024); } while (0)
#define PG8_LDB(dst, b, h) do { _Pragma("unroll") for (int n = 0; n < 2; ++n) _Pragma("unroll") for (int k = 0; k < 2; ++k) dst[n][k] = *(const PG8_LAS bf16x8*)(lds + PG8_SB(b, h) + boff + n * 2048 + k * 1024); } while (0)
#define PG8_MMA(ai, bj, At, Bt) do { __builtin_amdgcn_s_setprio(1); _Pragma("unroll") for (int m = 0; m < 4; ++m) _Pragma("unroll") for (int n = 0; n < 2; ++n) _Pragma("unroll") for (int k = 0; k < 2; ++k) \
        acc[ai][bj][m][n] = __builtin_amdgcn_mfma_f32_16x16x32_bf16(Bt[n][k], At[m][k], acc[ai][bj][m][n], 0, 0, 0); __builtin_amdgcn_s_setprio(0); } while (0)
#define PG8_WAIT_V(n) asm volatile("s_waitcnt vmcnt(" #n ")" ::: "memory")
#define PG8_WAIT_L(n) asm volatile("s_waitcnt lgkmcnt(" #n ")" ::: "memory")
#define PG8_BAR __builtin_amdgcn_s_barrier()
#define PG8_SCHED __builtin_amdgcn_sched_barrier(0)
    Unit cur, nxt; int ui = 0;
    if (!S.next(0, cur)) return;
    f32x4 acc[2][2][4][2];
#pragma unroll
    for (int a = 0; a < 2; ++a)
#pragma unroll
        for (int b = 0; b < 2; ++b)
#pragma unroll
            for (int m = 0; m < 4; ++m)
#pragma unroll
                for (int n = 0; n < 2; ++n) acc[a][b][m][n] = (f32x4){0.f, 0.f, 0.f, 0.f};
    bf16x8 At[4][2], B0[2][2], B1[2][2];
    const char* cA = (const char*)g.A + (size_t)cur.pm * tstepA; const char* cB = (const char*)g.Bt + (size_t)cur.pn * tstepB;
    S.a_ready(cur);
    if constexpr (SP2) {
        PG8_STAGE(PG8_SB(0, 0), cB, voffB); PG8_STAGE(PG8_SB(0, 1), cB + hstepB, voffB); PG8_STAGE(PG8_SA(0, 0), cA, voffA); PG8_STAGE(PG8_SA(0, 1), cA + hstepA, voffA);
        if (wr == 1) PG8_BAR;
        PG8_WAIT_V(2); PG8_BAR;
        PG8_STAGE(PG8_SB(1, 0), cB + kstep, voffB); PG8_STAGE(PG8_SA(1, 0), cA + kstep, voffA); PG8_STAGE(PG8_SB(1, 1), cB + hstepB + kstep, voffB);
        PG8_WAIT_V(6); PG8_BAR;
    } else {
        PG8_STAGE(PG8_SB(0, 0), cB, voffB); PG8_STAGE(PG8_SA(0, 0), cA, voffA); PG8_STAGE(PG8_SB(0, 1), cB + hstepB, voffB); PG8_STAGE(PG8_SA(0, 1), cA + hstepA, voffA);
        if (wr == 1) PG8_BAR;
        PG8_WAIT_V(4); PG8_BAR;
        PG8_STAGE(PG8_SB(1, 0), cB + kstep, voffB); PG8_STAGE(PG8_SA(1, 0), cA + kstep, voffA); PG8_STAGE(PG8_SB(1, 1), cB + hstepB + kstep, voffB);
        PG8_WAIT_V(6); PG8_BAR;
    }
    for (;;) {
        const bool has_next = S.next(ui + 1, nxt);
        const char* nA = has_next ? (const char*)g.A + (size_t)nxt.pm * tstepA : cA; const char* nB = has_next ? (const char*)g.Bt + (size_t)nxt.pn * tstepB : cB;
        for (int t = 0; t < nt; t += 2) {
            const bool last = (t == nt - 2);
            const char* a1 = cA + (size_t)(t + 1) * kstep;
            const char* a2 = last ? nA : cA + (size_t)(t + 2) * kstep; const char* b2 = last ? nB : cB + (size_t)(t + 2) * kstep;
            const char* a3 = a2 + kstep; const char* b3 = b2 + kstep;
            if (last && has_next) S.a_ready(nxt);
            if constexpr (SP2) {
            PG8_LDB(B0, 0, 0); PG8_LDB(B1, 0, 1); PG8_SCHED; PG8_LDA(At, 0, 0); PG8_STAGE(PG8_SA(1, 1), a1 + hstepA, voffA);
            PG8_WAIT_V(8); PG8_WAIT_L(0); PG8_BAR; PG8_MMA(0, 0, At, B0); PG8_MMA(0, 1, At, B1); PG8_BAR; PG8_SCHED;
            PG8_LDA(At, 0, 1); PG8_STAGE(PG8_SB(0, 0), b2, voffB); PG8_STAGE(PG8_SB(0, 1), b2 + hstepB, voffB); PG8_STAGE(PG8_SA(0, 0), a2, voffA);
            PG8_WAIT_V(8); PG8_WAIT_L(0); PG8_BAR; PG8_MMA(1, 0, At, B0); PG8_MMA(1, 1, At, B1); PG8_BAR; PG8_SCHED;
            PG8_LDB(B0, 1, 0); PG8_LDB(B1, 1, 1); PG8_SCHED; PG8_LDA(At, 1, 0); PG8_STAGE(PG8_SA(0, 1), a2 + hstepA, voffA);
            PG8_WAIT_V(8); PG8_WAIT_L(0); PG8_BAR; PG8_MMA(0, 0, At, B0); PG8_MMA(0, 1, At, B1); PG8_BAR; PG8_SCHED;
            PG8_LDA(At, 1, 1); PG8_STAGE(PG8_SB(1, 0), b3, voffB); PG8_STAGE(PG8_SB(1, 1), b3 + hstepB, voffB); PG8_STAGE(PG8_SA(1, 0), a3, voffA);
            PG8_WAIT_V(8); PG8_WAIT_L(0); PG8_BAR; PG8_MMA(1, 0, At, B0); PG8_MMA(1, 1, At, B1); PG8_BAR; PG8_SCHED;
            } else {
            PG8_LDB(B0, 0, 0); PG8_SCHED; PG8_LDA(At, 0, 0); PG8_STAGE(PG8_SA(1, 1), a1 + hstepA, voffA);
            PG8_WAIT_L(8); PG8_BAR; PG8_WAIT_L(0); PG8_MMA(0, 0, At, B0); PG8_BAR; PG8_SCHED;
            PG8_LDB(B1, 0, 1); PG8_STAGE(PG8_SB(0, 0), b2, voffB);
            PG8_BAR; PG8_WAIT_L(0); PG8_MMA(0, 1, At, B1); PG8_BAR;
            PG8_LDA(At, 0, 1); PG8_STAGE(PG8_SA(0, 0), a2, voffA);
            PG8_BAR; PG8_WAIT_L(0); PG8_MMA(1, 0, At, B0); PG8_BAR; PG8_SCHED;
            PG8_STAGE(PG8_SB(0, 1), b2 + hstepB, voffB);
            PG8_WAIT_V(6); PG8_BAR; PG8_MMA(1, 1, At, B1); PG8_BAR;
            PG8_LDB(B0, 1, 0); PG8_SCHED; PG8_LDA(At, 1, 0); PG8_STAGE(PG8_SA(0, 1), a2 + hstepA, voffA);
            PG8_WAIT_L(8); PG8_BAR; PG8_WAIT_L(0); PG8_MMA(0, 0, At, B0); PG8_BAR; PG8_SCHED;
            PG8_LDB(B1, 1, 1); PG8_STAGE(PG8_SB(1, 0), b3, voffB);
            PG8_BAR; PG8_WAIT_L(0); PG8_MMA(0, 1, At, B1); PG8_BAR;
            PG8_LDA(At, 1, 1); PG8_STAGE(PG8_SA(1, 0), a3, voffA);
            PG8_BAR; PG8_WAIT_L(0); PG8_MMA(1, 0, At, B0); PG8_BAR; PG8_SCHED;
            PG8_STAGE(PG8_SB(1, 1), b3 + hstepB, voffB);
            PG8_WAIT_V(6); PG8_BAR; PG8_MMA(1, 1, At, B1); PG8_BAR;
            }
        }
        if constexpr (ALIGN_EPI) { if (wr == 0) PG8_BAR; }
        if constexpr (!Epi::AFTER_DRAIN) { E(acc, cur, wr, wc, fr, fq); S.done(cur); }
        if (!has_next) break;
#pragma unroll
        for (int a = 0; a < 2; ++a)
#pragma unroll
            for (int b = 0; b < 2; ++b)
#pragma unroll
                for (int m = 0; m < 4; ++m)
#pragma unroll
                    for (int n = 0; n < 2; ++n) acc[a][b][m][n] = (f32x4){0.f, 0.f, 0.f, 0.f};
        cur = nxt; cA = nA; cB = nB; ++ui;
        if constexpr (ALIGN_EPI) { if (wr == 1) PG8_BAR; }
    }
    PG8_WAIT_V(0);
    if constexpr (!ALIGN_EPI) { if (wr == 0) PG8_BAR; }
    PG8_BAR;
    if constexpr (Epi::AFTER_DRAIN) { E.fused(acc, cur, wr, wc, fr, fq, lds, wid, lane); S.done(cur); }
#undef PG8_SA
#undef PG8_SB
#undef PG8_STAGE
#undef PG8_LDA
#undef PG8_LDB
#undef PG8_MMA
#undef PG8_WAIT_V
#undef PG8_WAIT_L
#undef PG8_BAR
#undef PG8_SCHED
}
}

DI void attnA_naive_item(bf16_t* __restrict__ proj, int item) {
    const int lane = olane();
    const int row = item >> 3, h = item & 7, b = row >> 11, s = row & (SEQ - 1);
    const float q = bf2f(proj[(size_t)row * PE + E_QA + h * 64 + lane]);
    float lse[3], o[3];
#pragma unroll
    for (int p = 0; p < 3; ++p) {
        const int dil = p == 0 ? 1 : (p == 1 ? 4 : 16);
        const int ls = s / dil, r = s % dil, j0 = ls - 128 < 0 ? 0 : ls - 128;
        float m = -INFINITY, l = 0.f, acc = 0.f;
        for (int j = j0; j <= ls; ++j) {
            const size_t kr = (size_t)(b * SEQ + j * dil + r) * PE;
            const float sc = wave_sum(q * bf2f(proj[kr + E_KA + h * 64 + lane]));
            const float vv = bf2f(proj[kr + E_VA + h * 64 + lane]);
            const float mn = fmaxf(m, sc), al = exp2f(m - mn), pp = exp2f(sc - mn);
            l = l * al + pp; acc = acc * al + pp * vv; m = mn;
        }
        lse[p] = m + log2f(l); o[p] = acc / l;
    }
    const float mx = fmaxf(lse[0], fmaxf(lse[1], lse[2]));
    const float w0 = exp2f(lse[0] - mx), w1 = exp2f(lse[1] - mx), w2 = exp2f(lse[2] - mx);
    const float out = (w0 * o[0] + w1 * o[1] + w2 * o[2]) / (w0 + w1 + w2);
    bf16_t* g = proj + (size_t)row * PE + E_G + h * 64 + lane;
    *g = f2bf(out * bf2f(*g));
}
DI void ret_naive_item(bf16_t* __restrict__ proj, int item) {
    const int lane = olane();
    const int row = item >> 2, h = item & 3, b = row >> 11, s = row & (SEQ - 1);
    const float q = bf2f(proj[(size_t)row * PE + E_QR + h * 64 + lane]);
    float o0 = 0.f, o1 = 0.f;
    for (int j = 0; j <= s; ++j) {
        const size_t kr = (size_t)(b * SEQ + j) * PE;
        const float sc = wave_sum(q * bf2f(proj[kr + E_KR + h * 64 + lane]));
        o0 += sc * bf2f(proj[kr + E_VR + h * 128 + lane]); o1 += sc * bf2f(proj[kr + E_VR + h * 128 + 64 + lane]);
    }
    const float rn = rsqrtf(wave_sum(o0 * o0 + o1 * o1) * (1.f / 128.f) + NORM_EPS);
    bf16_t* g = proj + (size_t)row * PE + E_G + 512 + h * 128 + lane;
    g[0] = f2bf(o0 * rn * bf2f(g[0])); g[64] = f2bf(o1 * rn * bf2f(g[64]));
}
DI void mem_naive_item(bf16_t* __restrict__ proj, int pitch, int qcol, int gcol, const bf16_t* __restrict__ memkv, int layer, int item) {
    const int lane = olane();
    const int row = item >> 2, h = item & 3, b = row >> 11;
    const float q = bf2f(proj[(size_t)row * pitch + qcol + h * 64 + lane]);
    float m = -INFINITY, l = 0.f, acc = 0.f;
    for (int j = 0; j < MEMT; ++j) {
        const bf16_t* kv = memkv + (size_t)(b * MEMT + j) * 2048 + layer * 512 + h * 64 + lane;
        const float sc = wave_sum(q * bf2f(kv[0])), vv = bf2f(kv[256]);
        const float mn = fmaxf(m, sc), al = exp2f(m - mn), pp = exp2f(sc - mn);
        l = l * al + pp; acc = acc * al + pp * vv; m = mn;
    }
    bf16_t* g = proj + (size_t)row * pitch + gcol + h * 64 + lane;
    *g = f2bf(acc / l * bf2f(*g));
}
DI void mla_naive_item(bf16_t* __restrict__ proj, const bf16_t* __restrict__ mq, const bf16_t* __restrict__ mkv, int item) {
    const int lane = olane();
    const int row = item >> 3, h = item & 7, b = row >> 11, s = row & (SEQ - 1);
    const float qn = bf2f(mq[(size_t)row * 1024 + h * 128 + lane]);
    const float qr = lane < 32 ? bf2f(mq[(size_t)row * 1024 + h * 128 + 64 + lane]) : 0.f;
    float m = -INFINITY, l = 0.f, acc = 0.f;
    for (int j = 0; j <= s; ++j) {
        const size_t kr = (size_t)(b * SEQ + j);
        float pr = qn * bf2f(mkv[kr * 1024 + h * 128 + lane]);
        if (lane < 32) pr += qr * bf2f(proj[kr * PO + O_KR + lane]);
        const float sc = wave_sum(pr), vv = bf2f(mkv[kr * 1024 + h * 128 + 64 + lane]);
        const float mn = fmaxf(m, sc), al = exp2f(m - mn), pp = exp2f(sc - mn);
        l = l * al + pp; acc = acc * al + pp * vv; m = mn;
    }
    bf16_t* g = proj + (size_t)row * PO + O_G + h * 64 + lane;
    *g = f2bf(acc / l * bf2f(*g));
}
DI void final_norm_rows(int gw, int ngw, float* __restrict__ x, const float* __restrict__ g) {
    const int lane = olane();
    for (int r = gw; r < MTOK; r += ngw) {
        f32x4* xr = (f32x4*)(x + (size_t)r * DM) + lane; const f32x4* gr = (const f32x4*)g + lane;
        f32x4 v[4]; float s = 0.f;
#pragma unroll
        for (int j = 0; j < 4; ++j) { v[j] = xr[64 * j]; s += v[j].x * v[j].x + v[j].y * v[j].y + v[j].z * v[j].z + v[j].w * v[j].w; }
        const float rn = rsqrtf(wave_sum(s) * (1.f / DM) + NORM_EPS);
#pragma unroll
        for (int j = 0; j < 4; ++j) { const f32x4 gg = gr[64 * j]; xr[64 * j] = (f32x4){v[j].x * rn * gg.x, v[j].y * rn * gg.y, v[j].z * rn * gg.z, v[j].w * rn * gg.w}; }
    }
}

typedef short bf16x8 __attribute__((ext_vector_type(8)));
typedef short s16x4 __attribute__((ext_vector_type(4)));
typedef float f32x16 __attribute__((ext_vector_type(16)));
#define LAS __attribute__((address_space(3)))
DI int crow(int r, int hi) { return (r & 3) + 8 * (r >> 2) + 4 * hi; }
DI s16x4 vtr(const LAS unsigned char* p) { return __builtin_bit_cast(s16x4, __builtin_amdgcn_ds_read_tr16_b64_v4i16((LAS s16x4*)p)); }
DI unsigned cvtpk(float lo, float hi) { typedef float f2 __attribute__((ext_vector_type(2))); typedef __bf16 b2 __attribute__((ext_vector_type(2))); f2 v = {lo, hi}; return __builtin_bit_cast(unsigned, __builtin_convertvector(v, b2)); }

struct KVSrc {
    const bf16_t* k; const bf16_t* k2; const bf16_t* v; int ldk, ldk2, ldv, kstride, koff, jmax;
};
struct MaskBand { DI bool operator()(int qi, int kj) const { return kj >= 0 && kj <= qi && qi - kj <= 128; } };
struct MaskDil4 { DI bool operator()(int qi, int kj) const { return kj <= qi && ((qi - kj) & 3) == 0; } };
struct MaskCausal { DI bool operator()(int qi, int kj) const { return kj <= qi; } };
struct MaskNone { DI bool operator()(int, int) const { return true; } };

template <int NDQ, int NDB, bool SOFTMAX> struct AttnWave {
    bf16x8 qf[NDQ]; f32x16 o[NDB]; float m, l;
    DI void init() {
#pragma unroll
        for (int d = 0; d < NDB; ++d)
#pragma unroll
            for (int r = 0; r < 16; ++r) o[d][r] = 0.f;
        m = -INFINITY; l = 0.f;
    }
    template <int NDQ1, class Mask> DI void segment(LAS unsigned char* vbuf, const KVSrc& S, int k0, int t0, int t1, int tf0, int tf1, int qi, const Mask& mask, int lane) {
        if (t0 >= t1) return;
        const int r32 = lane & 31, hi = lane >> 5;
        constexpr int VCH = NDB * 4;
        constexpr int VLD = NDB * 2;
        const int vrow = lane / VCH, vch = lane % VCH;
        const int vdst = (vch >> 2) * 2048 + vrow * 64 + (vch & 3) * 16;
        const LAS unsigned char* vb = vbuf + (4 * hi + ((lane & 15) >> 2)) * 64 + ((lane >> 4) & 1) * 32 + (lane & 3) * 8;
        bf16x8 kf[NDQ], kfn[NDQ]; u32x4 vr[VLD], vrn[VLD];
        auto loadk = [&](bf16x8 (&dst)[NDQ], int t) {
            int j = k0 + 32 * t + r32; j = j < 0 ? 0 : (j > S.jmax ? S.jmax : j);
            const size_t row = (size_t)(j * S.kstride + S.koff);
#pragma unroll
            for (int d = 0; d < NDQ; ++d) dst[d] = d < NDQ1 ? *(const bf16x8*)(S.k + row * S.ldk + 16 * d + 8 * hi) : *(const bf16x8*)(S.k2 + row * S.ldk2 + 16 * (d - NDQ1) + 8 * hi);
        };
        auto loadv = [&](u32x4 (&dst)[VLD], int t) {
#pragma unroll
            for (int i = 0; i < VLD; ++i) { int j = k0 + 32 * t + vrow + (64 / VCH) * i; j = j < 0 ? 0 : (j > S.jmax ? S.jmax : j);
                dst[i] = *(const u32x4*)(S.v + (size_t)(j * S.kstride + S.koff) * S.ldv + vch * 8); }
        };
        loadk(kf, t0); loadv(vr, t0);
        for (int t = t0; t < t1; ++t) {
#pragma unroll
            for (int i = 0; i < VLD; ++i) *(LAS u32x4*)(vbuf + vdst + i * (64 / VCH) * 64) = vr[i];
            asm volatile("" ::: "memory");
            if (t + 1 < t1) { loadk(kfn, t + 1); loadv(vrn, t + 1); }
            f32x16 s;
#pragma unroll
            for (int r = 0; r < 16; ++r) s[r] = 0.f;
#pragma unroll
            for (int d = 0; d < NDQ; ++d) s = __builtin_amdgcn_mfma_f32_32x32x16_bf16(kf[d], qf[d], s, 0, 0, 0);
            if (t < tf0 || t >= tf1) {
                const int kb = k0 + 32 * t + 4 * hi;
#pragma unroll
                for (int r = 0; r < 16; ++r) if (!mask(qi, kb + (r & 3) + 8 * (r >> 2))) s[r] = SOFTMAX ? -INFINITY : 0.f;
            }
            if (SOFTMAX) {
                float mx = s[0];
#pragma unroll
                for (int r = 1; r < 16; ++r) mx = fmaxf(mx, s[r]);
                mx = fmaxf(mx, __shfl_xor(mx, 32));
                const float mn = fmaxf(m, mx), mu = mn == -INFINITY ? 0.f : mn;
                const float al = __builtin_amdgcn_exp2f(m - mu);
                float ps = 0.f;
#pragma unroll
                for (int r = 0; r < 16; ++r) { s[r] = __builtin_amdgcn_exp2f(s[r] - mu); ps += s[r]; }
                l = l * al + ps; m = mn;
                if (__any(al != 1.f)) {
#pragma unroll
                    for (int d = 0; d < NDB; ++d)
#pragma unroll
                        for (int r = 0; r < 16; ++r) o[d][r] *= al;
                }
            }
            bf16x8 pb[2];
#pragma unroll
            for (int st = 0; st < 2; ++st) { u32x4 w; w.x = cvtpk(s[8 * st], s[8 * st + 1]); w.y = cvtpk(s[8 * st + 2], s[8 * st + 3]); w.z = cvtpk(s[8 * st + 4], s[8 * st + 5]); w.w = cvtpk(s[8 * st + 6], s[8 * st + 7]);
                pb[st] = __builtin_bit_cast(bf16x8, w); }
#pragma unroll
            for (int d = 0; d < NDB; ++d)
#pragma unroll
                for (int st = 0; st < 2; ++st) {
                    const s16x4 lo = vtr(vb + d * 2048 + st * 1024), hh = vtr(vb + d * 2048 + st * 1024 + 512);
                    const bf16x8 vf = {lo[0], lo[1], lo[2], lo[3], hh[0], hh[1], hh[2], hh[3]};
                    o[d] = __builtin_amdgcn_mfma_f32_32x32x16_bf16(vf, pb[st], o[d], 0, 0, 0);
                }
            asm volatile("" ::: "memory");
#pragma unroll
            for (int d = 0; d < NDQ; ++d) kf[d] = kfn[d];
#pragma unroll
            for (int i = 0; i < VLD; ++i) vr[i] = vrn[i];
        }
    }
    DI void finish_store(bf16_t* yrow  , int lane) {
        const int hi = lane >> 5;
        float sc;
        if (SOFTMAX) { const float lt = l + __shfl_xor(l, 32); sc = 1.f / lt; }
        else { float ss = 0.f;
#pragma unroll
            for (int d = 0; d < NDB; ++d)
#pragma unroll
                for (int r = 0; r < 16; ++r) ss += o[d][r] * o[d][r];
            ss += __shfl_xor(ss, 32); sc = rsqrtf(ss * (1.f / (32 * NDB)) + NORM_EPS); }
#pragma unroll
        for (int d = 0; d < NDB; ++d)
#pragma unroll
            for (int g = 0; g < 4; ++g) {
                unsigned long long* p = (unsigned long long*)(yrow + 32 * d + 8 * g + 4 * hi);
                const unsigned long long gv = *p; const unsigned g0 = (unsigned)gv, g1 = (unsigned)(gv >> 32);
                const float a0 = o[d][4 * g] * sc * __uint_as_float(g0 << 16), a1 = o[d][4 * g + 1] * sc * __uint_as_float(g0 & 0xffff0000u);
                const float a2 = o[d][4 * g + 2] * sc * __uint_as_float(g1 << 16), a3 = o[d][4 * g + 3] * sc * __uint_as_float(g1 & 0xffff0000u);
                *p = (unsigned long long)cvtpk(a0, a1) | ((unsigned long long)cvtpk(a2, a3) << 32);
            }
    }
};

DI void unitA(LAS unsigned char* vbuf, bf16_t* __restrict__ proj, int b, int h, int r4, int lb) {
    const int lane = olane(), r32 = lane & 31, hi = lane >> 5, l0 = 32 * lb;
    const int lq = l0 + r32, tq = 4 * lq + r4;
    const size_t rowq = (size_t)b * SEQ + tq;
    AttnWave<4, 2, true> W; W.init();
#pragma unroll
    for (int d = 0; d < 4; ++d) W.qf[d] = *(const bf16x8*)(proj + rowq * PE + E_QA + h * 64 + 16 * d + 8 * hi);
    const bf16_t* kb = proj + (size_t)b * SEQ * PE + E_KA + h * 64; const bf16_t* vb = proj + (size_t)b * SEQ * PE + E_VA + h * 64;
    {
        KVSrc S{kb, kb, vb, PE, PE, PE, 1, 0, SEQ - 1}; const int k0 = 4 * l0 + r4 - 128;
        const int ts = k0 + 31 < 0 ? (-k0) >> 5 : 0;
        W.template segment<4>(vbuf, S, k0, ts, 8, 0, 0, tq, MaskBand{}, lane);
    }
    {
        KVSrc S{kb, kb, vb, PE, PE, PE, 4, r4, SEQ / 4 - 1}; const int k0 = l0 - 128;
        const int ts = k0 + 31 < 0 ? (-k0) >> 5 : 0;
        W.template segment<4>(vbuf, S, k0, ts, 5, ts > 1 ? ts : 1, 4, lq, MaskBand{}, lane);
        W.template segment<4>(vbuf, S, 0, 0, lb + 1, 0, 0, lq, MaskDil4{}, lane);
    }
    W.finish_store(proj + rowq * PE + E_G + h * 64, lane);
}
DI void unitRet(LAS unsigned char* vbuf, bf16_t* __restrict__ proj, int b, int h, int qb) {
    const int lane = olane(), r32 = lane & 31, hi = lane >> 5;
    const int sq = 32 * qb + r32; const size_t rowq = (size_t)b * SEQ + sq;
    AttnWave<4, 4, false> W; W.init();
#pragma unroll
    for (int d = 0; d < 4; ++d) W.qf[d] = *(const bf16x8*)(proj + rowq * PE + E_QR + h * 64 + 16 * d + 8 * hi);
    const bf16_t* kb = proj + (size_t)b * SEQ * PE + E_KR + h * 64;
    KVSrc S{kb, kb, proj + (size_t)b * SEQ * PE + E_VR + h * 128, PE, PE, PE, 1, 0, SEQ - 1};
    W.template segment<4>(vbuf, S, 0, 0, qb + 1, 0, qb, sq, MaskCausal{}, lane);
    W.finish_store(proj + rowq * PE + E_G + 512 + h * 128, lane);
}
DI void unitMem(LAS unsigned char* vbuf, bf16_t* __restrict__ proj, int pitch, int qcol, int gcol, const bf16_t* __restrict__ memkv, int layer, int b, int h, int sb) {
    const int lane = olane(), r32 = lane & 31, hi = lane >> 5;
    const size_t rowq = (size_t)b * SEQ + 32 * sb + r32;
    AttnWave<4, 2, true> W; W.init();
#pragma unroll
    for (int d = 0; d < 4; ++d) W.qf[d] = *(const bf16x8*)(proj + rowq * pitch + qcol + h * 64 + 16 * d + 8 * hi);
    const bf16_t* kb = memkv + (size_t)b * MEMT * 2048 + layer * 512 + h * 64;
    KVSrc S{kb, kb, kb + 256, 2048, 2048, 2048, 1, 0, MEMT - 1};
    W.template segment<4>(vbuf, S, 0, 0, 8, 0, 8, 0, MaskNone{}, lane);
    W.finish_store(proj + rowq * pitch + gcol + h * 64, lane);
}
DI void unitMla(LAS unsigned char* vbuf, bf16_t* __restrict__ proj, const bf16_t* __restrict__ mq, const bf16_t* __restrict__ mkv, int b, int h, int qb) {
    const int lane = olane(), r32 = lane & 31, hi = lane >> 5;
    const int sq = 32 * qb + r32; const size_t rowq = (size_t)b * SEQ + sq;
    AttnWave<6, 2, true> W; W.init();
#pragma unroll
    for (int d = 0; d < 6; ++d) W.qf[d] = *(const bf16x8*)(mq + rowq * 1024 + h * 128 + 16 * d + 8 * hi);
    const bf16_t* kb = mkv + (size_t)b * SEQ * 1024 + h * 128;
    KVSrc S{kb, proj + (size_t)b * SEQ * PO + O_KR, kb + 64, 1024, PO, 1024, 1, 0, SEQ - 1};
    W.template segment<4>(vbuf, S, 0, 0, qb + 1, 0, qb, sq, MaskCausal{}, lane);
    W.finish_store(proj + rowq * PO + O_G + h * 64, lane);
}

typedef float f32x2 __attribute__((ext_vector_type(2)));
constexpr int RW_T = 32;
constexpr int RW_R = 0, RW_W = 8192, RW_K = 16384, RW_A = 24576, RW_B = 32768, RW_V = 40960, RW_Y = 49152, RW_BF = 57344, RW_STG = 77824;
DI float dpp_add(float x, const int ctrl_sel) {
    int t;
    if (ctrl_sel == 0) t = __builtin_amdgcn_update_dpp(0, __float_as_int(x), 0xB1, 0xf, 0xf, true);
    else if (ctrl_sel == 1) t = __builtin_amdgcn_update_dpp(0, __float_as_int(x), 0x4E, 0xf, 0xf, true);
    else t = __builtin_amdgcn_update_dpp(0, __float_as_int(x), 0x141, 0xf, 0xf, true);
    return x + __int_as_float(t);
}
DI float red8(float x) { return dpp_add(dpp_add(dpp_add(x, 0), 1), 2); }
struct RwkvW { const float *mu, *w0, *w2, *a0, *a2, *v0, *v2, *k_k, *k_a, *r_k, *lnx_w, *lnx_b; };

template <bool VRES>
DI void rwkv_unit(LAS unsigned char* lds, bf16_t* __restrict__ proj, bf16_t* __restrict__ vfirst, const bf16_t* __restrict__ loraT  ,
                  const RwkvW& W, int unit) {
    const int lane = olane(), wave = __builtin_amdgcn_readfirstlane(threadIdx.x >> 6);
    const int b = unit >> 3, h = unit & 7, hc = h * 64 + lane, r32 = lane & 31, hi = lane >> 5;
    LAS float* aR = (LAS float*)(lds + RW_R); LAS float* aW = (LAS float*)(lds + RW_W); LAS float* aK = (LAS float*)(lds + RW_K);
    LAS float* aA = (LAS float*)(lds + RW_A); LAS float* aB = (LAS float*)(lds + RW_B); LAS float* aV = (LAS float*)(lds + RW_V); LAS float* aY = (LAS float*)(lds + RW_Y);
    LAS bf16_t* stg = (LAS bf16_t*)(lds + RW_STG + wave * 1280);
    const float mu_r = W.mu[hc], mu_k = W.mu[512 + hc], mu_v = W.mu[1024 + hc], mu_wd = W.mu[1536 + lane], mu_ad = W.mu[1600 + lane];
    const float mu_mv = (VRES && lane < 32) ? W.mu[1664 + lane] : 0.f;
    const float w0 = W.w0[hc], a0 = W.a0[hc], v0 = VRES ? W.v0[hc] : 0.f, k_k = W.k_k[hc], k_a = W.k_a[hc], r_k = W.r_k[hc], lw = W.lnx_w[hc], lb = W.lnx_b[hc];
    typedef float f32x4_t __attribute__((ext_vector_type(4)));
    LAS bf16x8* bfr = (LAS bf16x8*)(lds + RW_BF);
    {
        const int cl = lane & 15, kg = lane >> 4;
        for (int f = wave; f < 20; f += 8) {
            bf16x8 v;
            if (f < 16) { const int ct = (f & 7) >> 1, ks = f & 1; v = *(const bf16x8*)(loraT + (f >= 8 ? 32768 : 0) + (size_t)(h * 64 + 16 * ct + cl) * 64 + 32 * ks + 8 * kg); }
            else v = VRES ? *(const bf16x8*)(loraT + 65536 + (size_t)(h * 64 + 16 * (f - 16) + cl) * 32 + 8 * kg) : bf16x8{0, 0, 0, 0, 0, 0, 0, 0};
            bfr[f * 64 + lane] = v;
        }
    }
    __syncthreads();
    const int sig = lane & 7, rho = lane >> 3;
    f32x2 sA[4], sB[4];
#pragma unroll
    for (int j = 0; j < 4; ++j) { sA[j] = (f32x2){0.f, 0.f}; sB[j] = (f32x2){0.f, 0.f}; }
    const size_t row0 = (size_t)b * SEQ;
    unsigned short raw[5][6]; unsigned short vfr[4]; unsigned short gt[4];
    auto load_raw = [&](int c) {
#pragma unroll
        for (int i = 0; i < 5; ++i) {
            const int t = c * RW_T + 4 * wave + i - 1;
            if (t >= 0) { const bf16_t* p = proj + (row0 + t) * PO;
                raw[i][0] = p[O_R + hc]; raw[i][1] = p[O_K + hc]; raw[i][2] = p[O_V + hc]; raw[i][3] = p[O_WD + lane]; raw[i][4] = p[O_AD + lane]; raw[i][5] = (VRES && lane < 32) ? p[O_MV + lane] : (unsigned short)0;
            } else {
#pragma unroll
                for (int q = 0; q < 6; ++q) raw[i][q] = 0;
            }
        }
        if (VRES) {
#pragma unroll
            for (int i = 0; i < 4; ++i) vfr[i] = vfirst[(row0 + c * RW_T + 4 * wave + i) * 512 + hc];
        }
    };
    load_raw(0);
    for (int c = 0; c < SEQ / RW_T; ++c) {
        const int t0 = c * RW_T + 4 * wave;
        float bon[4];
        {
            float rs[4], ks[4], vs[4];
#pragma unroll
            for (int i = 0; i < 4; ++i) {
                const float xr = bf2f(raw[i + 1][0]), xk = bf2f(raw[i + 1][1]), xv = bf2f(raw[i + 1][2]), xwd = bf2f(raw[i + 1][3]), xad = bf2f(raw[i + 1][4]), xmv = bf2f(raw[i + 1][5]);
                const float pr = bf2f(raw[i][0]), pk = bf2f(raw[i][1]), pv = bf2f(raw[i][2]), pwd = bf2f(raw[i][3]), pad = bf2f(raw[i][4]), pmv = bf2f(raw[i][5]);
                rs[i] = xr + (pr - xr) * mu_r; ks[i] = xk + (pk - xk) * mu_k; vs[i] = xv + (pv - xv) * mu_v;
                const float wds = xwd + (pwd - xwd) * mu_wd, ads = xad + (pad - xad) * mu_ad, mvs = xmv + (pmv - xmv) * mu_mv;
                stg[i * 64 + lane] = f2bf(tanhf(wds)); stg[256 + i * 64 + lane] = f2bf(ads); if (lane < 32) stg[512 + i * 32 + lane] = f2bf(mvs);
            }
            asm volatile("s_waitcnt lgkmcnt(0)" ::: "memory");
            f32x4_t dw[4], da[4], dv[4];
            const int tok = lane & 3, kg = lane >> 4;
            bf16x8 fw[2], fa[2], fv;
#pragma unroll
            for (int ks2 = 0; ks2 < 2; ++ks2) { fw[ks2] = *(const LAS bf16x8*)(stg + tok * 64 + 32 * ks2 + 8 * kg); fa[ks2] = *(const LAS bf16x8*)(stg + 256 + tok * 64 + 32 * ks2 + 8 * kg); }
            fv = *(const LAS bf16x8*)(stg + 512 + tok * 32 + 8 * kg);
#pragma unroll
            for (int ct = 0; ct < 4; ++ct) {
                dw[ct] = (f32x4_t){0.f, 0.f, 0.f, 0.f}; da[ct] = dw[ct]; dv[ct] = dw[ct];
#pragma unroll
                for (int ks2 = 0; ks2 < 2; ++ks2) {
                    dw[ct] = __builtin_amdgcn_mfma_f32_16x16x32_bf16(fw[ks2], bfr[(2 * ct + ks2) * 64 + lane], dw[ct], 0, 0, 0);
                    da[ct] = __builtin_amdgcn_mfma_f32_16x16x32_bf16(fa[ks2], bfr[(8 + 2 * ct + ks2) * 64 + lane], da[ct], 0, 0, 0);
                }
                if (VRES) dv[ct] = __builtin_amdgcn_mfma_f32_16x16x32_bf16(fv, bfr[(16 + ct) * 64 + lane], dv[ct], 0, 0, 0);
            }
            asm volatile("" ::: "memory");
            const int g4 = lane >> 4;
#pragma unroll
            for (int i = 0; i < 4; ++i) {
                const float pw = w0 + (g4 == 0 ? dw[0][i] : g4 == 1 ? dw[1][i] : g4 == 2 ? dw[2][i] : dw[3][i]), pa = a0 + (g4 == 0 ? da[0][i] : g4 == 1 ? da[1][i] : g4 == 2 ? da[2][i] : da[3][i]);
                const float z = -pw, sp = fmaxf(z, 0.f) + log1pf(expf(-fabsf(z)));
                const float dec = expf(-expf(-sp - 0.5f));
                const float a = sigmoidf_(pa);
                float vv = vs[i];
                if (VRES) { const float pvv = v0 + (g4 == 0 ? dv[0][i] : g4 == 1 ? dv[1][i] : g4 == 2 ? dv[2][i] : dv[3][i]); vv = vs[i] + (bf2f(vfr[i]) - vs[i]) * sigmoidf_(pvv); }
                else vfirst[(row0 + t0 + i) * 512 + hc] = f2bf(vs[i]);
                float kk = ks[i] * k_k; const float nrm = sqrtf(wave_sum(kk * kk)); kk = kk / fmaxf(nrm, 1e-12f);
                const float kx = ks[i] * (1.f + (a - 1.f) * k_a);
                const int o = (4 * wave + i) * 64 + lane;
                aR[o] = rs[i]; aW[o] = dec; aK[o] = kx; aA[o] = -kk; aB[o] = kk * a; aV[o] = vv;
                bon[i] = wave_sum(rs[i] * kx * r_k) * vv;
            }
        }
        __syncthreads();
        if (c + 1 < SEQ / RW_T) load_raw(c + 1);
#pragma unroll
        for (int i = 0; i < 4; ++i) gt[i] = proj[(row0 + t0 + i) * PO + O_G + 512 + hc];
        if (wave < 4) {
            const int vA = 16 * wave + rho, vB = vA + 8;
#pragma unroll 2
            for (int tt = 0; tt < RW_T; ++tt) {
                const LAS f32x2* pa = (const LAS f32x2*)(aA + tt * 64 + 8 * sig); const LAS f32x2* pb = (const LAS f32x2*)(aB + tt * 64 + 8 * sig);
                const LAS f32x2* pw = (const LAS f32x2*)(aW + tt * 64 + 8 * sig); const LAS f32x2* pk = (const LAS f32x2*)(aK + tt * 64 + 8 * sig);
                const LAS f32x2* prr = (const LAS f32x2*)(aR + tt * 64 + 8 * sig);
                const float va = aV[tt * 64 + vA], vb_ = aV[tt * 64 + vB];
                f32x2 accA = (f32x2){0.f, 0.f}, accB = (f32x2){0.f, 0.f};
#pragma unroll
                for (int j = 0; j < 4; ++j) { const f32x2 a2 = pa[j]; accA += sA[j] * a2; accB += sB[j] * a2; }
                const float saA = red8(accA.x + accA.y), saB = red8(accB.x + accB.y);
                f32x2 yA = (f32x2){0.f, 0.f}, yB = (f32x2){0.f, 0.f};
#pragma unroll
                for (int j = 0; j < 4; ++j) { const f32x2 w2 = pw[j], b2 = pb[j], k2 = pk[j], r2 = prr[j];
                    sA[j] = sA[j] * w2 + saA * b2 + va * k2; sB[j] = sB[j] * w2 + saB * b2 + vb_ * k2;
                    yA += sA[j] * r2; yB += sB[j] * r2; }
                const float ya = red8(yA.x + yA.y), yb = red8(yB.x + yB.y);
                if (sig == 0) { aY[tt * 64 + vA] = ya; aY[tt * 64 + vB] = yb; }
            }
        }
        __syncthreads();
#pragma unroll
        for (int i = 0; i < 4; ++i) {
            const float y = aY[(4 * wave + i) * 64 + lane];
            const float mean = wave_sum(y) * (1.f / 64.f), dy = y - mean, var = wave_sum(dy * dy) * (1.f / 64.f);
            const float yn = dy * rsqrtf(var + 64e-5f) * lw + lb;
            proj[(row0 + t0 + i) * PO + O_G + 512 + hc] = f2bf((yn + bon[i]) * bf2f(gt[i]));
        }
    }
    __syncthreads();
}

constexpr int LDS_VBUF = 0, LDS_SLOT = 147456 - 64;
DI int next_chunk(unsigned* counter, LAS unsigned* slot) {
    __syncthreads();
    if (threadIdx.x == 0) *slot = atomicAdd(counter, 1u);
    __syncthreads();
    return (int)*slot;
}
constexpr int NWAVES = 8, LDS_BYTES = 147456, GRID = 256;
template <class E> struct PgEpi {
    static constexpr bool PERM = true, AFTER_DRAIN = false;
    E e;
    DI void operator()(const pg8::f32x4 (&acc)[2][2][4][2], const pg8::Unit& u, int wr, int wc, int fr, int fq) const {
        const int row0 = u.pm * 256 + wr * 64 + fr, col0 = u.pn * 256 + wc * 32 + 8 * fq;
#pragma unroll
        for (int ai = 0; ai < 2; ++ai)
#pragma unroll
            for (int m = 0; m < 4; ++m) {
                const int row = row0 + ai * 128 + m * 16;
                const float rs = e.rowscale(row);
                float ss = 0.f;
#pragma unroll
                for (int bj = 0; bj < 2; ++bj) {
                    const pg8::f32x4 a0 = acc[ai][bj][m][0], a1 = acc[ai][bj][m][1];
                    float v[8] = {a0[0], a0[1], a0[2], a0[3], a1[0], a1[1], a1[2], a1[3]};
                    ss += e.apply(row, col0 + bj * 128, v, rs);
                }
                if (E::HAS_SSQ) { ss += __shfl_xor(ss, 16); ss += __shfl_xor(ss, 32); if (fq == 0) e.put_ssq(row, u.pn, wc, ss); }
                asm volatile("" ::: "memory");
            }
    }
};
template <int M, int N, int K, int LDA, class E> DI void run_gemm(pg8::PG8_LAS_T* lds, const bf16_t* A, const bf16_t* Bt, const E& e) {
    int bid = blockIdx.x; asm volatile("" : "+s"(bid));
    pg8::Gemm<M, N, K, LDA> g{A, Bt}; pg8::StaticOrder S; S.init(M, N, GRID, bid);
    PgEpi<E> pe{e};
    pg8::gemm_phase<PgEpi<E>, pg8::StaticOrder, true, true>(lds, g, S, pe);
}

namespace cg = cooperative_groups;

struct Args { const void* in[51]; float* out; unsigned char* ws; };
static_assert(sizeof(Args) == 53 * 8, "no padding");

__global__ void __launch_bounds__(NWAVES * 64, 2) mega(Args a) {
    extern __shared__ __attribute__((aligned(16))) unsigned char lds[];
    cg::grid_group grid = cg::this_grid();
    const int tid = threadIdx.x, wave = __builtin_amdgcn_readfirstlane(tid >> 6);
    const int G = gridDim.x, gw = blockIdx.x * NWAVES + wave, ngw = G * NWAVES;
    pg8::PG8_LAS_T* lds3 = (pg8::PG8_LAS_T*)lds;
#define WSB() ({ unsigned char* p_ = a.ws; asm volatile("" : "+s"(p_)); p_; })
#define ws WSB()
#define out ({ float* o_ = a.out; asm volatile("" : "+s"(o_)); o_; })
#define ssq ((float*)(ws + WS_SSQ))
#define cqsq ((float*)(ws + WS_CQSQ))
#define ckvsq ((float*)(ws + WS_CKVSQ))
#define mrstd ((float*)(ws + WS_MRSTD))
#define tabA ((float2*)(ws + WS_TABA))
#define tabR ((float2*)(ws + WS_TABR))
#define tabM ((float2*)(ws + WS_TABM))
#define wmem ((bf16_t*)(ws + WS_WMEM))
#define memb ((bf16_t*)(ws + WS_MEMB))
#define memkv ((bf16_t*)(ws + WS_MEMKV))
#define vfirst ((bf16_t*)(ws + WS_VFIRST))
#define xb ((bf16_t*)(ws + WS_XB))
#define mlakv ((bf16_t*)(ws + WS_XB))
#define mlaq ((bf16_t*)(ws + WS_MLAQ))
#define proj ((bf16_t*)(ws + WS_PROJ))
    const void* const* kin = (const void* const*)__builtin_amdgcn_kernarg_segment_ptr();
#define FIN(i) ((const float*)kin[i])
#define WI(l) ((bf16_t*)(ws + ((l) == 0 ? WS_WI0 : (l) == 1 ? WS_WI1 : (l) == 2 ? WS_WI2 : WS_WI3)))
#define WO(l) ((bf16_t*)(ws + WS_WO + (size_t)(l) * 2560 * 1024))
#define WQB(o) ((bf16_t*)(ws + WS_WQB + (size_t)(o) * 512 * 1024))
#define WKVB(o) ((bf16_t*)(ws + WS_WKVB + (size_t)(o) * 256 * 1024))

    {
        float* scr = (float*)lds + wave * (64 * 33);
        int base = 0;
#pragma unroll 1
        for (int l = 0; l < 4; ++l) {
            const bool odd = l & 1; const int dcols = l == 3 ? 1696 : 1664;
            const int i_norm = l == 0 ? 5 : l == 1 ? 9 : l == 2 ? 27 : 31, i_win = i_norm + 1;
            const int i_wmem = l == 0 ? 7 : l == 1 ? 25 : l == 2 ? 29 : 49, i_wout = i_wmem + 1;
            wconv_job(scr, gw, ngw, base, FIN(i_win), 1024, odd ? 416 + dcols + 256 + 1280 : 4096, WI(l), odd ? PO : PE, 0, odd ? 2 : 1, dcols, FIN(i_norm));
            wconv_job(scr, gw, ngw, base, FIN(i_wout), 1280, 1024, WO(l), 1024, 0, 0, 0, (const float*)nullptr);
            wconv_job(scr, gw, ngw, base, FIN(i_wmem), 1024, 512, wmem, 512, l * 512, 0, 0, FIN(3));
        }
#pragma unroll 1
        for (int o = 0; o < 2; ++o) {
            wconv_job(scr, gw, ngw, base, FIN(o ? 34 : 12), 256, 768, WQB(o), 1024, 0, 3, 0, FIN(o ? 33 : 11));
            wconv_job(scr, gw, ngw, base, FIN(o ? 36 : 14), 128, 1024, WKVB(o), 1024, 0, 0, 0, FIN(o ? 35 : 13));
        }
#pragma unroll 1
        for (int o = 0; o < 2; ++o) {
            bf16_t* lt = (bf16_t*)(ws + WS_LORA + (size_t)o * 262144);
            wconv_job(scr, gw, ngw, base, FIN(o ? 39 : 17), 64, 512, lt, 512, 0, 0, 0, (const float*)nullptr);
            wconv_job(scr, gw, ngw, base, FIN(o ? 41 : 19), 64, 512, lt + 32768, 512, 0, 0, 0, (const float*)nullptr);
            if (o) wconv_job(scr, gw, ngw, base, FIN(43), 32, 512, lt + 65536, 512, 0, 0, 0, (const float*)nullptr);
        }
        tables_rows(gw, ngw, (const int*)kin[2], tabA, tabR, tabM);
        rows_prep(gw, ngw, FIN(0), xb, ssq, MTOK, 0);
        rows_prep(gw, ngw, FIN(1), memb, mrstd, MROWS, 1);
    }
    grid.sync();
    run_gemm<MROWS, 2048, DM, DM>(lds3, memb, wmem, EpiMemKV{memkv, mrstd});
#pragma unroll 1
    for (int l = 0; l < 4; ++l) {
        const float* resid = l == 0 ? FIN(0) : out;
        const int i_wmem = l == 0 ? 7 : l == 1 ? 25 : l == 2 ? 29 : 49;
        if ((l & 1) == 0) {
            run_gemm<MTOK, PE, DM, DM>(lds3, xb, WI(l), EpiEvenIn{proj, ssq, tabA, tabR});
            grid.sync();
            {
                LAS unsigned char* vbuf = (LAS unsigned char*)lds + LDS_VBUF + wave * 8192; LAS unsigned* slot = (LAS unsigned*)((LAS unsigned char*)lds + LDS_SLOT);
                for (;;) {
                    const int c = next_chunk((unsigned*)(ws + WS_CTL) + 64 * (1 + l), slot);
                    if (c >= 2048) break;
                    if (c < 512) unitRet(vbuf, proj, 2 * (c & 7) + (wave >> 2), wave & 3, 63 - (c >> 3));
                    else if (c < 1536) { const int c2 = c - 512; unitA(vbuf, proj, (c2 & 63) >> 2, wave, c2 & 3, 15 - (c2 >> 6)); }
                    else { const int c3 = c - 1536; unitMem(vbuf, proj, PE, E_QM, E_G + 1024, memkv, l, c3 >> 5, wave & 3, 2 * (c3 & 31) + (wave >> 2)); }
                }
            }
            grid.sync();
            run_gemm<MTOK, DM, 1280, PE>(lds3, proj + E_G, WO(l), EpiWOut{resid, out, xb, ssq});
            grid.sync();
        } else {
            const int o = l >> 1;
            run_gemm<MTOK, PO, DM, DM>(lds3, xb, WI(l), EpiOddIn{proj, ssq, tabM, cqsq, ckvsq});
            grid.sync();
            run_gemm<MTOK, 1024, 256, PO>(lds3, proj + O_CQ, WQB(o), EpiMlaQ{mlaq, cqsq, tabM});
            run_gemm<MTOK, 1024, 128, PO>(lds3, proj + O_CKV, WKVB(o), EpiMlaKV{mlakv, ckvsq});
            grid.sync();
            {
                LAS unsigned char* vbuf = (LAS unsigned char*)lds + LDS_VBUF + wave * 8192; LAS unsigned* slot = (LAS unsigned*)((LAS unsigned char*)lds + LDS_SLOT);
                for (;;) {
                    const int c = next_chunk((unsigned*)(ws + WS_CTL) + 64 * (1 + l), slot);
                    if (c >= 1664) break;
                    if (c < 128) {
                        const bf16_t* lt = (const bf16_t*)(ws + WS_LORA + (size_t)o * 262144);
                        if (l == 1) { const RwkvW W{FIN(15), FIN(16), FIN(17), FIN(18), FIN(19), nullptr, nullptr, FIN(20), FIN(21), FIN(22), FIN(23), FIN(24)}; rwkv_unit<false>((LAS unsigned char*)lds, proj, vfirst, lt, W, c); }
                        else { const RwkvW W{FIN(37), FIN(38), FIN(39), FIN(40), FIN(41), FIN(42), FIN(43), FIN(44), FIN(45), FIN(46), FIN(47), FIN(48)}; rwkv_unit<true>((LAS unsigned char*)lds, proj, vfirst, lt, W, c); }
                    } else if (c < 1152) { const int c2 = c - 128; unitMla(vbuf, proj, mlaq, mlakv, c2 & 15, wave, 63 - (c2 >> 4)); }
                    else { const int c3 = c - 1152; unitMem(vbuf, proj, PO, O_QM, O_G + 1024, memkv, l, c3 >> 5, wave & 3, 2 * (c3 & 31) + (wave >> 2)); }
                }
            }
            grid.sync();
            run_gemm<MTOK, DM, 1280, PO>(lds3, proj + O_G, WO(l), EpiWOut{resid, out, xb, ssq});
            grid.sync();
        }
    }
    final_norm_rows(gw, ngw, out, FIN(4));
}

#undef WSB
#undef ws
#undef out
#undef ssq
#undef cqsq
#undef ckvsq
#undef mrstd
#undef tabA
#undef tabR
#undef tabM
#undef wmem
#undef memb
#undef memkv
#undef vfirst
#undef xb
#undef mlakv
#undef mlaq
#undef proj
#undef FIN
#undef WI
#undef WO
#undef WQB
#undef WKVB
extern "C" void kernel_launch(void* const* d_in, const int* in_sizes, int n_in, void* d_out, int out_size, void* d_ws, size_t ws_size, hipStream_t stream) {
    static int grid = 0;
    if (grid == 0) {
        if (n_in != 51 || ws_size < WS_END) { fprintf(stderr, "kernel_launch: unexpected n_in %d / ws %zu\n", n_in, ws_size); grid = -1; return; }
        int dev = 0, cus = 0, per_cu = 0;
        hipGetDevice(&dev); hipDeviceGetAttribute(&cus, hipDeviceAttributeMultiprocessorCount, dev);
        hipFuncSetAttribute((const void*)mega, hipFuncAttributeMaxDynamicSharedMemorySize, LDS_BYTES);
        hipOccupancyMaxActiveBlocksPerMultiprocessor(&per_cu, (const void*)mega, NWAVES * 64, LDS_BYTES);
        if (per_cu < 1) { fprintf(stderr, "kernel_launch: occupancy query says %d blocks per CU\n", per_cu); per_cu = 1; }
        if (cus * per_cu < GRID) { fprintf(stderr, "kernel_launch: device holds %d x %d workgroups, kernel is built for %d\n", cus, per_cu, GRID); grid = -1; return; }
        grid = GRID;
    }
    if (grid < 0) return;
    if (hipMemsetAsync((char*)d_ws + WS_CTL, 0, 4096, stream) != hipSuccess) { fprintf(stderr, "kernel_launch: memset failed\n"); return; }
    Args a{};
    for (int i = 0; i < 51; ++i) a.in[i] = d_in[i];
    a.out = (float*)d_out; a.ws = (unsigned char*)d_ws;
    void* args[] = {&a};
    hipError_t e = hipLaunchCooperativeKernel((const void*)mega, dim3(grid), dim3(NWAVES * 64), args, LDS_BYTES, stream);
    if (e != hipSuccess) fprintf(stderr, "cooperative launch failed: %s (grid %d)\n", hipGetErrorString(e), grid);
}
```

```cpp
#include <hip/hip_runtime.h>
#ifndef PROBE_TS_A
#define PROBE_TS_A -1
#define PROBE_TS_B -1
#define PROBE_TS_PH 0.5f
#define PROBE_TS_R 1.5f
#endif
#ifndef PROBE_ODD
#define PROBE_ODD 0
#endif
#ifndef PROBE_DUP
#define PROBE_DUP 0
#endif
#include <hip/hip_cooperative_groups.h>
#include <stdint.h>
#include <cstdio>

typedef unsigned short bf16_t;
typedef unsigned u32x4 __attribute__((ext_vector_type(4)));
typedef float f32x4 __attribute__((ext_vector_type(4)));
#define DI __device__ __forceinline__

constexpr int BATCH = 16, SEQ = 2048, DM = 1024, MTOK = BATCH * SEQ, MEMT = 256, MROWS = BATCH * MEMT;
constexpr int PEN = 4096, PE = 4160, PO = 3840;
constexpr int E_QA = 0, E_KA = 512, E_VA = 1024, E_QR = 1536, E_KR = 1792, E_VR = 2048, E_QM = 2560, E_G = 2816;
constexpr int O_CQ = 0, O_CKV = 256, O_KR = 384, O_R = 512, O_K = 1024, O_V = 1536, O_WD = 2048, O_AD = 2112, O_MV = 2176, O_QM = 2304, O_G = 2560;
constexpr float NORM_EPS = 1e-6f, LOG2E = 1.4426950408889634f;
constexpr float QSCALE = 0.125f * LOG2E;
constexpr float QSCALE_MLA = 0.10206207261596575f * LOG2E;

constexpr size_t MiB = 1u << 20;
constexpr size_t WS_LORA = 5 * MiB;
constexpr size_t WS_CTL = 0, WS_SSQ = 1 * MiB, WS_CQSQ = 3 * MiB, WS_CKVSQ = 3 * MiB + 512 * 1024, WS_MRSTD = 4 * MiB;
constexpr size_t WS_TABA = 8 * MiB, WS_TABR = 10 * MiB, WS_TABM = 18 * MiB;
constexpr size_t WS_WI0 = 24 * MiB, WS_WI1 = 32 * MiB, WS_WI2 = WS_WI1 + 7680 * 1024, WS_WI3 = WS_WI2 + 8 * MiB;
constexpr size_t WS_WO = 55 * MiB;
constexpr size_t WS_WMEM = 65 * MiB;
constexpr size_t WS_WQB = 69 * MiB;
constexpr size_t WS_WKVB = WS_WQB + 1024 * 1024;
constexpr size_t WS_MEMB = 72 * MiB, WS_MEMKV = 80 * MiB, WS_VFIRST = 96 * MiB, WS_XB = 128 * MiB, WS_MLAQ = 192 * MiB, WS_PROJ = 256 * MiB;
constexpr size_t WS_END = 512 * MiB;

DI int olane() { int l; asm volatile("v_and_b32 %0, 63, %1" : "=v"(l) : "v"(threadIdx.x)); return l; }
DI float bf2f(bf16_t v) { return __uint_as_float((unsigned)v << 16); }
DI bf16_t f2bf(float f) { unsigned u = __float_as_uint(f); return (bf16_t)((u + 0x7fffu + ((u >> 16) & 1u)) >> 16); }
DI unsigned pk2(float lo, float hi) { return (unsigned)f2bf(lo) | ((unsigned)f2bf(hi) << 16); }
DI float wave_sum(float v) {
#pragma unroll
    for (int o = 1; o < 64; o <<= 1) v += __shfl_xor(v, o);
    return v;
}
DI float siluf(float x) { return x / (1.f + __expf(-x)); }
DI float sigmoidf_(float x) { return 1.f / (1.f + __expf(-x)); }

DI int phys2log(int mapid, int p, int aux) {
    if (mapid == 1) {
        if (p < 1024) { const int pos = p & 63, base = p & ~63; return pos < 16 ? base + (pos & 1) * 8 + (pos >> 1) : p; }
        if (p >= 1536 && p < 2048) { const int pos = p & 63, base = p & ~63; return base + (pos & 1) * 32 + (pos >> 1); }
        return p;
    }
    if (mapid == 2) {
        if (p < 384) return p;
        if (p < 416) { const int pos = p - 384; return 384 + (pos & 1) * 16 + (pos >> 1); }
        if (p < 512) return -1;
        if (p < 2048) return 416 + (p - 512);
        if (p < 2176) return 416 + 1536 + (p - 2048);
        if (p < 2208) return aux > 1664 ? 416 + 1664 + (p - 2176) : -1;
        if (p < 2304) return -1;
        if (p < 2560) return 416 + aux + (p - 2304);
        return 416 + aux + 256 + (p - 2560);
    }
    if (mapid == 3) {
        const int hh = p >> 7, pos = p & 127;
        if (pos < 64) return hh * 96 + pos;
        if (pos >= 96) return -1;
        const int pp = pos - 64; return hh * 96 + 64 + (pp & 1) * 16 + (pp >> 1);
    }
    return p;
}


DI void wconv_job(float* scr, int gw, int ngw, int& base, const float* __restrict__ W, int K, int Nsrc, bf16_t* __restrict__ dst, int Nphys, int row_off, int mapid, int aux, const float* __restrict__ gain) {
    const int lane = olane();
    const int nblk = Nphys / 32, kblk = (K + 63) / 64, nitems = nblk * kblk;
    int first = (gw - base % ngw + ngw) % ngw; base += nitems;
    for (int item = first; item < nitems; item += ngw) {
        const int kb = item / nblk, nb = item % nblk, k0 = 64 * kb, n0 = 32 * nb;
        const int nl = phys2log(mapid, n0 + (lane & 31), aux);
        const float* src = W + (nl < 0 ? 0 : nl); const int kh = lane >> 5;
        float v[32], g[32];
#pragma unroll
        for (int i = 0; i < 32; ++i) { const int kq = k0 + 2 * i + kh, kc = kq < K ? kq : K - 1; v[i] = src[(size_t)kc * Nsrc]; g[i] = gain ? gain[kc] : 1.f; }
        __builtin_amdgcn_sched_barrier(0);
#pragma unroll
        for (int i = 0; i < 32; ++i) { const int kk = 2 * i + kh; scr[kk * 33 + (lane & 31)] = (nl >= 0 && k0 + kk < K) ? v[i] * g[i] : 0.f; }
        asm volatile("s_waitcnt lgkmcnt(0)" ::: "memory");
        const int c = lane & 7;
        if (k0 + 8 * c < K) {
#pragma unroll
            for (int j = 0; j < 4; ++j) {
                const int n = (lane >> 3) + 8 * j; const float* s = scr + (8 * c) * 33 + n;
                u32x4 o; o.x = pk2(s[0], s[33]); o.y = pk2(s[66], s[99]); o.z = pk2(s[132], s[165]); o.w = pk2(s[198], s[231]);
                *(u32x4*)(dst + (size_t)(row_off + n0 + n) * K + k0 + 8 * c) = o;
            }
        }
        asm volatile("s_waitcnt lgkmcnt(0)" ::: "memory");
    }
}
DI void rows_prep(int gw, int ngw, const float* __restrict__ x, bf16_t* __restrict__ xb, float* __restrict__ stat, int R, int mode) {
    const int lane = olane();
    f32x4 v[4][4], vn[4][4];
    int r0 = 4 * gw;
    if (r0 < R) {
#pragma unroll
        for (int q = 0; q < 4; ++q) { const f32x4* xr = (const f32x4*)(x + (size_t)(r0 + q) * DM) + lane;
#pragma unroll
            for (int j = 0; j < 4; ++j) v[q][j] = xr[64 * j]; }
    }
    for (; r0 < R; r0 += 4 * ngw) {
        const int rn = r0 + 4 * ngw < R ? r0 + 4 * ngw : r0;
#pragma unroll
        for (int q = 0; q < 4; ++q) { const f32x4* xr = (const f32x4*)(x + (size_t)(rn + q) * DM) + lane;
#pragma unroll
            for (int j = 0; j < 4; ++j) vn[q][j] = xr[64 * j]; }
        asm volatile("" ::: "memory");
#pragma unroll
        for (int q = 0; q < 4; ++q) {
            float s = 0.f;
            unsigned long long* o8 = (unsigned long long*)(xb + (size_t)(r0 + q) * DM) + lane;
#pragma unroll
            for (int j = 0; j < 4; ++j) { const f32x4 w = v[q][j]; s += w.x * w.x + w.y * w.y + w.z * w.z + w.w * w.w;
                o8[64 * j] = (unsigned long long)pk2(w.x, w.y) | ((unsigned long long)pk2(w.z, w.w) << 32); }
            s = wave_sum(s);
            if (mode == 0) { if (lane < 16) stat[(size_t)(r0 + q) * 16 + lane] = lane == 0 ? s : 0.f; }
            else if (lane == 0) stat[r0 + q] = rsqrtf(s * (1.f / DM) + NORM_EPS);
        }
#pragma unroll
        for (int q = 0; q < 4; ++q)
#pragma unroll
            for (int j = 0; j < 4; ++j) v[q][j] = vn[q][j];
    }
}
DI void tables_rows(int gw, int ngw, const int* __restrict__ positions, float2* __restrict__ tabA, float2* __restrict__ tabR, float2* __restrict__ tabM) {
    const int i = olane();
    float theta = 500000.f, dim = 16.f; int j = i, kind = 0;
    if (i >= 8 && i < 40) { theta = 10000.f; dim = 64.f; j = i - 8; kind = 1; }
    else if (i >= 40) { dim = 32.f; j = i - 40; kind = 2; }
    const float inv = expf((-logf(theta) * (float)(2 * j)) / dim);
    for (int row = gw; row < MTOK; row += ngw) {
        const float ang = (float)positions[row] * inv;
        float sn, cs; sincosf(ang, &sn, &cs);
        const float2 v = make_float2(cs, sn);
        if (kind == 0) tabA[(size_t)row * 8 + j] = v; else if (kind == 1) tabR[(size_t)row * 32 + j] = v; else if (i < 56) tabM[(size_t)row * 16 + j] = v;
    }
}

DI unsigned cvtpk(float lo, float hi) { typedef float f2 __attribute__((ext_vector_type(2))); typedef __bf16 b2 __attribute__((ext_vector_type(2))); f2 v = {lo, hi}; return __builtin_bit_cast(unsigned, __builtin_convertvector(v, b2)); }
DI void store8(bf16_t* p, const float* v) { u32x4 o; o.x = cvtpk(v[0], v[1]); o.y = cvtpk(v[2], v[3]); o.z = cvtpk(v[4], v[5]); o.w = cvtpk(v[6], v[7]); *(u32x4*)p = o; }
DI void rot4(float* v, const float2* cs, bool on) {
#pragma unroll
    for (int j = 0; j < 4; ++j) { const float2 c = cs[j]; const float a = v[2 * j], b = v[2 * j + 1]; const float ra = a * c.x - b * c.y, rb = a * c.y + b * c.x; v[2 * j] = on ? ra : a; v[2 * j + 1] = on ? rb : b; }
}
struct Tab8 { f32x4 a, b; };
struct NoTab {};
DI Tab8 tab8_load(const float2* p) { const f32x4* q = (const f32x4*)p; return Tab8{q[0], q[1]}; }
DI void rot4t(float* v, const Tab8& t, bool on) {
    const float cs[8] = {t.a.x, t.a.y, t.a.z, t.a.w, t.b.x, t.b.y, t.b.z, t.b.w};
#pragma unroll
    for (int j = 0; j < 4; ++j) { const float a = v[2 * j], b = v[2 * j + 1]; const float ra = a * cs[2 * j] - b * cs[2 * j + 1], rb = a * cs[2 * j + 1] + b * cs[2 * j]; v[2 * j] = on ? ra : a; v[2 * j + 1] = on ? rb : b; }
}
DI float fsilu(float x) { return x * __builtin_amdgcn_rcpf(1.f + __builtin_amdgcn_exp2f(-LOG2E * x)); }
struct Pre16 { f32x4 a, b, c, d; };
DI Pre16 ssq16_load(const float* ssq, int row) { const f32x4* p = (const f32x4*)(ssq + (size_t)row * 16); return Pre16{p[0], p[1], p[2], p[3]}; }
DI float ssq16_rstd(const Pre16& q, float invn) {
    const float s = (q.a.x + q.a.y + q.a.z + q.a.w) + (q.b.x + q.b.y + q.b.z + q.b.w) + (q.c.x + q.c.y + q.c.z + q.c.w) + (q.d.x + q.d.y + q.d.z + q.d.w);
    return rsqrtf(s * invn + NORM_EPS);
}
DI void xpair32(float x, float& a, float& b) { const auto r = __builtin_amdgcn_permlane32_swap(__float_as_uint(x), __float_as_uint(x), false, false); a = __uint_as_float(r[0]); b = __uint_as_float(r[1]); }
DI void xpair16(float x, float& a, float& b) { const auto r = __builtin_amdgcn_permlane16_swap(__float_as_uint(x), __float_as_uint(x), false, false); a = __uint_as_float(r[0]); b = __uint_as_float(r[1]); }
DI float xadd32(float x) { float a, b; xpair32(x, a, b); return a + b; }
DI float xadd16(float x) { float a, b; xpair16(x, a, b); return a + b; }
struct Pre4 { f32x4 a; };
DI Pre4 ssq16q_load(const float* ssq, int row, int col0) { return Pre4{*(const f32x4*)(ssq + (size_t)row * 16 + 4 * ((col0 >> 3) & 3))}; }
DI float ssq16q_rstd(const Pre4& q, float invn) { float s = (q.a.x + q.a.y) + (q.a.z + q.a.w); s = xadd32(xadd16(s)); return rsqrtf(s * invn + NORM_EPS); }
DI float ssq4_rstd(const Pre4& q, float invn) { return rsqrtf((q.a.x + q.a.y + q.a.z + q.a.w) * invn + NORM_EPS); }

struct EpiEvenIn {
    static constexpr bool HAS_SSQ = false; static constexpr int NKIND = 7; DI void put_ssq(int, int, int, float) const {}
    bf16_t* out; const float* ssq; const float2* tabA; const float2* tabR;
    DI int kind(int pn) const { return pn < 2 ? 0 : pn < 4 ? 1 : pn < 6 ? 2 : pn == 6 ? 3 : pn == 7 ? 4 : pn < 10 ? 2 : pn == 10 ? 5 : 6; }
    typedef Pre4 Pre;
    DI Pre prefetch(int row, int col0) const { return ssq16q_load(ssq, row, col0); }
    DI float rowscale(const Pre& q) const { return ssq16q_rstd(q, 1.f / DM); }
    typedef Tab8 Tab;
    template <int KIND> DI Tab tab(int row, int col0) const {
        const int pos = col0 & 63;
        if (KIND == 0 || KIND == 1) return tab8_load(tabA + (size_t)row * 8 + ((pos & 8) >> 1));
        if (KIND == 3 || KIND == 4) return tab8_load(tabR + (size_t)row * 32 + (pos >> 1));
        return Tab8{};
    }
    template <int KIND> DI float apply(int row, int c, float* v, float rs, const Pre&, int, const Tab& tb) const {
        if (KIND == 0 || KIND == 1) {
            const int pos = c & 63;
            rot4t(v, tb, pos < 16);
            if (KIND == 0) rs *= QSCALE;
        } else if (KIND == 3 || KIND == 4) {
            const int h = (c & 255) >> 6;
            rot4t(v, tb, true);
            const float lg = h == 0 ? -0.04580368961f : h == 1 ? -0.02272007650f : h == 2 ? -0.011315313228f : -0.005646563141f;
            const float s = (float)(row & (SEQ - 1));
            rs *= KIND == 3 ? __builtin_amdgcn_exp2f(s * lg) : 0.125f * __builtin_amdgcn_exp2f(-s * lg);
        } else if (KIND == 5) rs *= QSCALE;
#pragma unroll
        for (int i = 0; i < 8; ++i) v[i] *= rs;
        if (KIND == 6) {
#pragma unroll
            for (int i = 0; i < 8; ++i) v[i] = fsilu(v[i]);
        }
        store8(out + (size_t)row * PE + c, v);
        return 0.f;
    }
};
struct EpiOddIn {
    static constexpr bool HAS_SSQ = true; static constexpr int NKIND = 5;
    bf16_t* out; const float* ssq; const float2* tabM; float* cqsq; float* ckvsq;
    DI void put_ssq(int row, int pn, int wc, float ss) const { if (pn == 0) cqsq[(size_t)row * 4 + wc] = ss; else if (pn == 1) ckvsq[(size_t)row * 4 + wc] = ss; }
    DI int kind(int pn) const { return pn == 0 ? 0 : pn == 1 ? 1 : pn < 9 ? 2 : pn == 9 ? 3 : 4; }
    typedef Pre4 Pre;
    DI Pre prefetch(int row, int col0) const { return ssq16q_load(ssq, row, col0); }
    DI float rowscale(const Pre& q) const { return ssq16q_rstd(q, 1.f / DM); }
    typedef Tab8 Tab;
    template <int KIND> DI Tab tab(int row, int col0) const { if (KIND == 1) return tab8_load(tabM + (size_t)row * 16 + (((col0 - O_KR) & 31) >> 1)); return Tab8{}; }
    template <int KIND> DI float apply(int row, int c, float* v, float rs, const Pre&, int, const Tab& tb) const {
        float ss = 0.f;
        if (KIND == 3) rs *= QSCALE;
#pragma unroll
        for (int i = 0; i < 8; ++i) v[i] *= rs;
        if (KIND == 0 || (KIND == 1 && c < O_KR)) {
#pragma unroll
            for (int i = 0; i < 8; ++i) ss += v[i] * v[i];
        }
        if (KIND == 1) rot4t(v, tb, c >= O_KR && c < O_KR + 32);
        if (KIND == 4) {
#pragma unroll
            for (int i = 0; i < 8; ++i) v[i] = fsilu(v[i]);
        }
        store8(out + (size_t)row * PO + c, v);
        return ss;
    }
};
template <int MODE> struct EpiWOut {
    static constexpr bool HAS_SSQ = true; static constexpr int NKIND = 1;
    const float* resid; float* xo; bf16_t* xb; float* ssq;
    DI void put_ssq(int row, int pn, int wc, float ss) const { ssq[(size_t)row * 16 + pn * 4 + wc] = ss; }
    DI int kind(int) const { return 0; }
    struct Pre { f32x4 r[MODE == 0 ? 4 : 2]; };
    DI Pre prefetch(int row, int col0) const {
        if (MODE == 0) { const f32x4* p = (const f32x4*)(resid + (size_t)row * DM + col0); Pre q; q.r[0] = p[0]; q.r[1] = p[1]; q.r[2] = p[32]; q.r[3] = p[33]; return q; }
        const f32x4* p = (const f32x4*)(xb + (size_t)row * DM + col0); Pre q; q.r[0] = p[0]; q.r[1] = p[16]; return q;
    }
    DI float rowscale(const Pre&) const { return 1.f; }
    typedef NoTab Tab; template <int KIND> DI Tab tab(int, int) const { return NoTab{}; }
    template <int KIND> DI float apply(int row, int c, float* v, float, const Pre& q, int bj, const Tab&) const {
        if (MODE == 0) { const f32x4 r0 = q.r[2 * bj], r1 = q.r[2 * bj + 1];
            v[0] += r0.x; v[1] += r0.y; v[2] += r0.z; v[3] += r0.w; v[4] += r1.x; v[5] += r1.y; v[6] += r1.z; v[7] += r1.w; }
        else { const u32x4 w = __builtin_bit_cast(u32x4, q.r[bj]);
            v[0] += __uint_as_float(w.x << 16); v[1] += __uint_as_float(w.x & 0xffff0000u); v[2] += __uint_as_float(w.y << 16); v[3] += __uint_as_float(w.y & 0xffff0000u);
            v[4] += __uint_as_float(w.z << 16); v[5] += __uint_as_float(w.z & 0xffff0000u); v[6] += __uint_as_float(w.w << 16); v[7] += __uint_as_float(w.w & 0xffff0000u); }
        if (MODE == 2) { f32x4* o = (f32x4*)(xo + (size_t)row * DM + c); o[0] = (f32x4){v[0], v[1], v[2], v[3]}; o[1] = (f32x4){v[4], v[5], v[6], v[7]}; }
        else store8(xb + (size_t)row * DM + c, v);
        float ss = 0.f;
#pragma unroll
        for (int i = 0; i < 8; ++i) ss += v[i] * v[i];
        return ss;
    }
};
struct EpiMemKV {
    static constexpr bool HAS_SSQ = false; static constexpr int NKIND = 1; DI void put_ssq(int, int, int, float) const {}
    bf16_t* out; const float* rstd;
    DI int kind(int) const { return 0; }
    struct Pre { float r; };
    DI Pre prefetch(int row, int) const { return Pre{rstd[row]}; }
    DI float rowscale(const Pre& q) const { return q.r; }
    typedef NoTab Tab; template <int KIND> DI Tab tab(int, int) const { return NoTab{}; }
    template <int KIND> DI float apply(int row, int c, float* v, float rs, const Pre&, int, const Tab&) const {
#pragma unroll
        for (int i = 0; i < 8; ++i) v[i] *= rs;
        store8(out + (size_t)row * 2048 + c, v); return 0.f;
    }
};
struct EpiMlaQ {
    static constexpr bool HAS_SSQ = false; static constexpr int NKIND = 1; DI void put_ssq(int, int, int, float) const {}
    bf16_t* out; const float* cqsq; const float2* tabM;
    DI int kind(int) const { return 0; }
    typedef Pre4 Pre;
    DI Pre prefetch(int row, int) const { return Pre4{*(const f32x4*)(cqsq + (size_t)row * 4)}; }
    DI float rowscale(const Pre& q) const { return ssq4_rstd(q, 1.f / 256.f) * QSCALE_MLA; }
    typedef Tab8 Tab;
    template <int KIND> DI Tab tab(int row, int col0) const { return tab8_load(tabM + (size_t)row * 16 + ((col0 & 31) >> 1)); }
    template <int KIND> DI float apply(int row, int c, float* v, float rs, const Pre&, int, const Tab& tb) const {
        const int pos = c & 127;
        rot4t(v, tb, pos >= 64 && pos < 96);
#pragma unroll
        for (int i = 0; i < 8; ++i) v[i] *= rs;
        store8(out + (size_t)row * 1024 + c, v); return 0.f;
    }
};
struct EpiMlaKV {
    static constexpr bool HAS_SSQ = false; static constexpr int NKIND = 1; DI void put_ssq(int, int, int, float) const {}
    bf16_t* out; const float* ckvsq;
    DI int kind(int) const { return 0; }
    typedef Pre4 Pre;
    DI Pre prefetch(int row, int) const { return Pre4{*(const f32x4*)(ckvsq + (size_t)row * 4)}; }
    DI float rowscale(const Pre& q) const { return ssq4_rstd(q, 1.f / 128.f); }
    typedef NoTab Tab; template <int KIND> DI Tab tab(int, int) const { return NoTab{}; }
    template <int KIND> DI float apply(int row, int c, float* v, float rs, const Pre&, int, const Tab&) const {
#pragma unroll
        for (int i = 0; i < 8; ++i) v[i] *= rs;
        store8(out + (size_t)row * 1024 + c, v); return 0.f;
    }
};

namespace pg8 {
#define PG8_LAS __attribute__((address_space(3)))
typedef PG8_LAS unsigned char PG8_LAS_T;
typedef unsigned short bf16_t;
typedef short bf16x8 __attribute__((ext_vector_type(8)));
typedef float f32x4 __attribute__((ext_vector_type(4)));
typedef unsigned u32x4 __attribute__((ext_vector_type(4)));
constexpr int BM = 256, BK = 64, HALF = 128, HTB = HALF * BK * 2  , STAGE_BYTES = 8 * HTB, NXCD = 8, WGM = 2;

__host__ __device__ __forceinline__ int lds_byte(int r, int c) { const int st = (r >> 4) * 2 + (c >> 5), rr = r & 15, cc = c & 31, ob = rr * 64 + cc * 2; return st * 1024 + (ob ^ (((ob >> 9) & 1) << 5)); }
__host__ __device__ __forceinline__ void stage_rc(int b, int& R, int& C) { const int st = b / 1024, sb = b % 1024, swz = sb ^ (((sb >> 9) & 1) << 5); R = (st >> 1) * 16 + swz / 64; C = (st & 1) * 32 + (swz % 64) / 2; }
__host__ __device__ __forceinline__ int perm32(int rho) { const int n = rho >> 4, i = rho & 15; return 8 * (i >> 2) + 4 * n + (i & 3); }

struct Unit { int pm, pn; };
template <int M_, int N_, int K_, int LDA_> struct Gemm { const bf16_t* A; const bf16_t* Bt; static constexpr int M = M_, N = N_, K = K_, lda = LDA_; };

struct StaticOrder {
    int nM, nN, nwg, G, c;
    __host__ __device__ void init(int M, int N, int G_, int c_) { nM = M / BM; nN = N / BM; nwg = nM * nN; G = G_; c = c_; }
    __host__ __device__ bool next(int i, Unit& u) const {
        const long L = (long)i * G + c; if (L >= nwg) return false;
        int wgid = (int)L; { const int q = nwg / NXCD, r = nwg % NXCD, xcd = wgid % NXCD, off = wgid / NXCD; wgid = (xcd < r ? xcd * (q + 1) : r * (q + 1) + (xcd - r) * q) + off; }
        const int nig = WGM * nN, gid = wgid / nig, fm = gid * WGM, gsz = (nM - fm) < WGM ? (nM - fm) : WGM;
        u.pm = fm + ((wgid % nig) % gsz); u.pn = (wgid % nig) / gsz; return true;
    }
    __device__ __forceinline__ void a_ready(const Unit&) const {}
    __device__ __forceinline__ void done(const Unit&) const {}
};

template <class Epi, class Sched, bool ALIGN_EPI = false, bool SP2 = false, class GemmT>
__device__ __forceinline__ void gemm_phase(PG8_LAS unsigned char* lds, const GemmT g, const Sched& S, const Epi& E) {
    int tid_ = threadIdx.x; asm volatile("" : "+v"(tid_));
    const int tid = tid_, wid = __builtin_amdgcn_readfirstlane(tid >> 6), lane = tid & 63, wr = wid >> 2, wc = wid & 3, fr = lane & 15, fq = lane >> 4;
    const int K = g.K; int nt = K / BK; asm volatile("" : "+s"(nt));
    unsigned voffA[2], voffB[2];
#pragma unroll
    for (int i = 0; i < 2; ++i) { int R, C; stage_rc(tid * 16 + i * 8192, R, C); const int Rb = Epi::PERM ? ((R & ~31) + perm32(R & 31)) : R;
        voffA[i] = (unsigned)(R * g.lda + C) * 2u; voffB[i] = (unsigned)(Rb * K + C) * 2u; }
    const size_t kstep = (size_t)(BK * 2);
    const size_t hstepA = (size_t)HALF * g.lda * 2, hstepB = (size_t)HALF * K * 2;
    const size_t tstepA = 2 * hstepA, tstepB = 2 * hstepB;
    const unsigned ldsw = (unsigned)wid * 1024u;
    const int aoff = lds_byte(wr * 64 + fr, fq * 8), boff = lds_byte(wc * 32 + fr, fq * 8);
#define PG8_SA(b, h) (((b) * 2 + (h)) * HTB)
#define PG8_SB(b, h) ((4 + (b) * 2 + (h)) * HTB)
#define PG8_STAGE(bufoff, gbase, voff) do { _Pragma("unroll") for (int _i = 0; _i < 2; ++_i) \
        __builtin_amdgcn_global_load_lds((const unsigned*)((const char*)(gbase) + (voff)[_i]), (PG8_LAS unsigned*)(lds + (bufoff) + ldsw + _i * 8192), 16, 0, 0); } while (0)
#define PG8_LDA(dst, b, h) do { _Pragma("unroll") for (int m = 0; m < 4; ++m) _Pragma("unroll") for (int k = 0; k < 2; ++k) dst[m][k] = *(const PG8_LAS bf16x8*)(lds + PG8_SA(b, h) + aoff + m * 2048 + k * 1024); } while (0)
#define PG8_LDB(dst, b, h) do { _Pragma("unroll") for (int n = 0; n < 2; ++n) _Pragma("unroll") for (int k = 0; k < 2; ++k) dst[n][k] = *(const PG8_LAS bf16x8*)(lds + PG8_SB(b, h) + boff + n * 2048 + k * 1024); } while (0)
#define PG8_MMA(ai, bj, At, Bt) do { __builtin_amdgcn_s_setprio(1); _Pragma("unroll") for (int m = 0; m < 4; ++m) _Pragma("unroll") for (int n = 0; n < 2; ++n) _Pragma("unroll") for (int k = 0; k < 2; ++k) \
        acc[ai][bj][m][n] = __builtin_amdgcn_mfma_f32_16x16x32_bf16(Bt[n][k], At[m][k], acc[ai][bj][m][n], 0, 0, 0); __builtin_amdgcn_s_setprio(0); } while (0)
#define PG8_WAIT_V(n) asm volatile("s_waitcnt vmcnt(" #n ")" ::: "memory")
#define PG8_WAIT_L(n) asm volatile("s_waitcnt lgkmcnt(" #n ")" ::: "memory")
#define PG8_BAR __builtin_amdgcn_s_barrier()
#define PG8_SCHED __builtin_amdgcn_sched_barrier(0)
    Unit cur, nxt; int ui = 0;
    if (!S.next(0, cur)) return;
    f32x4 acc[2][2][4][2];
#pragma unroll
    for (int a = 0; a < 2; ++a)
#pragma unroll
        for (int b = 0; b < 2; ++b)
#pragma unroll
            for (int m = 0; m < 4; ++m)
#pragma unroll
                for (int n = 0; n < 2; ++n) acc[a][b][m][n] = (f32x4){0.f, 0.f, 0.f, 0.f};
    bf16x8 At[4][2], B0[2][2], B1[2][2];
    const char* cA = (const char*)g.A + (size_t)cur.pm * tstepA; const char* cB = (const char*)g.Bt + (size_t)cur.pn * tstepB;
    S.a_ready(cur);
    if constexpr (SP2) {
        PG8_STAGE(PG8_SB(0, 0), cB, voffB); PG8_STAGE(PG8_SB(0, 1), cB + hstepB, voffB); PG8_STAGE(PG8_SA(0, 0), cA, voffA); PG8_STAGE(PG8_SA(0, 1), cA + hstepA, voffA);
        if (wr == 1) PG8_BAR;
        PG8_WAIT_V(2); PG8_BAR;
        PG8_STAGE(PG8_SB(1, 0), cB + kstep, voffB); PG8_STAGE(PG8_SA(1, 0), cA + kstep, voffA); PG8_STAGE(PG8_SB(1, 1), cB + hstepB + kstep, voffB);
        PG8_WAIT_V(6); PG8_BAR;
    } else {
        PG8_STAGE(PG8_SB(0, 0), cB, voffB); PG8_STAGE(PG8_SA(0, 0), cA, voffA); PG8_STAGE(PG8_SB(0, 1), cB + hstepB, voffB); PG8_STAGE(PG8_SA(0, 1), cA + hstepA, voffA);
        if (wr == 1) PG8_BAR;
        PG8_WAIT_V(4); PG8_BAR;
        PG8_STAGE(PG8_SB(1, 0), cB + kstep, voffB); PG8_STAGE(PG8_SA(1, 0), cA + kstep, voffA); PG8_STAGE(PG8_SB(1, 1), cB + hstepB + kstep, voffB);
        PG8_WAIT_V(6); PG8_BAR;
    }
    for (;;) {
        const bool has_next = S.next(ui + 1, nxt);
        const char* nA = has_next ? (const char*)g.A + (size_t)nxt.pm * tstepA : cA; const char* nB = has_next ? (const char*)g.Bt + (size_t)nxt.pn * tstepB : cB;
        for (int t = 0; t < nt; t += 2) {
            const bool last = (t == nt - 2);
            const char* a1 = cA + (size_t)(t + 1) * kstep;
            const char* a2 = last ? nA : cA + (size_t)(t + 2) * kstep; const char* b2 = last ? nB : cB + (size_t)(t + 2) * kstep;
            const char* a3 = a2 + kstep; const char* b3 = b2 + kstep;
            if (last && has_next) S.a_ready(nxt);
            if constexpr (SP2) {
            PG8_LDB(B0, 0, 0); PG8_LDB(B1, 0, 1); PG8_SCHED; PG8_LDA(At, 0, 0); PG8_STAGE(PG8_SA(1, 1), a1 + hstepA, voffA);
            PG8_WAIT_V(8); PG8_WAIT_L(0); PG8_BAR; PG8_MMA(0, 0, At, B0); PG8_MMA(0, 1, At, B1); PG8_BAR; PG8_SCHED;
            PG8_LDA(At, 0, 1); PG8_STAGE(PG8_SB(0, 0), b2, voffB); PG8_STAGE(PG8_SB(0, 1), b2 + hstepB, voffB); PG8_STAGE(PG8_SA(0, 0), a2, voffA);
            PG8_WAIT_V(8); PG8_WAIT_L(0); PG8_BAR; PG8_MMA(1, 0, At, B0); PG8_MMA(1, 1, At, B1); PG8_BAR; PG8_SCHED;
            PG8_LDB(B0, 1, 0); PG8_LDB(B1, 1, 1); PG8_SCHED; PG8_LDA(At, 1, 0); PG8_STAGE(PG8_SA(0, 1), a2 + hstepA, voffA);
            PG8_WAIT_V(8); PG8_WAIT_L(0); PG8_BAR; PG8_MMA(0, 0, At, B0); PG8_MMA(0, 1, At, B1); PG8_BAR; PG8_SCHED;
            PG8_LDA(At, 1, 1); PG8_STAGE(PG8_SB(1, 0), b3, voffB); PG8_STAGE(PG8_SB(1, 1), b3 + hstepB, voffB); PG8_STAGE(PG8_SA(1, 0), a3, voffA);
            PG8_WAIT_V(8); PG8_WAIT_L(0); PG8_BAR; PG8_MMA(1, 0, At, B0); PG8_MMA(1, 1, At, B1); PG8_BAR; PG8_SCHED;
            } else {
            PG8_LDB(B0, 0, 0); PG8_SCHED; PG8_LDA(At, 0, 0); PG8_STAGE(PG8_SA(1, 1), a1 + hstepA, voffA);
            PG8_WAIT_L(8); PG8_BAR; PG8_WAIT_L(0); PG8_MMA(0, 0, At, B0); PG8_BAR; PG8_SCHED;
            PG8_LDB(B1, 0, 1); PG8_STAGE(PG8_SB(0, 0), b2, voffB);
            PG8_BAR; PG8_WAIT_L(0); PG8_MMA(0, 1, At, B1); PG8_BAR;
            PG8_LDA(At, 0, 1); PG8_STAGE(PG8_SA(0, 0), a2, voffA);
            PG8_BAR; PG8_WAIT_L(0); PG8_MMA(1, 0, At, B0); PG8_BAR; PG8_SCHED;
            PG8_STAGE(PG8_SB(0, 1), b2 + hstepB, voffB);
            PG8_WAIT_V(6); PG8_BAR; PG8_MMA(1, 1, At, B1); PG8_BAR;
            PG8_LDB(B0, 1, 0); PG8_SCHED; PG8_LDA(At, 1, 0); PG8_STAGE(PG8_SA(0, 1), a2 + hstepA, voffA);
            PG8_WAIT_L(8); PG8_BAR; PG8_WAIT_L(0); PG8_MMA(0, 0, At, B0); PG8_BAR; PG8_SCHED;
            PG8_LDB(B1, 1, 1); PG8_STAGE(PG8_SB(1, 0), b3, voffB);
            PG8_BAR; PG8_WAIT_L(0); PG8_MMA(0, 1, At, B1); PG8_BAR;
            PG8_LDA(At, 1, 1); PG8_STAGE(PG8_SA(1, 0), a3, voffA);
            PG8_BAR; PG8_WAIT_L(0); PG8_MMA(1, 0, At, B0); PG8_BAR; PG8_SCHED;
            PG8_STAGE(PG8_SB(1, 1), b3 + hstepB, voffB);
            PG8_WAIT_V(6); PG8_BAR; PG8_MMA(1, 1, At, B1); PG8_BAR;
            }
        }
        if constexpr (ALIGN_EPI) { if (wr == 0) PG8_BAR; }
        if constexpr (!Epi::AFTER_DRAIN) { E(acc, cur, wr, wc, fr, fq); S.done(cur); }
        if (!has_next) break;
#pragma unroll
        for (int a = 0; a < 2; ++a)
#pragma unroll
            for (int b = 0; b < 2; ++b)
#pragma unroll
                for (int m = 0; m < 4; ++m)
#pragma unroll
                    for (int n = 0; n < 2; ++n) acc[a][b][m][n] = (f32x4){0.f, 0.f, 0.f, 0.f};
        cur = nxt; cA = nA; cB = nB; ++ui;
        if constexpr (ALIGN_EPI) { if (wr == 1) PG8_BAR; }
    }
    PG8_WAIT_V(0);
    if constexpr (!ALIGN_EPI) { if (wr == 0) PG8_BAR; }
    PG8_BAR;
    if constexpr (Epi::AFTER_DRAIN) { E.fused(acc, cur, wr, wc, fr, fq, lds, wid, lane); S.done(cur); }
#undef PG8_SA
#undef PG8_SB
#undef PG8_STAGE
#undef PG8_LDA
#undef PG8_LDB
#undef PG8_MMA
#undef PG8_WAIT_V
#undef PG8_WAIT_L
#undef PG8_BAR
#undef PG8_SCHED
}
}

DI void attnA_naive_item(bf16_t* __restrict__ proj, int item) {
    const int lane = olane();
    const int row = item >> 3, h = item & 7, b = row >> 11, s = row & (SEQ - 1);
    const float q = bf2f(proj[(size_t)row * PE + E_QA + h * 64 + lane]);
    float lse[3], o[3];
#pragma unroll
    for (int p = 0; p < 3; ++p) {
        const int dil = p == 0 ? 1 : (p == 1 ? 4 : 16);
        const int ls = s / dil, r = s % dil, j0 = ls - 128 < 0 ? 0 : ls - 128;
        float m = -INFINITY, l = 0.f, acc = 0.f;
        for (int j = j0; j <= ls; ++j) {
            const size_t kr = (size_t)(b * SEQ + j * dil + r) * PE;
            const float sc = wave_sum(q * bf2f(proj[kr + E_KA + h * 64 + lane]));
            const float vv = bf2f(proj[kr + E_VA + h * 64 + lane]);
            const float mn = fmaxf(m, sc), al = exp2f(m - mn), pp = exp2f(sc - mn);
            l = l * al + pp; acc = acc * al + pp * vv; m = mn;
        }
        lse[p] = m + log2f(l); o[p] = acc / l;
    }
    const float mx = fmaxf(lse[0], fmaxf(lse[1], lse[2]));
    const float w0 = exp2f(lse[0] - mx), w1 = exp2f(lse[1] - mx), w2 = exp2f(lse[2] - mx);
    const float out = (w0 * o[0] + w1 * o[1] + w2 * o[2]) / (w0 + w1 + w2);
    bf16_t* g = proj + (size_t)row * PE + E_G + h * 64 + lane;
    *g = f2bf(out * bf2f(*g));
}
DI void ret_naive_item(bf16_t* __restrict__ proj, int item) {
    const int lane = olane();
    const int row = item >> 2, h = item & 3, b = row >> 11, s = row & (SEQ - 1);
    const float q = bf2f(proj[(size_t)row * PE + E_QR + h * 64 + lane]);
    float o0 = 0.f, o1 = 0.f;
    for (int j = 0; j <= s; ++j) {
        const size_t kr = (size_t)(b * SEQ + j) * PE;
        const float sc = wave_sum(q * bf2f(proj[kr + E_KR + h * 64 + lane]));
        o0 += sc * bf2f(proj[kr + E_VR + h * 128 + lane]); o1 += sc * bf2f(proj[kr + E_VR + h * 128 + 64 + lane]);
    }
    const float rn = rsqrtf(wave_sum(o0 * o0 + o1 * o1) * (1.f / 128.f) + NORM_EPS);
    bf16_t* g = proj + (size_t)row * PE + E_G + 512 + h * 128 + lane;
    g[0] = f2bf(o0 * rn * bf2f(g[0])); g[64] = f2bf(o1 * rn * bf2f(g[64]));
}
DI void mem_naive_item(bf16_t* __restrict__ proj, int pitch, int qcol, int gcol, const bf16_t* __restrict__ memkv, int layer, int item) {
    const int lane = olane();
    const int row = item >> 2, h = item & 3, b = row >> 11;
    const float q = bf2f(proj[(size_t)row * pitch + qcol + h * 64 + lane]);
    float m = -INFINITY, l = 0.f, acc = 0.f;
    for (int j = 0; j < MEMT; ++j) {
        const bf16_t* kv = memkv + (size_t)(b * MEMT + j) * 2048 + layer * 512 + h * 64 + lane;
        const float sc = wave_sum(q * bf2f(kv[0])), vv = bf2f(kv[256]);
        const float mn = fmaxf(m, sc), al = exp2f(m - mn), pp = exp2f(sc - mn);
        l = l * al + pp; acc = acc * al + pp * vv; m = mn;
    }
    bf16_t* g = proj + (size_t)row * pitch + gcol + h * 64 + lane;
    *g = f2bf(acc / l * bf2f(*g));
}
DI void mla_naive_item(bf16_t* __restrict__ proj, const bf16_t* __restrict__ mq, const bf16_t* __restrict__ mkv, int item) {
    const int lane = olane();
    const int row = item >> 3, h = item & 7, b = row >> 11, s = row & (SEQ - 1);
    const float qn = bf2f(mq[(size_t)row * 1024 + h * 128 + lane]);
    const float qr = lane < 32 ? bf2f(mq[(size_t)row * 1024 + h * 128 + 64 + lane]) : 0.f;
    float m = -INFINITY, l = 0.f, acc = 0.f;
    for (int j = 0; j <= s; ++j) {
        const size_t kr = (size_t)(b * SEQ + j);
        float pr = qn * bf2f(mkv[kr * 1024 + h * 128 + lane]);
        if (lane < 32) pr += qr * bf2f(proj[kr * PO + O_KR + lane]);
        const float sc = wave_sum(pr), vv = bf2f(mkv[kr * 1024 + h * 128 + 64 + lane]);
        const float mn = fmaxf(m, sc), al = exp2f(m - mn), pp = exp2f(sc - mn);
        l = l * al + pp; acc = acc * al + pp * vv; m = mn;
    }
    bf16_t* g = proj + (size_t)row * PO + O_G + h * 64 + lane;
    *g = f2bf(acc / l * bf2f(*g));
}
DI void final_norm_rows(int gw, int ngw, float* __restrict__ x, const float* __restrict__ g, float pert) {
    const int lane = olane();
    const f32x4* gr = (const f32x4*)g + lane;
    f32x4 gg[4], v[4], vn[4];
#pragma unroll
    for (int j = 0; j < 4; ++j) gg[j] = gr[64 * j];
    int r = gw;
    if (r < MTOK) {
#pragma unroll
        for (int j = 0; j < 4; ++j) v[j] = ((const f32x4*)(x + (size_t)r * DM) + lane)[64 * j];
    }
    for (; r < MTOK; r += ngw) {
        const int rn_ = r + ngw < MTOK ? r + ngw : r;
#pragma unroll
        for (int j = 0; j < 4; ++j) vn[j] = ((const f32x4*)(x + (size_t)rn_ * DM) + lane)[64 * j];
        asm volatile("" ::: "memory");
        float s = 0.f;
#pragma unroll
        for (int j = 0; j < 4; ++j) s += v[j].x * v[j].x + v[j].y * v[j].y + v[j].z * v[j].z + v[j].w * v[j].w;
        const float rn = rsqrtf(wave_sum(s) * (1.f / DM) + NORM_EPS) * pert;
        f32x4* xr = (f32x4*)(x + (size_t)r * DM) + lane;
#pragma unroll
        for (int j = 0; j < 4; ++j) xr[64 * j] = (f32x4){v[j].x * rn * gg[j].x, v[j].y * rn * gg[j].y, v[j].z * rn * gg[j].z, v[j].w * rn * gg[j].w};
#pragma unroll
        for (int j = 0; j < 4; ++j) v[j] = vn[j];
    }
}

typedef short bf16x8 __attribute__((ext_vector_type(8)));
typedef short s16x4 __attribute__((ext_vector_type(4)));
typedef float f32x16 __attribute__((ext_vector_type(16)));
typedef float f32x2 __attribute__((ext_vector_type(2)));
#define LAS __attribute__((address_space(3)))
DI int crow(int r, int hi) { return (r & 3) + 8 * (r >> 2) + 4 * hi; }
DI s16x4 vtr(const LAS unsigned char* p) { return __builtin_bit_cast(s16x4, __builtin_amdgcn_ds_read_tr16_b64_v4i16((LAS s16x4*)p)); }

struct Ticket {
    unsigned* ctr; unsigned val; bool pending;
    DI void issue() { if (!pending) { if (threadIdx.x == 0) val = atomicAdd(ctr, 1u); pending = true; } }
    DI int take(__attribute__((address_space(3))) unsigned* slot) { issue(); __syncthreads(); if (threadIdx.x == 0) *slot = val; __syncthreads(); pending = false; return (int)*slot; }
};
DI float max3(float a, float b, float c) { float r; asm("v_max3_f32 %0, %1, %2, %3" : "=v"(r) : "v"(a), "v"(b), "v"(c)); return r; }
struct KVSrc {
    const bf16_t* k; const bf16_t* k2; const bf16_t* v; int ldk, ldk2, ldv, kstride, koff, jmax;
};
struct MaskBand { DI float operator()(int qi, int kj) const { return ((unsigned)(qi - kj) <= 128u && kj >= 0) ? 0.f : -INFINITY; } };
struct MaskBandDil4 { DI float operator()(int qi, int kj) const {
        const int d = qi - kj;
        const int m = ((unsigned)d <= 128u ? 1 : 0) + ((d >= 0 && (d & 3) == 0) ? 1 : 0);
        return m == 0 ? -INFINITY : (m == 1 ? 0.f : 1.f); } };
struct MaskCausal { DI float operator()(int qi, int kj) const { return kj <= qi ? 0.f : -INFINITY; } };
struct MaskNone { DI float operator()(int, int) const { return 0.f; } };

template <int NDQ, int NDB, bool SOFTMAX> struct AttnWave {
    bf16x8 qf[NDQ]; f32x16 o[NDB]; float m, l;
    DI void init() {
#pragma unroll
        for (int d = 0; d < NDB; ++d)
#pragma unroll
            for (int r = 0; r < 16; ++r) o[d][r] = 0.f;
        m = -INFINITY; l = 0.f;
    }
    template <int NDQ1, class Mask> DI void segment(LAS unsigned char* vbuf, const KVSrc& S, int k0, int t0, int t1, int tf0, int tf1, int qi, const Mask& mask, int lane) {
        if (t0 >= t1) return;
        const int r32 = lane & 31, hi = lane >> 5;
        constexpr int VCH = NDB * 4;
        constexpr int VLD = NDB * 2;
        const int vrow = lane / VCH, vch = lane % VCH;
        const int vdst = (vch >> 2) * 2048 + vrow * 64 + (vch & 3) * 16;
        const LAS unsigned char* vb = vbuf + (4 * hi + ((lane & 15) >> 2)) * 64 + ((lane >> 4) & 1) * 32 + (lane & 3) * 8;
        static_assert(NDQ == 4 && NDQ1 == 4, "per-wave K image: 128-byte key rows");
        constexpr int KP = NDQ * 32 + 16;
        LAS unsigned char* kimg = vbuf + NDB * 2048;
        const int krow = lane >> 3, kch = lane & 7;
        u32x4 kf0[NDQ], kf1[NDQ], kf2[NDQ]; u32x4 vr0[VLD], vr1[VLD], vr2[VLD];
        auto loadk = [&](u32x4 (&dst)[NDQ], int t) {
#pragma unroll
            for (int i = 0; i < NDQ; ++i) { int j = k0 + 32 * t + krow + 8 * i; j = j < 0 ? 0 : (j > S.jmax ? S.jmax : j);
                dst[i] = *(const u32x4*)(S.k + (size_t)(j * S.kstride + S.koff) * S.ldk + kch * 8); }
        };
        auto loadv = [&](u32x4 (&dst)[VLD], int t) {
#pragma unroll
            for (int i = 0; i < VLD; ++i) { int j = k0 + 32 * t + vrow + (64 / VCH) * i; j = j < 0 ? 0 : (j > S.jmax ? S.jmax : j);
                dst[i] = *(const u32x4*)(S.v + (size_t)(j * S.kstride + S.koff) * S.ldv + vch * 8); }
        };
        auto step = [&](u32x4 (&kf)[NDQ], u32x4 (&vr)[VLD], int t) {
#pragma unroll
            for (int i = 0; i < NDQ; ++i) *(LAS u32x4*)(kimg + (krow + 8 * i) * KP + kch * 16) = kf[i];
#pragma unroll
            for (int i = 0; i < VLD; ++i) *(LAS u32x4*)(vbuf + vdst + i * (64 / VCH) * 64) = vr[i];
            asm volatile("" ::: "memory");
            f32x16 s;
#pragma unroll
            for (int r = 0; r < 16; ++r) s[r] = 0.f;
#pragma unroll
            for (int d = 0; d < NDQ; ++d) s = __builtin_amdgcn_mfma_f32_32x32x16_bf16(*(const LAS bf16x8*)(kimg + r32 * KP + (2 * d + hi) * 16), qf[d], s, 0, 0, 0);
            asm volatile("" ::: "memory");
            if (t + 3 < t1) { loadk(kf, t + 3); loadv(vr, t + 3); }
            if (t < tf0 || t >= tf1) {
                const int kb = k0 + 32 * t + 4 * hi;
#pragma unroll
                for (int r = 0; r < 16; ++r) { const float bias = mask(qi, kb + (r & 3) + 8 * (r >> 2)); s[r] = SOFTMAX ? s[r] + bias : (bias < 0.f ? 0.f : s[r]); }
            }
            if (SOFTMAX) {
                float mx = max3(s[0], s[1], s[2]);
#pragma unroll
                for (int r = 3; r < 15; r += 2) mx = max3(mx, s[r], s[r + 1]);
                mx = max3(mx, s[15], s[15]);
                float mxa, mxb; xpair32(mx, mxa, mxb);
                const float mn = max3(m, mxa, mxb);
                if (__any(mn > m + 8.f)) {
                    const float al = __builtin_amdgcn_exp2f(m - (mn == -INFINITY ? 0.f : mn));
                    l *= al; m = mn;
#pragma unroll
                    for (int d = 0; d < NDB; ++d)
#pragma unroll
                        for (int r = 0; r < 16; ++r) o[d][r] *= al;
                }
                const float mu = m == -INFINITY ? 0.f : m;
                f32x2 ps2 = {0.f, 0.f};
#pragma unroll
                for (int r = 0; r < 16; r += 2) { s[r] = __builtin_amdgcn_exp2f(s[r] - mu); s[r + 1] = __builtin_amdgcn_exp2f(s[r + 1] - mu); ps2 += (f32x2){s[r], s[r + 1]}; }
                l += ps2[0] + ps2[1];
            }
            bf16x8 pb[2];
#pragma unroll
            for (int st = 0; st < 2; ++st) { u32x4 w; w.x = cvtpk(s[8 * st], s[8 * st + 1]); w.y = cvtpk(s[8 * st + 2], s[8 * st + 3]); w.z = cvtpk(s[8 * st + 4], s[8 * st + 5]); w.w = cvtpk(s[8 * st + 6], s[8 * st + 7]);
                pb[st] = __builtin_bit_cast(bf16x8, w); }
#pragma unroll
            for (int d = 0; d < NDB; ++d)
#pragma unroll
                for (int st = 0; st < 2; ++st) {
                    const s16x4 lo = vtr(vb + d * 2048 + st * 1024), hh = vtr(vb + d * 2048 + st * 1024 + 512);
                    const bf16x8 vf = {lo[0], lo[1], lo[2], lo[3], hh[0], hh[1], hh[2], hh[3]};
                    o[d] = __builtin_amdgcn_mfma_f32_32x32x16_bf16(vf, pb[st], o[d], 0, 0, 0);
                }
            asm volatile("" ::: "memory");
        };
        loadk(kf0, t0); loadv(vr0, t0);
        if (t0 + 1 < t1) { loadk(kf1, t0 + 1); loadv(vr1, t0 + 1); }
        if (t0 + 2 < t1) { loadk(kf2, t0 + 2); loadv(vr2, t0 + 2); }
        for (int t = t0; t < t1; t += 3) {
            step(kf0, vr0, t);
            if (t + 1 < t1) step(kf1, vr1, t + 1);
            if (t + 2 < t1) step(kf2, vr2, t + 2);
        }
    }
    unsigned long long gpre[NDB][4];
    DI void gate_prefetch(const bf16_t* yrow, int lane) {
        const int hi = lane >> 5;
#pragma unroll
        for (int d = 0; d < NDB; ++d)
#pragma unroll
            for (int g = 0; g < 4; ++g) gpre[d][g] = *(const unsigned long long*)(yrow + 32 * d + 8 * g + 4 * hi);
    }
    DI void finish_store(bf16_t* yrow  , int lane, bool dry = false, bool pre = false) {
        const int hi = lane >> 5;
        float sc;
        if (SOFTMAX) { const float lt = xadd32(l); sc = 1.f / lt; }
        else { float ss = 0.f;
#pragma unroll
            for (int d = 0; d < NDB; ++d)
#pragma unroll
                for (int r = 0; r < 16; ++r) ss += o[d][r] * o[d][r];
            ss = xadd32(ss); sc = rsqrtf(ss * (1.f / (32 * NDB)) + NORM_EPS); }
#pragma unroll
        for (int d = 0; d < NDB; ++d)
#pragma unroll
            for (int g = 0; g < 4; ++g) {
                unsigned long long* p = (unsigned long long*)(yrow + 32 * d + 8 * g + 4 * hi);
                const unsigned long long gv = pre ? gpre[d][g] : *p; const unsigned g0 = (unsigned)gv, g1 = (unsigned)(gv >> 32);
                const float a0 = o[d][4 * g] * sc * __uint_as_float(g0 << 16), a1 = o[d][4 * g + 1] * sc * __uint_as_float(g0 & 0xffff0000u);
                const float a2 = o[d][4 * g + 2] * sc * __uint_as_float(g1 << 16), a3 = o[d][4 * g + 3] * sc * __uint_as_float(g1 & 0xffff0000u);
                if (!dry) *p = (unsigned long long)cvtpk(a0, a1) | ((unsigned long long)cvtpk(a2, a3) << 32);
            }
    }
};

struct SharedSrc { const bf16_t* k; const bf16_t* k2; const bf16_t* v; int ldk, ldk2, ldv; };
template <int NDB> struct FirstTile { u32x4 k, v[NDB / 2]; };
template <int NDB> DI FirstTile<NDB> first_tile_load(const SharedSrc& S) {
    int tid_ = threadIdx.x; asm volatile("" : "+v"(tid_));
    const int tid = tid_; constexpr int VCH = NDB * 4, VPT = NDB / 2;
    FirstTile<NDB> f;
    f.k = *(const u32x4*)(S.k + (size_t)(tid >> 3) * S.ldk + (tid & 7) * 8);
#pragma unroll
    for (int i = 0; i < VPT; ++i) f.v[i] = *(const u32x4*)(S.v + (size_t)(tid / VCH + (512 / VCH) * i) * S.ldv + (tid % VCH) * 8);
    return f;
}
template <int NDQ, int NDQ1, int NDB, bool SOFTMAX, bool CAUSAL, bool ALLMASK = false, class Mask = MaskCausal>
DI void attn_shared(LAS unsigned char* lds, AttnWave<NDQ, NDB, SOFTMAX>& W, const SharedSrc& S, int ntiles, int qb  , int qi  , const Mask& mask = Mask{}, const FirstTile<NDB>* pre = nullptr) {
    constexpr int RBP = NDQ * 32 + 16, KB = 64 * RBP, VB = NDB * 4096, BUF = KB + VB;
    int tid_ = threadIdx.x; asm volatile("" : "+v"(tid_));
    const int tid = tid_, lane = tid & 63, r32 = lane & 31, hi = lane >> 5;
    const int krow = tid >> 3, kch = tid & 7;
    const int k2row = tid >> 2, k2ch = tid & 3;
    constexpr int VCH = NDB * 4, VPT = NDB / 2;
    const int vrow = tid / VCH, vch = tid % VCH;
    u32x4 rk, rk2, rv[VPT];
    auto gload = [&](int t) {
        const size_t j0 = (size_t)64 * t;
        rk = *(const u32x4*)(S.k + (j0 + krow) * S.ldk + kch * 8);
        if (NDQ > NDQ1) { if (tid < 256) rk2 = *(const u32x4*)(S.k2 + (j0 + k2row) * S.ldk2 + k2ch * 8); }
#pragma unroll
        for (int i = 0; i < VPT; ++i) rv[i] = *(const u32x4*)(S.v + (j0 + vrow + (512 / VCH) * i) * S.ldv + vch * 8);
    };
    auto lstore = [&](int buf) {
        LAS unsigned char* kb = lds + buf * BUF; LAS unsigned char* vbs = kb + KB;
        *(LAS u32x4*)(kb + krow * RBP + kch * 16) = rk;
        if (NDQ > NDQ1) { if (tid < 256) *(LAS u32x4*)(kb + k2row * RBP + NDQ1 * 32 + k2ch * 16) = rk2; }
#pragma unroll
        for (int i = 0; i < VPT; ++i) *(LAS u32x4*)(vbs + (vch >> 2) * 4096 + (vrow + (512 / VCH) * i) * 64 + (vch & 3) * 16) = rv[i];
    };
    const int tmax = CAUSAL ? (qb >> 1) : ntiles - 1;
    if (pre != nullptr && NDQ == NDQ1) { rk = pre->k;
#pragma unroll
        for (int i = 0; i < VPT; ++i) rv[i] = pre->v[i]; }
    else gload(0);
    lstore(0);
    __syncthreads();
    for (int t = 0; t < ntiles; ++t) {
        if (t + 1 < ntiles) gload(t + 1);
#if PROBE_DUP == 30
        f32x16 osave[NDB]; float msave = W.m, lsave = W.l;
#pragma unroll
        for (int d = 0; d < NDB; ++d) osave[d] = W.o[d];
#pragma unroll 1
        for (int rep_ = 0; rep_ < (NDB == 2 ? 2 : 1); ++rep_) {
        if (rep_ == 1) { W.m = msave; W.l = lsave;
#pragma unroll
            for (int d = 0; d < NDB; ++d) W.o[d] = osave[d];
            asm volatile("" ::: "memory"); }
#endif
        if (t <= tmax) {
            const LAS unsigned char* kb = lds + (t & 1) * BUF; const LAS unsigned char* vb = kb + KB + (4 * hi + ((lane & 15) >> 2)) * 64 + ((lane >> 4) & 1) * 32 + (lane & 3) * 8;
            f32x16 s0, s1;
#pragma unroll
            for (int r = 0; r < 16; ++r) { s0[r] = 0.f; s1[r] = 0.f; }
            {
                bf16x8 ka[NDQ], kc[NDQ];
#pragma unroll
                for (int d = 0; d < NDQ; ++d) { ka[d] = *(const LAS bf16x8*)(kb + r32 * RBP + (2 * d + hi) * 16); kc[d] = *(const LAS bf16x8*)(kb + (32 + r32) * RBP + (2 * d + hi) * 16); }
                __builtin_amdgcn_sched_barrier(0);
#pragma unroll
                for (int d = 0; d < NDQ; ++d) {
                    s0 = __builtin_amdgcn_mfma_f32_32x32x16_bf16(ka[d], W.qf[d], s0, 0, 0, 0);
                    s1 = __builtin_amdgcn_mfma_f32_32x32x16_bf16(kc[d], W.qf[d], s1, 0, 0, 0);
                }
            }
            s16x4 vlo[4][NDB], vhh[4][NDB];
            if (NDB == 2) {
#pragma unroll
                for (int ks = 0; ks < 4; ++ks)
#pragma unroll
                    for (int d = 0; d < NDB; ++d) { vlo[ks][d] = vtr(vb + d * 4096 + ks * 1024); vhh[ks][d] = vtr(vb + d * 4096 + ks * 1024 + 512); }
                __builtin_amdgcn_sched_barrier(0);
            }
            if (ALLMASK) {
                const int kbase = 64 * t + 4 * hi;
#pragma unroll
                for (int r = 0; r < 16; ++r) { const int kj = kbase + (r & 3) + 8 * (r >> 2); s0[r] += mask(qi, kj); s1[r] += mask(qi, kj + 32); }
            } else if (CAUSAL && t == tmax) {
                const int kbase = 64 * t + 4 * hi;
#pragma unroll
                for (int r = 0; r < 16; ++r) { const int kj = kbase + (r & 3) + 8 * (r >> 2);
                    if (kj > qi) s0[r] = SOFTMAX ? -INFINITY : 0.f;
                    if (kj + 32 > qi) s1[r] = SOFTMAX ? -INFINITY : 0.f; }
            }
            if (SOFTMAX) {
                float mx = max3(s0[0], s1[0], s0[1]);
                mx = max3(mx, s1[1], s0[2]);
#pragma unroll
                for (int r = 2; r < 15; ++r) mx = max3(mx, s1[r], s0[r + 1]);
                mx = max3(mx, s1[15], s1[15]);
                float mxa, mxb; xpair32(mx, mxa, mxb);
                const float mn = max3(W.m, mxa, mxb);
                if (__any(mn > W.m + 8.f)) {
                    const float al = __builtin_amdgcn_exp2f(W.m - (mn == -INFINITY ? 0.f : mn));
                    W.l *= al; W.m = mn;
#pragma unroll
                    for (int d = 0; d < NDB; ++d)
#pragma unroll
                        for (int r = 0; r < 16; ++r) W.o[d][r] *= al;
                }
                const float mu = W.m == -INFINITY ? 0.f : W.m;
                f32x2 ps2 = {0.f, 0.f};
#pragma unroll
                for (int r = 0; r < 16; ++r) { s0[r] = __builtin_amdgcn_exp2f(s0[r] - mu); s1[r] = __builtin_amdgcn_exp2f(s1[r] - mu); ps2 += (f32x2){s0[r], s1[r]}; }
                W.l += ps2[0] + ps2[1];
            }
            bf16x8 pb[4];
#pragma unroll
            for (int st = 0; st < 2; ++st) {
                u32x4 w; w.x = cvtpk(s0[8 * st], s0[8 * st + 1]); w.y = cvtpk(s0[8 * st + 2], s0[8 * st + 3]); w.z = cvtpk(s0[8 * st + 4], s0[8 * st + 5]); w.w = cvtpk(s0[8 * st + 6], s0[8 * st + 7]);
                pb[st] = __builtin_bit_cast(bf16x8, w);
                u32x4 x; x.x = cvtpk(s1[8 * st], s1[8 * st + 1]); x.y = cvtpk(s1[8 * st + 2], s1[8 * st + 3]); x.z = cvtpk(s1[8 * st + 4], s1[8 * st + 5]); x.w = cvtpk(s1[8 * st + 6], s1[8 * st + 7]);
                pb[2 + st] = __builtin_bit_cast(bf16x8, x);
            }
#pragma unroll
            for (int ks = 0; ks < 4; ++ks)
#pragma unroll
                for (int d = 0; d < NDB; ++d) {
                    s16x4 lo, hh;
                    if (NDB == 2) { lo = vlo[ks][d]; hh = vhh[ks][d]; } else { lo = vtr(vb + d * 4096 + ks * 1024); hh = vtr(vb + d * 4096 + ks * 1024 + 512); }
                    const bf16x8 vf = {lo[0], lo[1], lo[2], lo[3], hh[0], hh[1], hh[2], hh[3]};
                    W.o[d] = __builtin_amdgcn_mfma_f32_32x32x16_bf16(vf, pb[ks], W.o[d], 0, 0, 0);
                    if (NDB == 4 && (d & 1)) asm volatile("" ::: "memory");
                }
        }
#if PROBE_DUP == 30
        }
#endif
        if (t + 1 < ntiles) lstore((t + 1) & 1);
        __syncthreads();
    }
}
DI void unitAS(LAS unsigned char* lds, bf16_t* __restrict__ proj, int b, int h, int r4, int lb8, bool dry, Ticket& tk) {
    const int lane = olane(), r32 = lane & 31, hi = lane >> 5, wave = __builtin_amdgcn_readfirstlane(threadIdx.x >> 6);
    const int lb = 8 * lb8 + wave, l0 = 32 * lb, lq = l0 + r32, tq = 4 * lq + r4;
    const size_t rowq = (size_t)b * SEQ + tq;
    AttnWave<4, 2, true> W; W.init();
#pragma unroll
    for (int d = 0; d < 4; ++d) W.qf[d] = *(const bf16x8*)(proj + rowq * PE + E_QA + h * 64 + 16 * d + 8 * hi);
    const bf16_t* kb = proj + (size_t)b * SEQ * PE + E_KA + h * 64; const bf16_t* vb = proj + (size_t)b * SEQ * PE + E_VA + h * 64;
    const SharedSrc S23{kb + (size_t)r4 * PE, kb, vb + (size_t)r4 * PE, 4 * PE, 4 * PE, 4 * PE};
    const FirstTile<2> ft = first_tile_load<2>(S23);
    {
        KVSrc S{kb, kb, vb, PE, PE, PE, 1, 0, SEQ - 1}; const int k0 = 4 * l0 + r4 - 128;
        const int ts = k0 + 31 < 0 ? (-k0) >> 5 : 0;
#if PROBE_DUP == 33
        W.template segment<4>(lds + 65536 + wave * 10240, S, k0, ts, 8, 0, 0, tq, MaskBand{}, lane);
        if (!dry) W.init();
#endif
        W.template segment<4>(lds + 65536 + wave * 10240, S, k0, ts, 8, 0, 0, tq, MaskBand{}, lane);
    }
    {
        W.gate_prefetch(proj + rowq * PE + E_G + h * 64, lane);
        attn_shared<4, 4, 2, true, true, true, MaskBandDil4>(lds, W, S23, 4 * lb8 + 4, lb, lq, MaskBandDil4{}, &ft);
    }
    tk.issue();
    W.finish_store(proj + rowq * PE + E_G + h * 64, lane, dry, true);
}
DI void unitRetState(LAS unsigned char* lds, const bf16_t* __restrict__ proj, bf16_t* __restrict__ pt, int b, int h) {
    int tid_ = threadIdx.x; asm volatile("" : "+v"(tid_));
    const int tid = tid_, lane = tid & 63, r32 = lane & 31, hi = lane >> 5, wave = __builtin_amdgcn_readfirstlane(tid >> 6);
    const int dvb = wave >> 1, dkb = wave & 1;
    constexpr int KIMG = 8192, VIMG = 16384, BUF = KIMG + VIMG;
    const bf16_t* kg = proj + (size_t)b * SEQ * PE + E_KR + h * 64; const bf16_t* vg = proj + (size_t)b * SEQ * PE + E_VR + h * 128;
    const int krow = tid >> 3, kch = tid & 7, vrow = tid >> 4, vch = tid & 15;
    u32x4 rk, rv[2];
    auto gload = [&](int t) { const size_t j0 = (size_t)64 * t; rk = *(const u32x4*)(kg + (j0 + krow) * PE + kch * 8);
        rv[0] = *(const u32x4*)(vg + (j0 + vrow) * PE + vch * 8); rv[1] = *(const u32x4*)(vg + (j0 + vrow + 32) * PE + vch * 8); };
    auto lstore = [&](int buf) { LAS unsigned char* kb = lds + buf * BUF; LAS unsigned char* vbs = kb + KIMG;
        *(LAS u32x4*)(kb + (kch >> 2) * 4096 + krow * 64 + (kch & 3) * 16) = rk;
        *(LAS u32x4*)(vbs + (vch >> 2) * 4096 + vrow * 64 + (vch & 3) * 16) = rv[0]; *(LAS u32x4*)(vbs + (vch >> 2) * 4096 + (vrow + 32) * 64 + (vch & 3) * 16) = rv[1]; };
    const int troff = (8 * hi + ((lane & 15) >> 2)) * 64 + ((lane >> 4) & 1) * 32 + (lane & 3) * 8;
    f32x16 acc;
#pragma unroll
    for (int r = 0; r < 16; ++r) acc[r] = 0.f;
    gload(0); lstore(0);
    __syncthreads();
    constexpr int NT = 28;
    for (int t = 0; t < NT; ++t) {
        if (t + 1 < NT) gload(t + 1);
        const LAS unsigned char* kb = lds + (t & 1) * BUF + dkb * 4096 + troff; const LAS unsigned char* vb = lds + (t & 1) * BUF + KIMG + dvb * 4096 + troff;
#pragma unroll
        for (int st = 0; st < 4; ++st) {
            const s16x4 vlo = vtr(vb + st * 1024), vhi = vtr(vb + st * 1024 + 256), klo = vtr(kb + st * 1024), khi = vtr(kb + st * 1024 + 256);
            const bf16x8 vf = {vlo[0], vlo[1], vlo[2], vlo[3], vhi[0], vhi[1], vhi[2], vhi[3]}, kf = {klo[0], klo[1], klo[2], klo[3], khi[0], khi[1], khi[2], khi[3]};
            acc = __builtin_amdgcn_mfma_f32_32x32x16_bf16(vf, kf, acc, 0, 0, 0);
        }
        if ((t & 3) == 3) {
            bf16_t* dst = pt + ((size_t)((b * 4 + h) * 7 + (t >> 2))) * 8192 + (size_t)(32 * dvb) * 64 + 32 * dkb + r32;
#pragma unroll
            for (int r = 0; r < 16; ++r) dst[(size_t)crow(r, hi) * 64] = f2bf(acc[r]);
        }
        if (t + 1 < NT) lstore((t + 1) & 1);
        __syncthreads();
    }
}
DI void unitRetC(LAS unsigned char* lds, bf16_t* __restrict__ proj, const bf16_t* __restrict__ pt, int b, int h, int qb8, bool dry, Ticket& tk) {
    const int lane = olane(), r32 = lane & 31, hi = lane >> 5, wave = __builtin_amdgcn_readfirstlane(threadIdx.x >> 6);
    const int sq = 256 * qb8 + 32 * wave + r32; const size_t rowq = (size_t)b * SEQ + sq;
    AttnWave<4, 4, false> W; W.init();
#pragma unroll
    for (int d = 0; d < 4; ++d) W.qf[d] = *(const bf16x8*)(proj + rowq * PE + E_QR + h * 64 + 16 * d + 8 * hi);
    const bf16_t* kb = proj + ((size_t)b * SEQ + 256 * qb8) * PE + E_KR + h * 64;
    const SharedSrc S{kb, kb, proj + ((size_t)b * SEQ + 256 * qb8) * PE + E_VR + h * 128, PE, PE, PE};
    const FirstTile<4> ft = first_tile_load<4>(S);
    if (qb8 > 0) {
        const bf16_t* pb = pt + ((size_t)((b * 4 + h) * 7 + (qb8 - 1))) * 8192 + (size_t)r32 * 64 + 8 * hi;
#pragma unroll
        for (int db = 0; db < 4; ++db)
#pragma unroll
            for (int d = 0; d < 4; ++d) W.o[db] = __builtin_amdgcn_mfma_f32_32x32x16_bf16(*(const bf16x8*)(pb + (size_t)db * 32 * 64 + 16 * d), W.qf[d], W.o[db], 0, 0, 0);
    }
    W.gate_prefetch(proj + rowq * PE + E_G + 512 + h * 128, lane);
    attn_shared<4, 4, 4, false, true>(lds, W, S, 4, wave, 32 * wave + r32, MaskCausal{}, &ft);
    tk.issue();
    W.finish_store(proj + rowq * PE + E_G + 512 + h * 128, lane, dry, true);
}
DI void unitMemS(LAS unsigned char* lds, bf16_t* __restrict__ proj, int pitch, int qcol, int gcol, const bf16_t* __restrict__ memkv, int layer, int b, int h, int sb8, bool dry, Ticket& tk) {
    const int lane = olane(), r32 = lane & 31, hi = lane >> 5, wave = __builtin_amdgcn_readfirstlane(threadIdx.x >> 6);
    const size_t rowq = (size_t)b * SEQ + 256 * sb8 + 32 * wave + r32;
    AttnWave<4, 2, true> W; W.init();
#pragma unroll
    for (int d = 0; d < 4; ++d) W.qf[d] = *(const bf16x8*)(proj + rowq * pitch + qcol + h * 64 + 16 * d + 8 * hi);
    const bf16_t* kb = memkv + (size_t)b * MEMT * 2048 + layer * 512 + h * 64;
    const SharedSrc S{kb, kb, kb + 256, 2048, 2048, 2048};
    W.gate_prefetch(proj + rowq * pitch + gcol + h * 64, lane);
    attn_shared<4, 4, 2, true, false>(lds, W, S, MEMT / 64, 0, 0);
    tk.issue();
    W.finish_store(proj + rowq * pitch + gcol + h * 64, lane, dry, true);
}
DI void unitMlaS(LAS unsigned char* lds, bf16_t* __restrict__ proj, const bf16_t* __restrict__ mq, const bf16_t* __restrict__ mkv, int b, int h, int qb8, bool dry, Ticket& tk) {
    const int lane = olane(), r32 = lane & 31, hi = lane >> 5, wave = __builtin_amdgcn_readfirstlane(threadIdx.x >> 6);
    const int qb = 8 * qb8 + wave, sq = 32 * qb + r32; const size_t rowq = (size_t)b * SEQ + sq;
    AttnWave<6, 2, true> W; W.init();
#pragma unroll
    for (int d = 0; d < 6; ++d) W.qf[d] = *(const bf16x8*)(mq + rowq * 1024 + h * 128 + 16 * d + 8 * hi);
    const bf16_t* kb = mkv + (size_t)b * SEQ * 1024 + h * 128;
    const SharedSrc S{kb, proj + (size_t)b * SEQ * PO + O_KR, kb + 64, 1024, PO, 1024};
    W.gate_prefetch(proj + rowq * PO + O_G + h * 64, lane);
    attn_shared<6, 4, 2, true, true>(lds, W, S, 4 * qb8 + 4, qb, sq);
    tk.issue();
    W.finish_store(proj + rowq * PO + O_G + h * 64, lane, dry, true);
}

typedef float f32x4_t __attribute__((ext_vector_type(4)));
constexpr int RW_T = 32, RW_NCH = SEQ / RW_T;
constexpr int RW_BUF = 49152;
constexpr int RW_Y = 2 * RW_BUF, RW_BF = RW_Y + 16384, RW_STG = RW_BF + 20480, RW_CST = RW_STG + 4 * 2560;
static_assert(RW_CST + 14 * 256 <= 163840 - 64, "RWKV LDS map");
DI float dpp_add(float x, const int sel) {
    int t;
    if (sel == 0) t = __builtin_amdgcn_update_dpp(0, __float_as_int(x), 0xB1, 0xf, 0xf, true);
    else if (sel == 1) t = __builtin_amdgcn_update_dpp(0, __float_as_int(x), 0x4E, 0xf, 0xf, true);
    else if (sel == 2) t = __builtin_amdgcn_update_dpp(0, __float_as_int(x), 0x141, 0xf, 0xf, true);
    else t = __builtin_amdgcn_update_dpp(0, __float_as_int(x), 0x140, 0xf, 0xf, true);
    return x + __int_as_float(t);
}
DI float red8(float x) { return dpp_add(dpp_add(dpp_add(x, 0), 1), 2); }
DI float wsum64(float x) {
    x = dpp_add(dpp_add(dpp_add(dpp_add(x, 0), 1), 2), 3);
    const int xi = __float_as_int(x);
    const float s0 = __int_as_float(__builtin_amdgcn_readlane(xi, 0)), s1 = __int_as_float(__builtin_amdgcn_readlane(xi, 16));
    const float s2 = __int_as_float(__builtin_amdgcn_readlane(xi, 32)), s3 = __int_as_float(__builtin_amdgcn_readlane(xi, 48));
    return (s0 + s1) + (s2 + s3);
}
DI float fsigmoid(float x) { return __builtin_amdgcn_rcpf(1.f + __builtin_amdgcn_exp2f(-LOG2E * x)); }
struct RwkvW { const float *mu, *w0, *w2, *a0, *a2, *v0, *v2, *k_k, *k_a, *r_k, *lnx_w, *lnx_b; };

constexpr int RC_ARR = 0, RC_Y = 49152, RC_BON = 65536, RC_IMG = 81920, RC_IMGSZ = 19712, RC_PA = 68  , RC_PT = 20  , RC_BF = RC_IMG + 2 * RC_IMGSZ, RC_STG = RC_BF + 20480, RC_CST = RC_STG + 4 * 2560;
static_assert(RC_CST + 14 * 256 <= 163840 - 64, "chunked RWKV LDS map");
DI bf16_t bf1(float x) { return (bf16_t)(cvtpk(x, 0.f) & 0xffffu); }
DI bf16x8 cvt8(const f32x16& x, const int base) { u32x4 w; w.x = cvtpk(x[base], x[base + 1]); w.y = cvtpk(x[base + 2], x[base + 3]); w.z = cvtpk(x[base + 4], x[base + 5]); w.w = cvtpk(x[base + 6], x[base + 7]); return __builtin_bit_cast(bf16x8, w); }
DI bf16x8 afrag_k(const LAS bf16_t* rowp, int koff, int hi) {
    typedef unsigned long long u64; typedef u64 u64x2 __attribute__((ext_vector_type(2)));
    const u64x2 w = {*(const LAS u64*)(rowp + koff + 4 * hi), *(const LAS u64*)(rowp + koff + 8 + 4 * hi)};
    return __builtin_bit_cast(bf16x8, w);
}
DI bf16x8 nfrag(const LAS bf16_t* p) {
    typedef unsigned long long u64; typedef u64 u64x2 __attribute__((ext_vector_type(2)));
    const u64x2 w = {*(const LAS u64*)p, *(const LAS u64*)(p + 4)};
    return __builtin_bit_cast(bf16x8, w);
}
template <int T0> DI void rc_opnd8(const LAS float* arr  , LAS unsigned char* img, int k) {
    LAS bf16_t* AI2 = (LAS bf16_t*)img; LAS bf16_t* BK2 = (LAS bf16_t*)(img + 4352); LAS bf16_t* BPT = (LAS bf16_t*)(img + 8704); LAS bf16_t* KPT = (LAS bf16_t*)(img + 11264);
    LAS bf16_t* VVT = (LAS bf16_t*)(img + 17408); LAS float* PC = (LAS float*)(img + 19456);
    float Pr[16], av_[8], bv_[8], rv_[8], kv_[8], vv_[8];
#pragma unroll
    for (int tt = 0; tt < 16; ++tt) Pr[tt] = arr[2048 + tt * 64];
#pragma unroll
    for (int u = 0; u < 8; ++u) { const int tt = T0 + u; av_[u] = arr[6144 + tt * 64]; bv_[u] = arr[8192 + tt * 64]; rv_[u] = arr[tt * 64]; kv_[u] = arr[4096 + tt * 64]; vv_[u] = arr[10240 + tt * 64]; }
    __builtin_amdgcn_sched_barrier(0);
#pragma unroll
    for (int tt = 1; tt < 16; ++tt) Pr[tt] *= Pr[tt - 1];
    const float PCv = Pr[15];
    unsigned bpw[4], kpw[4]; float bprev = 0.f, kprev = 0.f;
#pragma unroll
    for (int u = 0; u < 8; ++u) {
        const int tt = T0 + u;
        const float Pm = tt ? Pr[tt - 1] : 1.f, inv = __builtin_amdgcn_rcpf(Pr[tt]), eC = PCv * inv;
        const float a = av_[u], bb_ = bv_[u], r = rv_[u], kx = kv_[u], v = vv_[u];
        AI2[tt * RC_PA + k] = bf1(a * Pm); AI2[(16 + tt) * RC_PA + k] = bf1(r * Pr[tt]); BK2[tt * RC_PA + k] = bf1(bb_ * inv); BK2[(16 + tt) * RC_PA + k] = bf1(kx * inv);
        VVT[(k >> 5) * 512 + tt * 32 + (k & 31)] = bf1(v);
        const float bpv = bb_ * eC, kpv = kx * eC;
        if (u & 1) { bpw[u >> 1] = cvtpk(bprev, bpv); kpw[u >> 1] = cvtpk(kprev, kpv); } else { bprev = bpv; kprev = kpv; }
    }
    { typedef unsigned u32x2 __attribute__((ext_vector_type(2)));
#pragma unroll
      for (int q = 0; q < 2; ++q) { *(LAS u32x2*)(BPT + k * RC_PT + T0 + 4 * q) = (u32x2){bpw[2 * q], bpw[2 * q + 1]}; *(LAS u32x2*)(KPT + k * RC_PT + T0 + 4 * q) = (u32x2){kpw[2 * q], kpw[2 * q + 1]}; } }
    if (T0 == 0) PC[k] = PCv;
}
constexpr int RC_FLAG = RC_CST + 14 * 256;
static_assert(RC_FLAG + 64 <= 163840 - 64, "chunked RWKV LDS map (flags)");
template <bool VRES>
DI void rwkv_unit_c(LAS unsigned char* lds, bf16_t* __restrict__ proj, bf16_t* __restrict__ vfirst, const bf16_t* __restrict__ loraT  ,
                  const RwkvW& W, int unit, const bf16_t* __restrict__ zrow  , bool dry = false) {
    const int lane = olane(), wave = __builtin_amdgcn_readfirstlane(threadIdx.x >> 6);
    const int b = unit >> 3, h = unit & 7, hc = h * 64 + lane;
    const size_t row0 = (size_t)b * SEQ;
    LAS bf16x8* bfr = (LAS bf16x8*)(lds + RC_BF);
#if PROBE_DUP == 26
    if (!dry) { const unsigned long long t0_ = __builtin_amdgcn_s_memrealtime(); while (__builtin_amdgcn_s_memrealtime() - t0_ < 5000ull) __builtin_amdgcn_s_sleep(32); }
#endif
    {
        const int cl = lane & 15, kg = lane >> 4;
        for (int f = wave; f < 20; f += 8) {
            bf16x8 v;
            if (f < 16) { const int ct = (f & 7) >> 1, ks = f & 1; v = *(const bf16x8*)(loraT + (f >= 8 ? 32768 : 0) + (size_t)(h * 64 + 16 * ct + cl) * 64 + 32 * ks + 8 * kg); }
            else v = VRES ? *(const bf16x8*)(loraT + 65536 + (size_t)(h * 64 + 16 * (f - 16) + cl) * 32 + 8 * kg) : bf16x8{0, 0, 0, 0, 0, 0, 0, 0};
            bfr[f * 64 + lane] = v;
        }
        if (threadIdx.x < 2) ((volatile LAS unsigned*)(lds + RC_FLAG))[threadIdx.x] = 0u;
    }
    __syncthreads();
    if (wave < 2) {
        const int vh = wave, r32 = lane & 31, hi = lane >> 5, rt = r32 & 15;
        f32x16 S0, S1;
#pragma unroll
        for (int r = 0; r < 16; ++r) { S0[r] = 0.f; S1[r] = 0.f; }
        __syncthreads();
        __syncthreads();
        for (int c = 0; c < RW_NCH; ++c) {
            rc_opnd8<8>((const LAS float*)(lds + RC_ARR) + (16 * vh) * 64 + lane, lds + RC_IMG + vh * RC_IMGSZ, lane);
            asm volatile("s_waitcnt lgkmcnt(0)" ::: "memory");
            if (lane == 0) ((volatile LAS unsigned*)(lds + RC_FLAG))[vh] = (unsigned)(c + 1);
            __syncthreads();
            LAS float* pY = (LAS float*)(lds + RC_Y + (c & 1) * 8192);
#if PROBE_DUP == 24
            f32x16 K0 = S0, K1 = S1;
#pragma unroll 1
            for (int half2 = 0; half2 < 4; ++half2) {
                const int half = half2 & 1;
                if (half2 == 2) { if (dry) { K0 = S0; K1 = S1; } S0 = K0; S1 = K1; }
#else
#pragma unroll 1
            for (int half = 0; half < 2; ++half) {
#endif
                const LAS unsigned char* img = lds + RC_IMG + half * RC_IMGSZ;
                const LAS bf16_t* AI2 = (const LAS bf16_t*)img; const LAS bf16_t* BPT = (const LAS bf16_t*)(img + 8704); const LAS bf16_t* KPT = (const LAS bf16_t*)(img + 11264);
                const LAS bf16_t* BTT = (const LAS bf16_t*)(img + 13824); const LAS bf16_t* MBT = (const LAS bf16_t*)(img + 14464); const LAS bf16_t* MKT = (const LAS bf16_t*)(img + 15104);
                const LAS bf16_t* TTm = (const LAS bf16_t*)(img + 15744); const LAS float* PC = (const LAS float*)(img + 19456);
                const LAS unsigned char* vvt = img + 17408 + vh * 1024 + (4 * hi + ((lane & 15) >> 2)) * 64 + ((lane >> 4) & 1) * 32 + (lane & 3) * 8;
                const LAS bf16_t* arow = AI2 + rt * RC_PA; const LAS bf16_t* rrow = AI2 + (16 + rt) * RC_PA;
                const bf16x8 fa0 = afrag_k(arow, 0, hi), fa1 = afrag_k(arow, 16, hi), fa2 = afrag_k(arow, 32, hi), fa3 = afrag_k(arow, 48, hi);
                const bf16x8 fr0 = afrag_k(rrow, 0, hi), fr1 = afrag_k(rrow, 16, hi), fr2 = afrag_k(rrow, 32, hi), fr3 = afrag_k(rrow, 48, hi);
                const bf16x8 fbt = afrag_k(BTT + rt * RC_PT, 0, hi), ftt = afrag_k(TTm + rt * RC_PT, 0, hi), fmb = afrag_k(MBT + rt * RC_PT, 0, hi), fmk = afrag_k(MKT + rt * RC_PT, 0, hi);
                const bf16x8 fbp0 = afrag_k(BPT + r32 * RC_PT, 0, hi), fkp0 = afrag_k(KPT + r32 * RC_PT, 0, hi), fbp1 = afrag_k(BPT + (32 + r32) * RC_PT, 0, hi), fkp1 = afrag_k(KPT + (32 + r32) * RC_PT, 0, hi);
                f32x4_t pc0[4], pc1[4];
#pragma unroll
                for (int g = 0; g < 4; ++g) { pc0[g] = *(const LAS f32x4_t*)(PC + 8 * g + 4 * hi); pc1[g] = *(const LAS f32x4_t*)(PC + 32 + 8 * g + 4 * hi); }
                const s16x4 vlo = vtr(vvt), vhi = vtr(vvt + 512);
                const bf16x8 vf = {vlo[0], vlo[1], vlo[2], vlo[3], vhi[0], vhi[1], vhi[2], vhi[3]};
                __builtin_amdgcn_sched_barrier(0);
                const bf16x8 sf0 = cvt8(S0, 0), sf1 = cvt8(S0, 8), sf2 = cvt8(S1, 0), sf3 = cvt8(S1, 8);
                f32x16 X;
#pragma unroll
                for (int r = 0; r < 16; ++r) X[r] = 0.f;
                X = __builtin_amdgcn_mfma_f32_32x32x16_bf16(fa0, sf0, X, 0, 0, 0);
                X = __builtin_amdgcn_mfma_f32_32x32x16_bf16(fa1, sf1, X, 0, 0, 0);
                X = __builtin_amdgcn_mfma_f32_32x32x16_bf16(fa2, sf2, X, 0, 0, 0);
                X = __builtin_amdgcn_mfma_f32_32x32x16_bf16(fa3, sf3, X, 0, 0, 0);
                X = __builtin_amdgcn_mfma_f32_32x32x16_bf16(fbt, vf, X, 0, 0, 0);
                f32x16 Yt;
#pragma unroll
                for (int r = 0; r < 16; ++r) Yt[r] = 0.f;
                Yt = __builtin_amdgcn_mfma_f32_32x32x16_bf16(fr0, sf0, Yt, 0, 0, 0);
                Yt = __builtin_amdgcn_mfma_f32_32x32x16_bf16(fr1, sf1, Yt, 0, 0, 0);
                Yt = __builtin_amdgcn_mfma_f32_32x32x16_bf16(fr2, sf2, Yt, 0, 0, 0);
                Yt = __builtin_amdgcn_mfma_f32_32x32x16_bf16(fr3, sf3, Yt, 0, 0, 0);
                Yt = __builtin_amdgcn_mfma_f32_32x32x16_bf16(fmk, vf, Yt, 0, 0, 0);
                const bf16x8 xf = cvt8(X, 0);
                f32x16 U;
#pragma unroll
                for (int r = 0; r < 16; ++r) U[r] = 0.f;
                U = __builtin_amdgcn_mfma_f32_32x32x16_bf16(ftt, xf, U, 0, 0, 0);
#pragma unroll
                for (int g = 0; g < 4; ++g) {
#pragma unroll
                    for (int e = 0; e < 4; ++e) { S0[4 * g + e] *= pc0[g][e]; S1[4 * g + e] *= pc1[g][e]; }
                }
                S0 = __builtin_amdgcn_mfma_f32_32x32x16_bf16(fkp0, vf, S0, 0, 0, 0);
                S1 = __builtin_amdgcn_mfma_f32_32x32x16_bf16(fkp1, vf, S1, 0, 0, 0);
                const bf16x8 uf = cvt8(U, 0);
                Yt = __builtin_amdgcn_mfma_f32_32x32x16_bf16(fmb, uf, Yt, 0, 0, 0);
                S0 = __builtin_amdgcn_mfma_f32_32x32x16_bf16(fbp0, uf, S0, 0, 0, 0);
                S1 = __builtin_amdgcn_mfma_f32_32x32x16_bf16(fbp1, uf, S1, 0, 0, 0);
#pragma unroll
                for (int r = 0; r < 8; ++r) pY[(16 * half + crow(r, hi)) * 64 + 32 * vh + r32] = Yt[r];
            }
            __syncthreads();
        }
        __syncthreads();
    } else if (wave < 4) {
        const int half = wave - 2, k = lane, r32 = lane & 31, hi = lane >> 5;
        LAS unsigned char* img = lds + RC_IMG + half * RC_IMGSZ;
        LAS bf16_t* AI2 = (LAS bf16_t*)img; LAS bf16_t* BK2 = (LAS bf16_t*)(img + 4352); LAS bf16_t* BPT = (LAS bf16_t*)(img + 8704); LAS bf16_t* KPT = (LAS bf16_t*)(img + 11264);
        LAS bf16_t* BTT = (LAS bf16_t*)(img + 13824); LAS bf16_t* MBT = (LAS bf16_t*)(img + 14464); LAS bf16_t* MKT = (LAS bf16_t*)(img + 15104); LAS bf16_t* TTm = (LAS bf16_t*)(img + 15744);
        LAS float* ATT = (LAS float*)(img + 16384); LAS bf16_t* VVT = (LAS bf16_t*)(img + 17408); LAS float* PC = (LAS float*)(img + 19456);
        const LAS float* arr = (const LAS float*)(lds + RC_ARR) + (16 * half) * 64 + k;
        __syncthreads();
        __syncthreads();
        for (int c = 0; c < RW_NCH; ++c) {
#if PROBE_DUP == 20
#pragma unroll 1
          for (int rep_ = 0; rep_ < (dry ? 1 : 2); ++rep_) {
#endif
            rc_opnd8<0>(arr, img, k);
            asm volatile("s_waitcnt lgkmcnt(0)" ::: "memory");
            { volatile LAS unsigned* fl = (volatile LAS unsigned*)(lds + RC_FLAG) + half; unsigned sp_ = 0u;
              while (*fl != (unsigned)(c + 1) && ++sp_ < (1u << 20)) __builtin_amdgcn_s_sleep(1); }
            asm volatile("" ::: "memory");
            f32x16 G;
#pragma unroll
            for (int r = 0; r < 16; ++r) G[r] = 0.f;
#pragma unroll
            for (int d = 0; d < 4; ++d)
                G = __builtin_amdgcn_mfma_f32_32x32x16_bf16(nfrag(BK2 + r32 * RC_PA + 16 * d + 8 * hi), nfrag(AI2 + r32 * RC_PA + 16 * d + 8 * hi), G, 0, 0, 0);
            {
                const int tcol = r32 & 15; const bool isR = r32 >= 16;
#pragma unroll
                for (int g2 = 0; g2 < 2; ++g2) {
                    const int i0 = 8 * g2 + 4 * hi;
                    float t0[4], t1[4];
#pragma unroll
                    for (int e = 0; e < 4; ++e) { const bool keep = isR ? (i0 + e <= tcol) : (i0 + e < tcol); t0[e] = keep ? G[4 * g2 + e] : 0.f; t1[e] = keep ? G[8 + 4 * g2 + e] : 0.f; }
                    const unsigned long long w1 = (unsigned long long)cvtpk(t1[0], t1[1]) | ((unsigned long long)cvtpk(t1[2], t1[3]) << 32);
                    if (isR) { *(LAS unsigned long long*)(MBT + tcol * RC_PT + i0) = (unsigned long long)cvtpk(t0[0], t0[1]) | ((unsigned long long)cvtpk(t0[2], t0[3]) << 32);
                               *(LAS unsigned long long*)(MKT + tcol * RC_PT + i0) = w1; }
                    else { *(LAS f32x4_t*)(ATT + tcol * 16 + i0) = (f32x4_t){t0[0], t0[1], t0[2], t0[3]}; *(LAS unsigned long long*)(BTT + tcol * RC_PT + i0) = w1; }
                }
            }
            asm volatile("s_waitcnt lgkmcnt(0)" ::: "memory");
            {
                const int jj = lane & 15; float tr[16];
                f32x4_t at[16][4];
#pragma unroll
                for (int t = 1; t < 16; ++t) {
#pragma unroll
                    for (int q4 = 0; q4 < (t + 3) / 4; ++q4) at[t][q4] = *(const LAS f32x4_t*)(ATT + t * 16 + 4 * q4);
                }
                __builtin_amdgcn_sched_barrier(0);
#pragma unroll
                for (int t = 0; t < 16; ++t) {
                    float x0 = jj == t ? 1.f : 0.f, x1 = 0.f, x2 = 0.f, x3 = 0.f;
#pragma unroll
                    for (int q4 = 0; q4 < (t + 3) / 4; ++q4) { const f32x4_t a4 = at[t][q4];
                        if (4 * q4 + 0 < t) x0 += a4[0] * tr[4 * q4 + 0]; if (4 * q4 + 1 < t) x1 += a4[1] * tr[4 * q4 + 1];
                        if (4 * q4 + 2 < t) x2 += a4[2] * tr[4 * q4 + 2]; if (4 * q4 + 3 < t) x3 += a4[3] * tr[4 * q4 + 3]; }
                    tr[t] = (x0 + x1) + (x2 + x3);
                }
#pragma unroll
                for (int t = 0; t < 16; ++t) TTm[t * RC_PT + jj] = bf1(tr[t]);
            }
#if PROBE_DUP == 20
            asm volatile("s_waitcnt lgkmcnt(0)" ::: "memory");
          }
#endif
            __syncthreads();
            __syncthreads();
        }
        __syncthreads();
    } else {
        const int hw = wave - 4, t8 = lane >> 3, ch = lane & 7;
        LAS bf16_t* stg = (LAS bf16_t*)(lds + RC_STG + hw * 2560);
        const LAS f32x4_t* cst = (const LAS f32x4_t*)(lds + RC_CST) + 2 * ch;
        {
            LAS float* cw = (LAS float*)(lds + RC_CST);
            for (int v = hw; v < 14; v += 4) {
                float x = 0.f;
                switch (v) { case 0: x = W.mu[hc]; break; case 1: x = W.mu[512 + hc]; break; case 2: x = W.mu[1024 + hc]; break; case 3: x = W.mu[1536 + lane]; break; case 4: x = W.mu[1600 + lane]; break;
                    case 5: x = (VRES && lane < 32) ? W.mu[1664 + lane] : 0.f; break; case 6: x = W.w0[hc]; break; case 7: x = W.a0[hc]; break; case 8: x = VRES ? W.v0[hc] : 0.f; break;
                    case 9: x = W.k_k[hc]; break; case 10: x = W.k_a[hc]; break; case 11: x = W.r_k[hc]; break; case 12: x = W.lnx_w[hc]; break; default: x = W.lnx_b[hc]; break; }
                cw[v * 64 + lane] = x;
            }
        }
        u32x4 cur[6], prv[6], vfr, gt;
        auto load_raw = [&](int c) {
            const int t = c * RW_T + 8 * hw + t8;
            const bf16_t* p = proj + (row0 + t) * PO; const bf16_t* q = t > 0 ? p - PO : zrow;
            cur[0] = *(const u32x4*)(p + O_R + h * 64 + 8 * ch); cur[1] = *(const u32x4*)(p + O_K + h * 64 + 8 * ch); cur[2] = *(const u32x4*)(p + O_V + h * 64 + 8 * ch);
            cur[3] = *(const u32x4*)(p + O_WD + 8 * ch); cur[4] = *(const u32x4*)(p + O_AD + 8 * ch); cur[5] = VRES ? *(const u32x4*)(p + O_MV + 8 * (ch & 3)) : (u32x4){0u, 0u, 0u, 0u};
            prv[0] = *(const u32x4*)(q + O_R + h * 64 + 8 * ch); prv[1] = *(const u32x4*)(q + O_K + h * 64 + 8 * ch); prv[2] = *(const u32x4*)(q + O_V + h * 64 + 8 * ch);
            prv[3] = *(const u32x4*)(q + O_WD + 8 * ch); prv[4] = *(const u32x4*)(q + O_AD + 8 * ch); prv[5] = VRES ? *(const u32x4*)(q + O_MV + 8 * (ch & 3)) : (u32x4){0u, 0u, 0u, 0u};
            if (VRES) vfr = *(const u32x4*)(vfirst + (row0 + t) * 512 + h * 64 + 8 * ch);
        };
        auto load_gate = [&](int c) { gt = *(const u32x4*)(proj + (row0 + c * RW_T + 8 * hw + t8) * PO + O_G + 512 + h * 64 + 8 * ch); };
#define UNPK8(dst, W_) do { const u32x4 w_ = (W_); dst[0] = __uint_as_float(w_[0] << 16); dst[1] = __uint_as_float(w_[0] & 0xffff0000u); dst[2] = __uint_as_float(w_[1] << 16); dst[3] = __uint_as_float(w_[1] & 0xffff0000u); \
        dst[4] = __uint_as_float(w_[2] << 16); dst[5] = __uint_as_float(w_[2] & 0xffff0000u); dst[6] = __uint_as_float(w_[3] << 16); dst[7] = __uint_as_float(w_[3] & 0xffff0000u); } while (0)
#define CST8(dst, v) do { const f32x4_t c0_ = cst[16 * (v)], c1_ = cst[16 * (v) + 1]; dst[0] = c0_[0]; dst[1] = c0_[1]; dst[2] = c0_[2]; dst[3] = c0_[3]; dst[4] = c1_[0]; dst[5] = c1_[1]; dst[6] = c1_[2]; dst[7] = c1_[3]; } while (0)
#define PK8(v) ((u32x4){cvtpk(v[0], v[1]), cvtpk(v[2], v[3]), cvtpk(v[4], v[5]), cvtpk(v[6], v[7])})
#define ST8(arr, o, v) do { *(LAS f32x4_t*)((arr) + (o)) = (f32x4_t){v[0], v[1], v[2], v[3]}; *(LAS f32x4_t*)((arr) + (o) + 4) = (f32x4_t){v[4], v[5], v[6], v[7]}; } while (0)
#define LD8(dst, arr, o) do { const f32x4_t l0_ = *(const LAS f32x4_t*)((arr) + (o)), l1_ = *(const LAS f32x4_t*)((arr) + (o) + 4); dst[0] = l0_[0]; dst[1] = l0_[1]; dst[2] = l0_[2]; dst[3] = l0_[3]; dst[4] = l1_[0]; dst[5] = l1_[1]; dst[6] = l1_[2]; dst[7] = l1_[3]; } while (0)
        float rs[8], ks[8], vs[8]; u32x4 vfr_s = (u32x4){0u, 0u, 0u, 0u};
        auto prep1 = [&]() {
            float x[8], p[8], m[8], y[8];
            vfr_s = vfr;
            UNPK8(x, cur[0]); UNPK8(p, prv[0]); CST8(m, 0);
#pragma unroll
            for (int e = 0; e < 8; ++e) rs[e] = x[e] + (p[e] - x[e]) * m[e];
            UNPK8(x, cur[1]); UNPK8(p, prv[1]); CST8(m, 1);
#pragma unroll
            for (int e = 0; e < 8; ++e) ks[e] = x[e] + (p[e] - x[e]) * m[e];
            UNPK8(x, cur[2]); UNPK8(p, prv[2]); CST8(m, 2);
#pragma unroll
            for (int e = 0; e < 8; ++e) vs[e] = x[e] + (p[e] - x[e]) * m[e];
            UNPK8(x, cur[3]); UNPK8(p, prv[3]); CST8(m, 3);
#pragma unroll
            for (int e = 0; e < 8; ++e) { const float wds = x[e] + (p[e] - x[e]) * m[e]; y[e] = 1.f - 2.f * __builtin_amdgcn_rcpf(1.f + __builtin_amdgcn_exp2f(2.f * LOG2E * wds)); }
            *(LAS u32x4*)(stg + t8 * 64 + 8 * ch) = PK8(y);
            UNPK8(x, cur[4]); UNPK8(p, prv[4]); CST8(m, 4);
#pragma unroll
            for (int e = 0; e < 8; ++e) y[e] = x[e] + (p[e] - x[e]) * m[e];
            *(LAS u32x4*)(stg + 512 + t8 * 64 + 8 * ch) = PK8(y);
            if (VRES) {
                UNPK8(x, cur[5]); UNPK8(p, prv[5]);
                { const LAS f32x4_t* cm = (const LAS f32x4_t*)(lds + RC_CST) + 16 * 5 + 2 * (ch & 3); const f32x4_t c0_ = cm[0], c1_ = cm[1]; m[0] = c0_[0]; m[1] = c0_[1]; m[2] = c0_[2]; m[3] = c0_[3]; m[4] = c1_[0]; m[5] = c1_[1]; m[6] = c1_[2]; m[7] = c1_[3]; }
#pragma unroll
                for (int e = 0; e < 8; ++e) y[e] = x[e] + (p[e] - x[e]) * m[e];
                if (ch < 4) *(LAS u32x4*)(stg + 1024 + t8 * 32 + 8 * ch) = PK8(y);
            }
            asm volatile("s_waitcnt lgkmcnt(0)" ::: "memory");
        };
        auto prep2 = [&](int c) {
            LAS float* bb = (LAS float*)(lds + RC_ARR); LAS float* bon = (LAS float*)(lds + RC_BON + (c & 1) * 8192);
            const int o = (8 * hw + t8) * 64 + 8 * ch;
            float x[8], p[8], m[8], y[8];
            {
                const int tokr = lane & 7, kg = lane >> 4, col16 = lane & 15, tb = 4 * (kg & 1);
                bf16x8 fw[2], fa[2], fv;
#pragma unroll
                for (int ks2 = 0; ks2 < 2; ++ks2) { fw[ks2] = *(const LAS bf16x8*)(stg + tokr * 64 + 32 * ks2 + 8 * kg); fa[ks2] = *(const LAS bf16x8*)(stg + 512 + tokr * 64 + 32 * ks2 + 8 * kg); }
                fv = *(const LAS bf16x8*)(stg + 1024 + tokr * 32 + 8 * kg);
#pragma unroll
                for (int ct = 0; ct < 4; ++ct) {
                    bf16x8 bw[2], ba[2], bv;
#pragma unroll
                    for (int ks2 = 0; ks2 < 2; ++ks2) { bw[ks2] = bfr[(2 * ct + ks2) * 64 + lane]; ba[ks2] = bfr[(8 + 2 * ct + ks2) * 64 + lane]; }
                    bv = VRES ? bfr[(16 + ct) * 64 + lane] : bf16x8{0, 0, 0, 0, 0, 0, 0, 0};
                    f32x4_t dw = (f32x4_t){0.f, 0.f, 0.f, 0.f}, da = dw, dv = dw;
#pragma unroll
                    for (int ks2 = 0; ks2 < 2; ++ks2) {
                        dw = __builtin_amdgcn_mfma_f32_16x16x32_bf16(fw[ks2], bw[ks2], dw, 0, 0, 0);
                        da = __builtin_amdgcn_mfma_f32_16x16x32_bf16(fa[ks2], ba[ks2], da, 0, 0, 0);
                    }
                    if (VRES) dv = __builtin_amdgcn_mfma_f32_16x16x32_bf16(fv, bv, dv, 0, 0, 0);
                    const int od = (8 * hw + tb) * 64 + 16 * ct + col16;
#pragma unroll
                    for (int r = 0; r < 4; ++r) { bb[2048 + od + 64 * r] = dw[r]; bb[6144 + od + 64 * r] = da[r]; if (VRES) bb[8192 + od + 64 * r] = dv[r]; }
                }
            }
            asm volatile("s_waitcnt lgkmcnt(0)" ::: "memory");
            float dec[8], av[8], kk[8];
            LD8(x, bb + 2048, o); CST8(m, 6);
#pragma unroll
            for (int e = 0; e < 8; ++e) dec[e] = __builtin_amdgcn_exp2f(-0.60653065971f * LOG2E * fsigmoid(m[e] + x[e]));
            LD8(x, bb + 6144, o); CST8(m, 7);
#pragma unroll
            for (int e = 0; e < 8; ++e) av[e] = fsigmoid(m[e] + x[e]);
            if (VRES) {
                LD8(x, bb + 8192, o); CST8(m, 8); UNPK8(p, vfr_s);
#pragma unroll
                for (int e = 0; e < 8; ++e) vs[e] = vs[e] + (p[e] - vs[e]) * fsigmoid(m[e] + x[e]);
            } else if (!dry) *(u32x4*)(vfirst + (row0 + c * RW_T + 8 * hw + t8) * 512 + h * 64 + 8 * ch) = PK8(vs);
            CST8(m, 9);
            float ss = 0.f;
#pragma unroll
            for (int e = 0; e < 8; ++e) { kk[e] = ks[e] * m[e]; ss += kk[e] * kk[e]; }
            const float inv = 1.f / fmaxf(sqrtf(red8(ss)), 1e-12f);
            CST8(m, 10);
#pragma unroll
            for (int e = 0; e < 8; ++e) { kk[e] *= inv; x[e] = ks[e] * (1.f + (av[e] - 1.f) * m[e]); p[e] = -kk[e]; y[e] = kk[e] * av[e]; }
            ST8(bb, o, rs); ST8(bb + 2048, o, dec); ST8(bb + 4096, o, x); ST8(bb + 6144, o, p); ST8(bb + 8192, o, y); ST8(bb + 10240, o, vs);
            CST8(m, 11);
            float s3 = 0.f;
#pragma unroll
            for (int e = 0; e < 8; ++e) s3 += rs[e] * x[e] * m[e];
            const float coef = red8(s3);
#pragma unroll
            for (int e = 0; e < 8; ++e) y[e] = coef * vs[e];
            ST8(bon, o, y);
        };
        auto finish = [&](int c) {
            const LAS float* pY = (const LAS float*)(lds + RC_Y + (c & 1) * 8192); const LAS float* bon = (const LAS float*)(lds + RC_BON + (c & 1) * 8192);
            const int o = (8 * hw + t8) * 64 + 8 * ch;
            float y[8], bo[8], m[8], q[8], g[8];
            LD8(y, pY, o); LD8(bo, bon, o);
            float s1 = 0.f;
#pragma unroll
            for (int e = 0; e < 8; ++e) s1 += y[e];
            const float mean = red8(s1) * (1.f / 64.f);
            float s2 = 0.f;
#pragma unroll
            for (int e = 0; e < 8; ++e) { y[e] -= mean; s2 += y[e] * y[e]; }
            const float rstd = rsqrtf(red8(s2) * (1.f / 64.f) + 64e-5f);
            CST8(m, 12); CST8(q, 13); UNPK8(g, gt);
#pragma unroll
            for (int e = 0; e < 8; ++e) y[e] = (y[e] * rstd * m[e] + q[e] + bo[e]) * g[e];
            if (!dry) *(u32x4*)(proj + (row0 + c * RW_T + 8 * hw + t8) * PO + O_G + 512 + h * 64 + 8 * ch) = PK8(y);
        };
        asm volatile("s_waitcnt lgkmcnt(0)" ::: "memory");
        load_raw(0);
        __syncthreads();
        prep1(); prep2(0);
        load_raw(1); load_gate(0);
        __syncthreads();
        for (int c = 0; c < RW_NCH; ++c) {
            if (c >= 1) { finish(c - 1); load_gate(c); }
            if (c + 1 < RW_NCH) { prep1(); if (c + 2 < RW_NCH) load_raw(c + 2); }
            __syncthreads();
            if (c + 1 < RW_NCH) prep2(c + 1);
            __syncthreads();
        }
        finish(RW_NCH - 1);
        __syncthreads();
#undef UNPK8
#undef CST8
#undef PK8
#undef ST8
#undef LD8
    }
}

typedef __attribute__((address_space(1))) unsigned gu32;
#define XB_TMO      128
#define XB_XCNT(j)  (256  + 64 * (j))
#define XB_XSUB(j)  (1280 + 64 * (j))
#define XB_XGEN(j)  (2304 + 64 * (j))
#define XB_TOP      3328
#define XB_TOPGEN   3392
#define XCD_BAR_WORDS 3456
#define XB_SPIN_CAP (1u << 18)

__device__ __forceinline__ unsigned xb_ld(unsigned* p)              { return __hip_atomic_load(p, __ATOMIC_RELAXED, __HIP_MEMORY_SCOPE_AGENT); }
__device__ __forceinline__ unsigned xb_add(unsigned* p, unsigned v) { return __hip_atomic_fetch_add(p, v, __ATOMIC_RELAXED, __HIP_MEMORY_SCOPE_AGENT); }
__device__ __forceinline__ unsigned xb_xcc_id() { return (unsigned)__builtin_amdgcn_s_getreg((3 << 11) | 20) & 0xFu; }
#define XB_SPIN(cond, bar) do { unsigned _sp = 0; while (cond) { __builtin_amdgcn_s_sleep(1); \
    if ((++_sp & 255u) == 0u) { if (xb_ld(&(bar)[XB_TMO])) break; if (_sp > XB_SPIN_CAP) { atomicAdd(&(bar)[XB_TMO], 1u); break; } } } } while (0)

struct XcdBarrier {
    unsigned* bar; unsigned x;
    volatile LAS unsigned* st;
};

__device__ __forceinline__ XcdBarrier xcd_barrier_post(unsigned* bar, volatile LAS unsigned* st) {
    XcdBarrier b; b.bar = bar; b.x = xb_xcc_id(); b.st = st;
    if (threadIdx.x == 0) (void)xb_add(&bar[XB_XCNT(b.x)], 1u);
    return b;
}
__device__ __forceinline__ void xcd_barrier_complete(unsigned* bar, unsigned x, unsigned& nloc, unsigned& nx) {
    const unsigned G = gridDim.x * gridDim.y * gridDim.z;
    unsigned sum, cnt, mine, sp = 0u;
    for (;;) {
        sum = 0u; cnt = 0u; mine = 0u;
#pragma unroll
        for (unsigned j = 0; j < 16; ++j) { const unsigned c = xb_ld(&bar[XB_XCNT(j)]); sum += c; cnt += (c > 0u) ? 1u : 0u; mine = (j == x) ? c : mine; }
        if (sum == G) break;
        __builtin_amdgcn_s_sleep(1);
        if ((++sp & 255u) == 0u) { if (xb_ld(&bar[XB_TMO])) break; if (sp > XB_SPIN_CAP) { atomicAdd(&bar[XB_TMO], 1u); break; } }
    }
    nloc = mine > 0u ? mine : 1u; nx = cnt > 0u ? cnt : 1u;
}

__device__ __forceinline__ void xcd_barrier(const XcdBarrier& b) {
    asm volatile("s_waitcnt vmcnt(0)" ::: "memory");
    __syncthreads();
    if (threadIdx.x == 0) {
        unsigned* bar = b.bar;
        __builtin_amdgcn_s_waitcnt(0);
        unsigned nloc = b.st[0], nx = b.st[1];
        if (nloc == 0u) { xcd_barrier_complete(bar, b.x, nloc, nx); b.st[0] = nloc; b.st[1] = nx; }
        const unsigned old = xb_add(&bar[XB_XSUB(b.x)], 1u);
        const unsigned gen = old / nloc;
        if (old + 1u == (gen + 1u) * nloc) {
            __builtin_amdgcn_fence(__ATOMIC_RELEASE, "agent");
            asm volatile("s_waitcnt vmcnt(0)" ::: "memory");
            const unsigned og = xb_add(&bar[XB_TOP], 1u);
            const unsigned tg = og / nx;
            if (og + 1u == (tg + 1u) * nx) xb_add(&bar[XB_TOPGEN], 1u);
            else XB_SPIN(xb_ld(&bar[XB_TOPGEN]) == tg, bar);
            __builtin_amdgcn_fence(__ATOMIC_ACQUIRE, "agent");
            xb_add(&bar[XB_XGEN(b.x)], 1u);
            asm volatile("s_waitcnt vmcnt(0)" ::: "memory");
        } else {
            XB_SPIN(xb_ld(&bar[XB_XGEN(b.x)]) == gen, bar);
            __builtin_amdgcn_fence(__ATOMIC_ACQUIRE, "agent");
            asm volatile("s_waitcnt vmcnt(0)" ::: "memory");
        }
    }
    __syncthreads();
}

constexpr int LDS_VBUF = 0, LDS_SLOT = 163840 - 64;
DI int next_chunk(unsigned* counter, LAS unsigned* slot) {
    __syncthreads();
    if (threadIdx.x == 0) *slot = atomicAdd(counter, 1u);
    __syncthreads();
    return (int)*slot;
}
constexpr int NWAVES = 8, LDS_BYTES = 163840, GRID = 256;
template <class E> struct PgEpi {
    static constexpr bool PERM = true, AFTER_DRAIN = false;
    E e; bool dry;
    template <int KIND> DI void rows(const pg8::f32x4 (&acc)[2][2][4][2], const pg8::Unit& u, int wr, int wc, int fr, int fq) const {
        const int row0 = u.pm * 256 + wr * 64 + fr, col0 = u.pn * 256 + wc * 32 + 8 * fq;
        constexpr int PD = sizeof(typename E::Pre) <= 16 ? (sizeof(typename E::Tab) >= 32 ? 4 : 8) : sizeof(typename E::Pre) <= 32 ? 4 : 2;
        constexpr int TD = sizeof(typename E::Tab) >= 32 ? 3 : 8;
        typename E::Pre pr[8]; typename E::Tab tb[8];
#pragma unroll
        for (int i = 0; i < PD; ++i) pr[i] = e.prefetch(row0 + (i >> 2) * 128 + (i & 3) * 16, col0);
#pragma unroll
        for (int i = 0; i < TD; ++i) tb[i] = e.template tab<KIND>(row0 + (i >> 2) * 128 + (i & 3) * 16, col0);
#pragma unroll
        for (int i = 0; i < 8; ++i) {
            const int ai = i >> 2, m = i & 3, row = row0 + ai * 128 + m * 16;
            if (i + PD < 8) pr[i + PD] = e.prefetch(row0 + ((i + PD) >> 2) * 128 + ((i + PD) & 3) * 16, col0);
            if (i + TD < 8) tb[i + TD] = e.template tab<KIND>(row0 + ((i + TD) >> 2) * 128 + ((i + TD) & 3) * 16, col0);
            asm volatile("" ::: "memory");
            const typename E::Pre& pre = pr[i];
            const float rs = e.rowscale(pre);
            float ss = 0.f;
#pragma unroll
            for (int bj = 0; bj < 2; ++bj) {
                const pg8::f32x4 a0 = acc[ai][bj][m][0], a1 = acc[ai][bj][m][1];
                float v[8] = {a0[0], a0[1], a0[2], a0[3], a1[0], a1[1], a1[2], a1[3]};
                if (!dry) ss += e.template apply<KIND>(row, col0 + bj * 128, v, rs, pre, bj, tb[i]); else ss += v[0] + v[7];
            }
            if (E::HAS_SSQ) { ss = xadd32(xadd16(ss)); if (fq == 0 && !dry) e.put_ssq(row, u.pn, wc, ss); }
            if (dry) asm volatile("" :: "v"(ss));
        }
    }
    DI void operator()(const pg8::f32x4 (&acc)[2][2][4][2], const pg8::Unit& u, int wr, int wc, int fr, int fq) const {
        const int k = e.kind(u.pn);
        if (E::NKIND == 1 || k == 0) rows<0>(acc, u, wr, wc, fr, fq);
        else if (k == 1) rows<1>(acc, u, wr, wc, fr, fq);
        else if (k == 2) rows<2>(acc, u, wr, wc, fr, fq);
        else if (k == 3) rows<3>(acc, u, wr, wc, fr, fq);
        else if (k == 4) rows<4>(acc, u, wr, wc, fr, fq);
        else if (k == 5) rows<(E::NKIND > 5 ? 5 : 0)>(acc, u, wr, wc, fr, fq);
        else rows<(E::NKIND > 6 ? 6 : 0)>(acc, u, wr, wc, fr, fq);
    }
};
template <int M, int N, int K, int LDA, class E, int G = GRID, int C0 = 0> DI void run_gemm(pg8::PG8_LAS_T* lds, const bf16_t* A, const bf16_t* Bt, const E& e, bool dry = false) {
    int bid = (int)blockIdx.x - C0; asm volatile("" : "+s"(bid));
    pg8::Gemm<M, N, K, LDA> g{A, Bt}; pg8::StaticOrder S; S.init(M, N, G, bid);
    PgEpi<E> pe{e, dry};
    pg8::gemm_phase<PgEpi<E>, pg8::StaticOrder, true, true>(lds, g, S, pe);
}

namespace cg = cooperative_groups;

struct Args { const void* in[51]; float* out; unsigned char* ws; long long probe; };
static_assert(sizeof(Args) == 54 * 8, "no padding");

__global__ void __launch_bounds__(NWAVES * 64, 2) mega(Args a) {
    extern __shared__ __attribute__((aligned(16))) unsigned char lds[];
    cg::grid_group grid = cg::this_grid();
    const int tid = threadIdx.x, wave = __builtin_amdgcn_readfirstlane(tid >> 6);
    const int G = gridDim.x, gw = blockIdx.x * NWAVES + wave, ngw = G * NWAVES;
    pg8::PG8_LAS_T* lds3 = (pg8::PG8_LAS_T*)lds;
#define GASP __attribute__((address_space(1)))
#define WSB() ({ GASP unsigned char* p_ = (GASP unsigned char*)a.ws; asm volatile("" : "+s"(p_)); (unsigned char*)p_; })
#define ws WSB()
#define out ({ GASP float* o_ = (GASP float*)a.out; asm volatile("" : "+s"(o_)); (float*)o_; })
#define ssq ((float*)(ws + WS_SSQ))
#define cqsq ((float*)(ws + WS_CQSQ))
#define ckvsq ((float*)(ws + WS_CKVSQ))
#define mrstd ((float*)(ws + WS_MRSTD))
#define tabA ((float2*)(ws + WS_TABA))
#define tabR ((float2*)(ws + WS_TABR))
#define tabM ((float2*)(ws + WS_TABM))
#define wmem ((bf16_t*)(ws + WS_WMEM))
#define memb ((bf16_t*)(ws + WS_MEMB))
#define memkv ((bf16_t*)(ws + WS_MEMKV))
#define vfirst ((bf16_t*)(ws + WS_VFIRST))
#define xb ((bf16_t*)(ws + WS_XB))
#define mlakv ((bf16_t*)out)
#define mlaq ((bf16_t*)(ws + WS_MLAQ))
#define proj ((bf16_t*)(ws + ((l & 1) ? WS_PROJ : WS_PROJ - 4 * MiB)))
    const void* const* kin = (const void* const*)__builtin_amdgcn_kernarg_segment_ptr();
#define FIN(i) ((const float*)(const GASP float*)kin[i])
#if PROBE_TS_A >= 0
    int n_stamp = 0;
#define STAMP() do { if (blockIdx.x == 0 && tid == 0) ((unsigned long long*)(ws + WS_CTL + 32768))[n_stamp] = __builtin_amdgcn_s_memrealtime(); ++n_stamp; } while (0)
#else
#define STAMP() do {} while (0)
#endif
    STAMP();
    const bool rt_true = (a.probe == 0), rt_false = (a.probe != 0);
    volatile LAS unsigned* xst = (volatile LAS unsigned*)((LAS unsigned char*)lds + LDS_SLOT + 16);
    if (tid < 2) xst[tid] = 0u;
    __syncthreads();
#define XBAR_WORDS ((unsigned*)(ws + WS_CTL) + 4096)
    (void)xcd_barrier_post(XBAR_WORDS, xst);
#if PROBE_DUP == 14
#define GSYNC() do { XcdBarrier b_; b_.bar = XBAR_WORDS; b_.x = xb_xcc_id(); b_.st = xst; xcd_barrier(b_); xcd_barrier(b_); xcd_barrier(b_); } while (0)
#else
#define GSYNC() do { XcdBarrier b_; b_.bar = XBAR_WORDS; b_.x = xb_xcc_id(); b_.st = xst; xcd_barrier(b_); } while (0)
#endif
#define WI(l) ((bf16_t*)(ws + ((l) == 0 ? WS_WI0 : (l) == 1 ? WS_WI1 : (l) == 2 ? WS_WI2 : WS_WI3)))
#define WO(l) ((bf16_t*)(ws + WS_WO + (size_t)(l) * 2560 * 1024))
#define WQB(o) ((bf16_t*)(ws + WS_WQB + (size_t)(o) * 512 * 1024))
#define WKVB(o) ((bf16_t*)(ws + WS_WKVB + (size_t)(o) * 256 * 1024))

#if PROBE_DUP == 10
    {
        float* scr = (float*)lds + wave * (64 * 33);
        int base = 0;
#pragma unroll 1
        for (int l = 0; l < 4; ++l) {
            const bool odd = l & 1; const int dcols = l == 3 ? 1696 : 1664;
            const int i_norm = l == 0 ? 5 : l == 1 ? 9 : l == 2 ? 27 : 31, i_win = i_norm + 1;
            const int i_wmem = l == 0 ? 7 : l == 1 ? 25 : l == 2 ? 29 : 49, i_wout = i_wmem + 1;
            wconv_job(scr, gw, ngw, base, FIN(i_win), 1024, odd ? 416 + dcols + 256 + 1280 : 4096, WI(l), odd ? PO : PEN, 0, odd ? 2 : 1, dcols, FIN(i_norm));
            wconv_job(scr, gw, ngw, base, FIN(i_wout), 1280, 1024, WO(l), 1024, 0, 0, 0, (const float*)nullptr);
            wconv_job(scr, gw, ngw, base, FIN(i_wmem), 1024, 512, wmem, 512, l * 512, 0, 0, FIN(3));
        }
#pragma unroll 1
        for (int o = 0; o < 2; ++o) {
            wconv_job(scr, gw, ngw, base, FIN(o ? 34 : 12), 256, 768, WQB(o), 1024, 0, 3, 0, FIN(o ? 33 : 11));
            wconv_job(scr, gw, ngw, base, FIN(o ? 36 : 14), 128, 1024, WKVB(o), 1024, 0, 0, 0, FIN(o ? 35 : 13));
        }
#pragma unroll 1
        for (int o = 0; o < 2; ++o) {
            bf16_t* lt = (bf16_t*)(ws + WS_LORA + (size_t)o * 262144);
            wconv_job(scr, gw, ngw, base, FIN(o ? 39 : 17), 64, 512, lt, 512, 0, 0, 0, (const float*)nullptr);
            wconv_job(scr, gw, ngw, base, FIN(o ? 41 : 19), 64, 512, lt + 32768, 512, 0, 0, 0, (const float*)nullptr);
            if (o) wconv_job(scr, gw, ngw, base, FIN(43), 32, 512, lt + 65536, 512, 0, 0, 0, (const float*)nullptr);
        }
        tables_rows(gw, ngw, (const int*)(const GASP int*)kin[2], tabA, tabR, tabM);
        rows_prep(gw, ngw, FIN(0), xb, ssq, MTOK, 0);
        rows_prep(gw, ngw, FIN(1), memb, mrstd, MROWS, 1);
    }
#endif
#if PROBE_DUP == 40
    {
        float* scr = (float*)lds + wave * (64 * 33);
        int base = 0;
#pragma unroll 1
        for (int l = 0; l < 4; ++l) {
            const bool odd = l & 1; const int dcols = l == 3 ? 1696 : 1664;
            const int i_norm = l == 0 ? 5 : l == 1 ? 9 : l == 2 ? 27 : 31, i_win = i_norm + 1;
            const int i_wmem = l == 0 ? 7 : l == 1 ? 25 : l == 2 ? 29 : 49, i_wout = i_wmem + 1;
            wconv_job(scr, gw, ngw, base, FIN(i_win), 1024, odd ? 416 + dcols + 256 + 1280 : 4096, WI(l), odd ? PO : PEN, 0, odd ? 2 : 1, dcols, FIN(i_norm));
            wconv_job(scr, gw, ngw, base, FIN(i_wout), 1280, 1024, WO(l), 1024, 0, 0, 0, (const float*)nullptr);
            wconv_job(scr, gw, ngw, base, FIN(i_wmem), 1024, 512, wmem, 512, l * 512, 0, 0, FIN(3));
        }
#pragma unroll 1
        for (int o = 0; o < 2; ++o) {
            wconv_job(scr, gw, ngw, base, FIN(o ? 34 : 12), 256, 768, WQB(o), 1024, 0, 3, 0, FIN(o ? 33 : 11));
            wconv_job(scr, gw, ngw, base, FIN(o ? 36 : 14), 128, 1024, WKVB(o), 1024, 0, 0, 0, FIN(o ? 35 : 13));
        }
#pragma unroll 1
        for (int o = 0; o < 2; ++o) {
            bf16_t* lt = (bf16_t*)(ws + WS_LORA + (size_t)o * 262144);
            wconv_job(scr, gw, ngw, base, FIN(o ? 39 : 17), 64, 512, lt, 512, 0, 0, 0, (const float*)nullptr);
            wconv_job(scr, gw, ngw, base, FIN(o ? 41 : 19), 64, 512, lt + 32768, 512, 0, 0, 0, (const float*)nullptr);
            if (o) wconv_job(scr, gw, ngw, base, FIN(43), 32, 512, lt + 65536, 512, 0, 0, 0, (const float*)nullptr);
        }
    }
#endif
#if PROBE_DUP == 41
    {
        tables_rows(gw, ngw, (const int*)(const GASP int*)kin[2], tabA, tabR, tabM);
        rows_prep(gw, ngw, FIN(0), xb, ssq, MTOK, 0);
        rows_prep(gw, ngw, FIN(1), memb, mrstd, MROWS, 1);
    }
#endif
    {
        float* scr = (float*)lds + wave * (64 * 33);
        int base = 0;
#pragma unroll 1
        for (int l = 0; l < 4; ++l) {
            const bool odd = l & 1; const int dcols = l == 3 ? 1696 : 1664;
            const int i_norm = l == 0 ? 5 : l == 1 ? 9 : l == 2 ? 27 : 31, i_win = i_norm + 1;
            const int i_wmem = l == 0 ? 7 : l == 1 ? 25 : l == 2 ? 29 : 49, i_wout = i_wmem + 1;
            wconv_job(scr, gw, ngw, base, FIN(i_win), 1024, odd ? 416 + dcols + 256 + 1280 : 4096, WI(l), odd ? PO : PEN, 0, odd ? 2 : 1, dcols, FIN(i_norm));
            wconv_job(scr, gw, ngw, base, FIN(i_wout), 1280, 1024, WO(l), 1024, 0, 0, 0, (const float*)nullptr);
            wconv_job(scr, gw, ngw, base, FIN(i_wmem), 1024, 512, wmem, 512, l * 512, 0, 0, FIN(3));
        }
#pragma unroll 1
        for (int o = 0; o < 2; ++o) {
            wconv_job(scr, gw, ngw, base, FIN(o ? 34 : 12), 256, 768, WQB(o), 1024, 0, 3, 0, FIN(o ? 33 : 11));
            wconv_job(scr, gw, ngw, base, FIN(o ? 36 : 14), 128, 1024, WKVB(o), 1024, 0, 0, 0, FIN(o ? 35 : 13));
        }
#pragma unroll 1
        for (int o = 0; o < 2; ++o) {
            bf16_t* lt = (bf16_t*)(ws + WS_LORA + (size_t)o * 262144);
            wconv_job(scr, gw, ngw, base, FIN(o ? 39 : 17), 64, 512, lt, 512, 0, 0, 0, (const float*)nullptr);
            wconv_job(scr, gw, ngw, base, FIN(o ? 41 : 19), 64, 512, lt + 32768, 512, 0, 0, 0, (const float*)nullptr);
            if (o) wconv_job(scr, gw, ngw, base, FIN(43), 32, 512, lt + 65536, 512, 0, 0, 0, (const float*)nullptr);
        }
        tables_rows(gw, ngw, (const int*)(const GASP int*)kin[2], tabA, tabR, tabM);
        rows_prep(gw, ngw, FIN(0), xb, ssq, MTOK, 0);
        rows_prep(gw, ngw, FIN(1), memb, mrstd, MROWS, 1);
    }
    grid.sync();
    STAMP();
#if PROBE_DUP == 13
    run_gemm<MROWS, 2048, DM, DM>(lds3, memb, wmem, EpiMemKV{memkv, mrstd}, rt_true);
#endif
    run_gemm<MROWS, 2048, DM, DM>(lds3, memb, wmem, EpiMemKV{memkv, mrstd});
#pragma unroll 1
    for (int l = 0; l < 4; ++l) {
        const int i_wmem = l == 0 ? 7 : l == 1 ? 25 : l == 2 ? 29 : 49;
        if ((l & 1) == 0) {
#if PROBE_DUP == 4
            run_gemm<MTOK, PEN, DM, DM>(lds3, xb, WI(l), EpiEvenIn{proj, ssq, tabA, tabR}, rt_true);
#elif PROBE_DUP == 16
            run_gemm<MTOK, PEN, DM, DM>(lds3, xb, WI(l), EpiEvenIn{proj, ssq, tabA, tabR}, rt_false);
#endif
            run_gemm<MTOK, PEN, DM, DM>(lds3, xb, WI(l), EpiEvenIn{proj, ssq, tabA, tabR}, rt_false);
            GSYNC(); STAMP();
#define EVEN_MIX(lo, hi, qi, dry) do { LAS unsigned* slot = (LAS unsigned*)((LAS unsigned char*)lds + LDS_SLOT); unsigned* ret_done = (unsigned*)(ws + WS_CTL) + 64 * (21 + l); bool ret_ready = false; Ticket tk{(unsigned*)(ws + WS_CTL) + 64 * (qi), 0u, false}; \
                for (;;) { const int c = tk.take(slot) + (lo); if (c >= (hi)) break; \
                    if (c < 64) { unitRetState((LAS unsigned char*)lds, proj, memb, c >> 2, c & 3); \
                        asm volatile("s_waitcnt vmcnt(0)" ::: "memory"); __syncthreads(); \
                        if (tid == 0) { __threadfence(); asm volatile("s_waitcnt vmcnt(0)" ::: "memory"); __hip_atomic_fetch_add(ret_done, 1u, __ATOMIC_RELAXED, __HIP_MEMORY_SCOPE_AGENT); } } \
                    else if (c < 1088) { const int c2 = c - 64; unitAS((LAS unsigned char*)lds, proj, (c2 >> 5) & 15, (c2 >> 2) & 7, c2 & 3, 1 - (c2 >> 9), dry, tk); } \
                    else if (c < 1600) { const int c3 = c - 1088; unitMemS((LAS unsigned char*)lds, proj, PE, E_QM, E_G + 1024, memkv, l, c3 >> 5, (c3 >> 3) & 3, c3 & 7, dry, tk); } \
                    else { const int c4 = c - 1600; \
                        if (!ret_ready) { if (tid == 0) { unsigned spins = 0; while (__hip_atomic_load(ret_done, __ATOMIC_RELAXED, __HIP_MEMORY_SCOPE_AGENT) < 64u && ++spins < (1u << 22)) __builtin_amdgcn_s_sleep(8); \
                                __threadfence(); asm volatile("s_waitcnt vmcnt(0)" ::: "memory"); } __syncthreads(); ret_ready = true; } \
                        unitRetC((LAS unsigned char*)lds, proj, memb, (c4 & 63) >> 2, c4 & 3, 7 - (c4 >> 6), dry, tk); } } } while (0)
#if PROBE_DUP == 1
            EVEN_MIX(0, 2048, 9 + l, rt_true);
#elif PROBE_DUP == 7
            EVEN_MIX(0, 512, 9 + l, rt_true);
#elif PROBE_DUP == 8
            EVEN_MIX(512, 1536, 9 + l, rt_true);
#elif PROBE_DUP == 9
            EVEN_MIX(1536, 2048, 9 + l, rt_true);
#endif
            EVEN_MIX(0, 2112, 1 + l, rt_false);
            GSYNC(); STAMP();
#if PROBE_DUP == 5
            run_gemm<MTOK, DM, 1280, PE>(lds3, proj + E_G, WO(l), EpiWOut<1>{nullptr, out, xb, ssq}, rt_true);
#endif
            if (l == 0) run_gemm<MTOK, DM, 1280, PE>(lds3, proj + E_G, WO(l), EpiWOut<0>{FIN(0), out, xb, ssq}, rt_false);
            else run_gemm<MTOK, DM, 1280, PE>(lds3, proj + E_G, WO(l), EpiWOut<1>{nullptr, out, xb, ssq}, rt_false);
            GSYNC(); STAMP();
        } else {
            const int o = l >> 1;
#if PROBE_DUP == 11
            run_gemm<MTOK, PO, DM, DM>(lds3, xb, WI(l), EpiOddIn{proj, ssq, tabM, cqsq, ckvsq}, rt_true);
#elif PROBE_DUP == 17
            run_gemm<MTOK, PO, DM, DM>(lds3, xb, WI(l), EpiOddIn{proj, ssq, tabM, cqsq, ckvsq}, rt_false);
#endif
            run_gemm<MTOK, PO, DM, DM>(lds3, xb, WI(l), EpiOddIn{proj, ssq, tabM, cqsq, ckvsq});
            GSYNC(); STAMP();
#if PROBE_DUP == 12
            run_gemm<MTOK, 1024, 256, PO>(lds3, proj + O_CQ, WQB(o), EpiMlaQ{mlaq, cqsq, tabM}, rt_true);
            run_gemm<MTOK, 1024, 128, PO>(lds3, proj + O_CKV, WKVB(o), EpiMlaKV{mlakv, ckvsq}, rt_true);
#endif
            unsigned* mla_done = (unsigned*)(ws + WS_CTL) + 64 * (17 + l);
            if (blockIdx.x >= 128) {
                run_gemm<MTOK, 1024, 256, PO, EpiMlaQ, 128, 128>(lds3, proj + O_CQ, WQB(o), EpiMlaQ{mlaq, cqsq, tabM});
                run_gemm<MTOK, 1024, 128, PO, EpiMlaKV, 128, 128>(lds3, proj + O_CKV, WKVB(o), EpiMlaKV{mlakv, ckvsq});
                asm volatile("s_waitcnt vmcnt(0)" ::: "memory");
                __syncthreads();
                if (tid == 0) { __threadfence(); asm volatile("s_waitcnt vmcnt(0)" ::: "memory"); __hip_atomic_fetch_add(mla_done, 1u, __ATOMIC_RELAXED, __HIP_MEMORY_SCOPE_AGENT); }
            } else {
                const bf16_t* lt = (const bf16_t*)(ws + WS_LORA + (size_t)o * 262144);
                if (l == 1) { const RwkvW W{FIN(15), FIN(16), FIN(17), FIN(18), FIN(19), nullptr, nullptr, FIN(20), FIN(21), FIN(22), FIN(23), FIN(24)}; rwkv_unit_c<false>((LAS unsigned char*)lds, proj, vfirst, lt, W, (int)blockIdx.x, (const bf16_t*)(ws + WS_CTL + 40960), rt_false); }
                else { const RwkvW W{FIN(37), FIN(38), FIN(39), FIN(40), FIN(41), FIN(42), FIN(43), FIN(44), FIN(45), FIN(46), FIN(47), FIN(48)}; rwkv_unit_c<true>((LAS unsigned char*)lds, proj, vfirst, lt, W, (int)blockIdx.x, (const bf16_t*)(ws + WS_CTL + 40960), rt_false); }
            }
            if (tid == 0) {
                unsigned spins = 0;
                while (__hip_atomic_load(mla_done, __ATOMIC_RELAXED, __HIP_MEMORY_SCOPE_AGENT) < 128u && ++spins < (1u << 22)) __builtin_amdgcn_s_sleep(8);
                __threadfence(); asm volatile("s_waitcnt vmcnt(0)" ::: "memory");
            }
            __syncthreads();
            STAMP();
#define ODD_MIX(lo, hi, qi, dry) do { LAS unsigned* slot = (LAS unsigned*)((LAS unsigned char*)lds + LDS_SLOT); Ticket tk{(unsigned*)(ws + WS_CTL) + 64 * (qi), 0u, false}; \
                for (;;) { const int c = tk.take(slot) + (lo); if (c >= (hi)) break; \
                    if (c < 1024) unitMlaS((LAS unsigned char*)lds, proj, mlaq, mlakv, (c & 127) >> 3, c & 7, 7 - (c >> 7), dry, tk); \
                    else { const int c3 = c - 1024; unitMemS((LAS unsigned char*)lds, proj, PO, O_QM, O_G + 1024, memkv, l, c3 >> 5, (c3 >> 3) & 3, c3 & 7, dry, tk); } } } while (0)
#if PROBE_DUP == 31
            ODD_MIX(0, 1024, 5 + l, rt_true);
#elif PROBE_DUP == 32
            ODD_MIX(1024, 1536, 5 + l, rt_true);
#endif
            ODD_MIX(0, 1536, 1 + l, rt_false);
            GSYNC(); STAMP();
#if PROBE_DUP == 15
            run_gemm<MTOK, DM, 1280, PO>(lds3, proj + O_G, WO(l), EpiWOut<1>{nullptr, out, xb, ssq}, rt_true);
#endif
            if (l == 1) run_gemm<MTOK, DM, 1280, PO>(lds3, proj + O_G, WO(l), EpiWOut<1>{nullptr, out, xb, ssq});
            else run_gemm<MTOK, DM, 1280, PO>(lds3, proj + O_G, WO(l), EpiWOut<2>{nullptr, out, xb, ssq});
            GSYNC(); STAMP();
        }
    }
#if PROBE_TS_A >= 0
    { const unsigned long long* tsp = (const unsigned long long*)(ws + WS_CTL + 32768);
      float T_us = (float)(tsp[PROBE_TS_B] - tsp[PROBE_TS_A]) * 0.01f;
      T_us = expf(floorf(logf(T_us) / logf(PROBE_TS_R) + PROBE_TS_PH) * logf(PROBE_TS_R));
      final_norm_rows(gw, ngw, out, FIN(4), 1.f + T_us * (1.f / 4000.f)); }
#else
    final_norm_rows(gw, ngw, out, FIN(4), 1.f);
#endif
}

#undef WSB
#undef STAMP
#undef GASP
#undef EVEN_MIX
#undef ODD_MIX
#undef XBAR_WORDS
#undef GSYNC
#undef ws
#undef out
#undef ssq
#undef cqsq
#undef ckvsq
#undef mrstd
#undef tabA
#undef tabR
#undef tabM
#undef wmem
#undef memb
#undef memkv
#undef vfirst
#undef xb
#undef mlakv
#undef mlaq
#undef proj
#undef FIN
#undef WI
#undef WO
#undef WQB
#undef WKVB
extern "C" void kernel_launch(void* const* d_in, const int* in_sizes, int n_in, void* d_out, int out_size, void* d_ws, size_t ws_size, hipStream_t stream) {
    static int grid = 0;
    if (grid == 0) {
        if (n_in != 51 || ws_size < WS_END) { fprintf(stderr, "kernel_launch: unexpected n_in %d / ws %zu\n", n_in, ws_size); grid = -1; return; }
        int dev = 0, cus = 0, per_cu = 0;
        hipGetDevice(&dev); hipDeviceGetAttribute(&cus, hipDeviceAttributeMultiprocessorCount, dev);
        hipFuncSetAttribute((const void*)mega, hipFuncAttributeMaxDynamicSharedMemorySize, LDS_BYTES);
        hipOccupancyMaxActiveBlocksPerMultiprocessor(&per_cu, (const void*)mega, NWAVES * 64, LDS_BYTES);
        if (per_cu < 1) { fprintf(stderr, "kernel_launch: occupancy query says %d blocks per CU\n", per_cu); per_cu = 1; }
        if (cus * per_cu < GRID) { fprintf(stderr, "kernel_launch: device holds %d x %d workgroups, kernel is built for %d\n", cus, per_cu, GRID); grid = -1; return; }
        grid = GRID;
    }
    if (grid < 0) return;
    if (hipMemsetAsync((char*)d_ws + WS_CTL, 0, 65536, stream) != hipSuccess) { fprintf(stderr, "kernel_launch: memset failed\n"); return; }
    Args a{};
    for (int i = 0; i < 51; ++i) a.in[i] = d_in[i];
    a.out = (float*)d_out; a.ws = (unsigned char*)d_ws;
    void* args[] = {&a};
    hipError_t e = hipLaunchCooperativeKernel((const void*)mega, dim3(grid), dim3(NWAVES * 64), args, LDS_BYTES, stream);
    if (e != hipSuccess) fprintf(stderr, "cooperative launch failed: %s (grid %d)\n", hipGetErrorString(e), grid);
}
```

```cpp
#include <hip/hip_runtime.h>
#ifndef PROBE_TS_A
#define PROBE_TS_A -1
#define PROBE_TS_B -1
#define PROBE_TS_PH 0.5f
#define PROBE_TS_R 1.5f
#endif
#ifndef PROBE_ODD
#define PROBE_ODD 0
#endif
#ifndef PROBE_DUP
#define PROBE_DUP 0
#endif
#include <hip/hip_cooperative_groups.h>
#include <stdint.h>
#include <cstdio>

typedef unsigned short bf16_t;
typedef unsigned u32x4 __attribute__((ext_vector_type(4)));
typedef float f32x4 __attribute__((ext_vector_type(4)));
#define DI __device__ __forceinline__

constexpr int BATCH = 16, SEQ = 2048, DM = 1024, MTOK = BATCH * SEQ, MEMT = 256, MROWS = BATCH * MEMT;
constexpr int PEN = 4096, PE = 4160, PO = 3840;
constexpr int E_QA = 0, E_KA = 512, E_VA = 1024, E_QR = 1536, E_KR = 1792, E_VR = 2048, E_QM = 2560, E_G = 2816;
constexpr int O_CQ = 0, O_CKV = 256, O_KR = 384, O_R = 512, O_K = 1024, O_V = 1536, O_WD = 2048, O_AD = 2112, O_MV = 2176, O_QM = 2304, O_G = 2560;
constexpr float NORM_EPS = 1e-6f, LOG2E = 1.4426950408889634f;
constexpr float QSCALE = 0.125f * LOG2E;
constexpr float QSCALE_MLA = 0.10206207261596575f * LOG2E;

constexpr size_t MiB = 1u << 20;
constexpr size_t WS_LORA = 5 * MiB;
constexpr size_t WS_CTL = 0, WS_SSQ = 1 * MiB, WS_CQSQ = 3 * MiB, WS_CKVSQ = 3 * MiB + 512 * 1024, WS_MRSTD = 4 * MiB;
constexpr size_t WS_TABA = 8 * MiB, WS_TABR = 10 * MiB, WS_TABM = 18 * MiB;
constexpr size_t WS_WI0 = 24 * MiB, WS_WI1 = 32 * MiB, WS_WI2 = WS_WI1 + 7680 * 1024, WS_WI3 = WS_WI2 + 8 * MiB;
constexpr size_t WS_WO = 55 * MiB;
constexpr size_t WS_WMEM = 65 * MiB;
constexpr size_t WS_WQB = 69 * MiB;
constexpr size_t WS_WKVB = WS_WQB + 1024 * 1024;
constexpr size_t WS_MEMB = 72 * MiB, WS_MEMKV = 80 * MiB, WS_VFIRST = 96 * MiB, WS_XB = 128 * MiB, WS_MLAQ = 192 * MiB, WS_PROJ = 256 * MiB;
constexpr size_t WS_END = 512 * MiB;

DI int olane() { int l; asm volatile("v_and_b32 %0, 63, %1" : "=v"(l) : "v"(threadIdx.x)); return l; }
DI float bf2f(bf16_t v) { return __uint_as_float((unsigned)v << 16); }
DI bf16_t f2bf(float f) { unsigned u = __float_as_uint(f); return (bf16_t)((u + 0x7fffu + ((u >> 16) & 1u)) >> 16); }
DI unsigned pk2(float lo, float hi) { return (unsigned)f2bf(lo) | ((unsigned)f2bf(hi) << 16); }
DI float wave_sum(float v) {
#pragma unroll
    for (int o = 1; o < 64; o <<= 1) v += __shfl_xor(v, o);
    return v;
}
DI float siluf(float x) { return x / (1.f + __expf(-x)); }
DI float sigmoidf_(float x) { return 1.f / (1.f + __expf(-x)); }

DI int phys2log(int mapid, int p, int aux) {
    if (mapid == 1) {
        if (p < 1024) { const int pos = p & 63, base = p & ~63; return pos < 16 ? base + (pos & 1) * 8 + (pos >> 1) : p; }
        if (p >= 1536 && p < 2048) { const int pos = p & 63, base = p & ~63; return base + (pos & 1) * 32 + (pos >> 1); }
        return p;
    }
    if (mapid == 2) {
        if (p < 384) return p;
        if (p < 416) { const int pos = p - 384; return 384 + (pos & 1) * 16 + (pos >> 1); }
        if (p < 512) return -1;
        if (p < 2048) return 416 + (p - 512);
        if (p < 2176) return 416 + 1536 + (p - 2048);
        if (p < 2208) return aux > 1664 ? 416 + 1664 + (p - 2176) : -1;
        if (p < 2304) return -1;
        if (p < 2560) return 416 + aux + (p - 2304);
        return 416 + aux + 256 + (p - 2560);
    }
    if (mapid == 3) {
        const int hh = p >> 7, pos = p & 127;
        if (pos < 64) return hh * 96 + pos;
        if (pos >= 96) return -1;
        const int pp = pos - 64; return hh * 96 + 64 + (pp & 1) * 16 + (pp >> 1);
    }
    return p;
}


DI void wconv_job(float* scr, int gw, int ngw, int& base, const float* __restrict__ W, int K, int Nsrc, bf16_t* __restrict__ dst, int Nphys, int row_off, int mapid, int aux, const float* __restrict__ gain) {
    const int lane = olane();
    const int nblk = Nphys / 32, kblk = (K + 63) / 64, nitems = nblk * kblk;
    int first = (gw - base % ngw + ngw) % ngw; base += nitems;
    for (int item = first; item < nitems; item += ngw) {
        const int kb = item / nblk, nb = item % nblk, k0 = 64 * kb, n0 = 32 * nb;
        const int nl = phys2log(mapid, n0 + (lane & 31), aux);
        const float* src = W + (nl < 0 ? 0 : nl); const int kh = lane >> 5, c = lane & 7;
        float v[32];
#pragma unroll
        for (int i = 0; i < 32; ++i) { const int kq = k0 + 2 * i + kh, kc = kq < K ? kq : K - 1; v[i] = __builtin_nontemporal_load(src + (size_t)kc * Nsrc); }
        float g8[8] = {1.f, 1.f, 1.f, 1.f, 1.f, 1.f, 1.f, 1.f};
        if (gain) { const int kg = k0 + 8 * c < K ? k0 + 8 * c : K - 8; const float4 ga = *(const float4*)(gain + kg), gb = *(const float4*)(gain + kg + 4);
            g8[0] = ga.x; g8[1] = ga.y; g8[2] = ga.z; g8[3] = ga.w; g8[4] = gb.x; g8[5] = gb.y; g8[6] = gb.z; g8[7] = gb.w; }
        __builtin_amdgcn_sched_barrier(0);
#pragma unroll
        for (int i = 0; i < 32; ++i) { const int kk = 2 * i + kh; scr[kk * 33 + (lane & 31)] = (nl >= 0 && k0 + kk < K) ? v[i] : 0.f; }
        asm volatile("s_waitcnt lgkmcnt(0)" ::: "memory");
        if (k0 + 8 * c < K) {
#pragma unroll
            for (int j = 0; j < 4; ++j) {
                const int n = (lane >> 3) + 8 * j; const float* s = scr + (8 * c) * 33 + n;
                u32x4 o; o.x = pk2(s[0] * g8[0], s[33] * g8[1]); o.y = pk2(s[66] * g8[2], s[99] * g8[3]); o.z = pk2(s[132] * g8[4], s[165] * g8[5]); o.w = pk2(s[198] * g8[6], s[231] * g8[7]);
                *(u32x4*)(dst + (size_t)(row_off + n0 + n) * K + k0 + 8 * c) = o;
            }
        }
        asm volatile("s_waitcnt lgkmcnt(0)" ::: "memory");
    }
}
DI void rows_prep(int gw, int ngw, const float* __restrict__ x, bf16_t* __restrict__ xb, float* __restrict__ stat, int R, int mode) {
    const int lane = olane();
    f32x4 v[4][4], vn[4][4];
    int r0 = 4 * gw;
    if (r0 < R) {
#pragma unroll
        for (int q = 0; q < 4; ++q) { const f32x4* xr = (const f32x4*)(x + (size_t)(r0 + q) * DM) + lane;
#pragma unroll
            for (int j = 0; j < 4; ++j) v[q][j] = __builtin_nontemporal_load(xr + 64 * j); }
    }
    for (; r0 < R; r0 += 4 * ngw) {
        const int rn = r0 + 4 * ngw < R ? r0 + 4 * ngw : r0;
#pragma unroll
        for (int q = 0; q < 4; ++q) { const f32x4* xr = (const f32x4*)(x + (size_t)(rn + q) * DM) + lane;
#pragma unroll
            for (int j = 0; j < 4; ++j) vn[q][j] = __builtin_nontemporal_load(xr + 64 * j); }
        asm volatile("" ::: "memory");
#pragma unroll
        for (int q = 0; q < 4; ++q) {
            float s = 0.f;
            unsigned long long* o8 = (unsigned long long*)(xb + (size_t)(r0 + q) * DM) + lane;
#pragma unroll
            for (int j = 0; j < 4; ++j) { const f32x4 w = v[q][j]; s += w.x * w.x + w.y * w.y + w.z * w.z + w.w * w.w;
                o8[64 * j] = (unsigned long long)pk2(w.x, w.y) | ((unsigned long long)pk2(w.z, w.w) << 32); }
            s = wave_sum(s);
            if (mode == 0) { if (lane < 16) stat[(size_t)(r0 + q) * 16 + lane] = lane == 0 ? s : 0.f; }
            else if (lane == 0) stat[r0 + q] = rsqrtf(s * (1.f / DM) + NORM_EPS);
        }
#pragma unroll
        for (int q = 0; q < 4; ++q)
#pragma unroll
            for (int j = 0; j < 4; ++j) v[q][j] = vn[q][j];
    }
}
DI void tables_rows(int gw, int ngw, const int* __restrict__ positions, float2* __restrict__ tabA, float2* __restrict__ tabR, float2* __restrict__ tabM) {
    const int i = olane();
    float theta = 500000.f, dim = 16.f; int j = i, kind = 0;
    if (i >= 8 && i < 40) { theta = 10000.f; dim = 64.f; j = i - 8; kind = 1; }
    else if (i >= 40) { dim = 32.f; j = i - 40; kind = 2; }
    const float inv = expf((-logf(theta) * (float)(2 * j)) / dim);
    const int nrow = gw < MTOK ? (MTOK - gw + ngw - 1) / ngw : 0;
    int posv = 0; if (i < nrow) posv = positions[gw + i * ngw];
    for (int it = 0; it < nrow; ++it) {
        const int row = gw + it * ngw;
        const int pos = it < 64 ? __builtin_amdgcn_readlane(posv, it) : positions[row];
        const float ang = (float)pos * inv;
        float sn, cs; sincosf(ang, &sn, &cs);
        const float2 v = make_float2(cs, sn);
        if (kind == 0) tabA[(size_t)row * 8 + j] = v; else if (kind == 1) tabR[(size_t)row * 32 + j] = v; else if (i < 56) tabM[(size_t)row * 16 + j] = v;
    }
}

DI unsigned cvtpk(float lo, float hi) { typedef float f2 __attribute__((ext_vector_type(2))); typedef __bf16 b2 __attribute__((ext_vector_type(2))); f2 v = {lo, hi}; return __builtin_bit_cast(unsigned, __builtin_convertvector(v, b2)); }
DI void store8(bf16_t* p, const float* v) { u32x4 o; o.x = cvtpk(v[0], v[1]); o.y = cvtpk(v[2], v[3]); o.z = cvtpk(v[4], v[5]); o.w = cvtpk(v[6], v[7]); *(u32x4*)p = o; }
DI void rot4(float* v, const float2* cs, bool on) {
#pragma unroll
    for (int j = 0; j < 4; ++j) { const float2 c = cs[j]; const float a = v[2 * j], b = v[2 * j + 1]; const float ra = a * c.x - b * c.y, rb = a * c.y + b * c.x; v[2 * j] = on ? ra : a; v[2 * j + 1] = on ? rb : b; }
}
struct Tab8 { f32x4 a, b; };
struct NoTab {};
DI Tab8 tab8_load(const float2* p) { const f32x4* q = (const f32x4*)p; return Tab8{q[0], q[1]}; }
DI void rot4t(float* v, const Tab8& t, bool on) {
    const float cs[8] = {t.a.x, t.a.y, t.a.z, t.a.w, t.b.x, t.b.y, t.b.z, t.b.w};
#pragma unroll
    for (int j = 0; j < 4; ++j) { const float a = v[2 * j], b = v[2 * j + 1]; const float ra = a * cs[2 * j] - b * cs[2 * j + 1], rb = a * cs[2 * j + 1] + b * cs[2 * j]; v[2 * j] = on ? ra : a; v[2 * j + 1] = on ? rb : b; }
}
DI float fsilu(float x) { return x * __builtin_amdgcn_rcpf(1.f + __builtin_amdgcn_exp2f(-LOG2E * x)); }
struct Pre16 { f32x4 a, b, c, d; };
DI Pre16 ssq16_load(const float* ssq, int row) { const f32x4* p = (const f32x4*)(ssq + (size_t)row * 16); return Pre16{p[0], p[1], p[2], p[3]}; }
DI float ssq16_rstd(const Pre16& q, float invn) {
    const float s = (q.a.x + q.a.y + q.a.z + q.a.w) + (q.b.x + q.b.y + q.b.z + q.b.w) + (q.c.x + q.c.y + q.c.z + q.c.w) + (q.d.x + q.d.y + q.d.z + q.d.w);
    return rsqrtf(s * invn + NORM_EPS);
}
DI void xpair32(float x, float& a, float& b) { const auto r = __builtin_amdgcn_permlane32_swap(__float_as_uint(x), __float_as_uint(x), false, false); a = __uint_as_float(r[0]); b = __uint_as_float(r[1]); }
DI void xpair16(float x, float& a, float& b) { const auto r = __builtin_amdgcn_permlane16_swap(__float_as_uint(x), __float_as_uint(x), false, false); a = __uint_as_float(r[0]); b = __uint_as_float(r[1]); }
DI float xadd32(float x) { float a, b; xpair32(x, a, b); return a + b; }
DI float xadd16(float x) { float a, b; xpair16(x, a, b); return a + b; }
struct Pre4 { f32x4 a; };
DI Pre4 ssq16q_load(const float* ssq, int row, int col0) { return Pre4{*(const f32x4*)(ssq + (size_t)row * 16 + 4 * ((col0 >> 3) & 3))}; }
DI float ssq16q_rstd(const Pre4& q, float invn) { float s = (q.a.x + q.a.y) + (q.a.z + q.a.w); s = xadd32(xadd16(s)); return rsqrtf(s * invn + NORM_EPS); }
DI float ssq4_rstd(const Pre4& q, float invn) { return rsqrtf((q.a.x + q.a.y + q.a.z + q.a.w) * invn + NORM_EPS); }

struct EpiEvenIn {
    static constexpr bool HAS_SSQ = false; static constexpr int NKIND = 7; DI void put_ssq(int, int, int, float) const {}
    bf16_t* out; const float* ssq; const float2* tabA; const float2* tabR;
    DI int kind(int pn) const { return pn < 2 ? 0 : pn < 4 ? 1 : pn < 6 ? 2 : pn == 6 ? 3 : pn == 7 ? 4 : pn < 10 ? 2 : pn == 10 ? 5 : 6; }
    typedef Pre4 Pre;
    DI Pre prefetch(int row, int col0) const { return ssq16q_load(ssq, row, col0); }
    DI float rowscale(const Pre& q) const { return ssq16q_rstd(q, 1.f / DM); }
    typedef Tab8 Tab;
    template <int KIND> DI Tab tab(int row, int col0) const {
        const int pos = col0 & 63;
        if (KIND == 0 || KIND == 1) return tab8_load(tabA + (size_t)row * 8 + ((pos & 8) >> 1));
        if (KIND == 3 || KIND == 4) return tab8_load(tabR + (size_t)row * 32 + (pos >> 1));
        return Tab8{};
    }
    template <int KIND> DI float apply(int row, int c, float* v, float rs, const Pre&, int, const Tab& tb) const {
        if (KIND == 0 || KIND == 1) {
            const int pos = c & 63;
            rot4t(v, tb, pos < 16);
            if (KIND == 0) rs *= QSCALE;
        } else if (KIND == 3 || KIND == 4) {
            const int h = (c & 255) >> 6;
            rot4t(v, tb, true);
            const float lg = h == 0 ? -0.04580368961f : h == 1 ? -0.02272007650f : h == 2 ? -0.011315313228f : -0.005646563141f;
            const float s = (float)(row & (SEQ - 1));
            rs *= KIND == 3 ? __builtin_amdgcn_exp2f(s * lg) : 0.125f * __builtin_amdgcn_exp2f(-s * lg);
        } else if (KIND == 5) rs *= QSCALE;
#pragma unroll
        for (int i = 0; i < 8; ++i) v[i] *= rs;
        if (KIND == 6) {
#pragma unroll
            for (int i = 0; i < 8; ++i) v[i] = fsilu(v[i]);
        }
        store8(out + (size_t)row * PE + c, v);
        return 0.f;
    }
};
struct EpiOddIn {
    static constexpr bool HAS_SSQ = true; static constexpr int NKIND = 5;
    bf16_t* out; const float* ssq; const float2* tabM; float* cqsq; float* ckvsq;
    DI void put_ssq(int row, int pn, int wc, float ss) const { if (pn == 0) cqsq[(size_t)row * 4 + wc] = ss; else if (pn == 1) ckvsq[(size_t)row * 4 + wc] = ss; }
    DI int kind(int pn) const { return pn == 0 ? 0 : pn == 1 ? 1 : pn < 9 ? 2 : pn == 9 ? 3 : 4; }
    typedef Pre4 Pre;
    DI Pre prefetch(int row, int col0) const { return ssq16q_load(ssq, row, col0); }
    DI float rowscale(const Pre& q) const { return ssq16q_rstd(q, 1.f / DM); }
    typedef Tab8 Tab;
    template <int KIND> DI Tab tab(int row, int col0) const { if (KIND == 1) return tab8_load(tabM + (size_t)row * 16 + (((col0 - O_KR) & 31) >> 1)); return Tab8{}; }
    template <int KIND> DI float apply(int row, int c, float* v, float rs, const Pre&, int, const Tab& tb) const {
        float ss = 0.f;
        if (KIND == 3) rs *= QSCALE;
#pragma unroll
        for (int i = 0; i < 8; ++i) v[i] *= rs;
        if (KIND == 0 || (KIND == 1 && c < O_KR)) {
#pragma unroll
            for (int i = 0; i < 8; ++i) ss += v[i] * v[i];
        }
        if (KIND == 1) rot4t(v, tb, c >= O_KR && c < O_KR + 32);
        if (KIND == 4) {
#pragma unroll
            for (int i = 0; i < 8; ++i) v[i] = fsilu(v[i]);
        }
        store8(out + (size_t)row * PO + c, v);
        return ss;
    }
};
template <int MODE> struct EpiWOut {
    static constexpr bool HAS_SSQ = true; static constexpr int NKIND = 1;
    const float* resid; float* xo; bf16_t* xb; float* ssq;
    DI void put_ssq(int row, int pn, int wc, float ss) const { ssq[(size_t)row * 16 + pn * 4 + wc] = ss; }
    DI int kind(int) const { return 0; }
    struct Pre { f32x4 r[MODE == 0 ? 4 : 2]; };
    DI Pre prefetch(int row, int col0) const {
        if (MODE == 0) { const f32x4* p = (const f32x4*)(resid + (size_t)row * DM + col0); Pre q; q.r[0] = p[0]; q.r[1] = p[1]; q.r[2] = p[32]; q.r[3] = p[33]; return q; }
        const f32x4* p = (const f32x4*)(xb + (size_t)row * DM + col0); Pre q; q.r[0] = p[0]; q.r[1] = p[16]; return q;
    }
    DI float rowscale(const Pre&) const { return 1.f; }
    typedef NoTab Tab; template <int KIND> DI Tab tab(int, int) const { return NoTab{}; }
    template <int KIND> DI float apply(int row, int c, float* v, float, const Pre& q, int bj, const Tab&) const {
        if (MODE == 0) { const f32x4 r0 = q.r[2 * bj], r1 = q.r[2 * bj + 1];
            v[0] += r0.x; v[1] += r0.y; v[2] += r0.z; v[3] += r0.w; v[4] += r1.x; v[5] += r1.y; v[6] += r1.z; v[7] += r1.w; }
        else { const u32x4 w = __builtin_bit_cast(u32x4, q.r[bj]);
            v[0] += __uint_as_float(w.x << 16); v[1] += __uint_as_float(w.x & 0xffff0000u); v[2] += __uint_as_float(w.y << 16); v[3] += __uint_as_float(w.y & 0xffff0000u);
            v[4] += __uint_as_float(w.z << 16); v[5] += __uint_as_float(w.z & 0xffff0000u); v[6] += __uint_as_float(w.w << 16); v[7] += __uint_as_float(w.w & 0xffff0000u); }
        if (MODE == 2) { f32x4* o = (f32x4*)(xo + (size_t)row * DM + c); o[0] = (f32x4){v[0], v[1], v[2], v[3]}; o[1] = (f32x4){v[4], v[5], v[6], v[7]}; }
        else store8(xb + (size_t)row * DM + c, v);
        float ss = 0.f;
#pragma unroll
        for (int i = 0; i < 8; ++i) ss += v[i] * v[i];
        return ss;
    }
};
struct EpiMemKV {
    static constexpr bool HAS_SSQ = false; static constexpr int NKIND = 1; DI void put_ssq(int, int, int, float) const {}
    bf16_t* out; const float* rstd;
    DI int kind(int) const { return 0; }
    struct Pre { float r; };
    DI Pre prefetch(int row, int) const { return Pre{rstd[row]}; }
    DI float rowscale(const Pre& q) const { return q.r; }
    typedef NoTab Tab; template <int KIND> DI Tab tab(int, int) const { return NoTab{}; }
    template <int KIND> DI float apply(int row, int c, float* v, float rs, const Pre&, int, const Tab&) const {
#pragma unroll
        for (int i = 0; i < 8; ++i) v[i] *= rs;
        store8(out + (size_t)row * 2048 + c, v); return 0.f;
    }
};
struct EpiMlaQ {
    static constexpr bool HAS_SSQ = false; static constexpr int NKIND = 1; DI void put_ssq(int, int, int, float) const {}
    bf16_t* out; const float* cqsq; const float2* tabM;
    DI int kind(int) const { return 0; }
    typedef Pre4 Pre;
    DI Pre prefetch(int row, int) const { return Pre4{*(const f32x4*)(cqsq + (size_t)row * 4)}; }
    DI float rowscale(const Pre& q) const { return ssq4_rstd(q, 1.f / 256.f) * QSCALE_MLA; }
    typedef Tab8 Tab;
    template <int KIND> DI Tab tab(int row, int col0) const { return tab8_load(tabM + (size_t)row * 16 + ((col0 & 31) >> 1)); }
    template <int KIND> DI float apply(int row, int c, float* v, float rs, const Pre&, int, const Tab& tb) const {
        const int pos = c & 127;
        rot4t(v, tb, pos >= 64 && pos < 96);
#pragma unroll
        for (int i = 0; i < 8; ++i) v[i] *= rs;
        store8(out + (size_t)row * 1024 + c, v); return 0.f;
    }
};
struct EpiMlaKV {
    static constexpr bool HAS_SSQ = false; static constexpr int NKIND = 1; DI void put_ssq(int, int, int, float) const {}
    bf16_t* out; const float* ckvsq;
    DI int kind(int) const { return 0; }
    typedef Pre4 Pre;
    DI Pre prefetch(int row, int) const { return Pre4{*(const f32x4*)(ckvsq + (size_t)row * 4)}; }
    DI float rowscale(const Pre& q) const { return ssq4_rstd(q, 1.f / 128.f); }
    typedef NoTab Tab; template <int KIND> DI Tab tab(int, int) const { return NoTab{}; }
    template <int KIND> DI float apply(int row, int c, float* v, float rs, const Pre&, int, const Tab&) const {
#pragma unroll
        for (int i = 0; i < 8; ++i) v[i] *= rs;
        store8(out + (size_t)row * 1024 + c, v); return 0.f;
    }
};

namespace pg8 {
#define PG8_LAS __attribute__((address_space(3)))
typedef PG8_LAS unsigned char PG8_LAS_T;
typedef unsigned short bf16_t;
typedef short bf16x8 __attribute__((ext_vector_type(8)));
typedef float f32x4 __attribute__((ext_vector_type(4)));
typedef unsigned u32x4 __attribute__((ext_vector_type(4)));
constexpr int BM = 256, BK = 64, HALF = 128, HTB = HALF * BK * 2  , STAGE_BYTES = 8 * HTB, NXCD = 8, WGM = 4;

__host__ __device__ __forceinline__ int lds_byte(int r, int c) { const int st = (r >> 4) * 2 + (c >> 5), rr = r & 15, cc = c & 31, ob = rr * 64 + cc * 2; return st * 1024 + (ob ^ (((ob >> 9) & 1) << 5)); }
__host__ __device__ __forceinline__ void stage_rc(int b, int& R, int& C) { const int st = b / 1024, sb = b % 1024, swz = sb ^ (((sb >> 9) & 1) << 5); R = (st >> 1) * 16 + swz / 64; C = (st & 1) * 32 + (swz % 64) / 2; }
__host__ __device__ __forceinline__ int perm32(int rho) { const int n = rho >> 4, i = rho & 15; return 8 * (i >> 2) + 4 * n + (i & 3); }

struct Unit { int pm, pn; };
template <int M_, int N_, int K_, int LDA_> struct Gemm { const bf16_t* A; const bf16_t* Bt; static constexpr int M = M_, N = N_, K = K_, lda = LDA_; };

struct StaticOrder {
    int nM, nN, nwg, G, c;
    __host__ __device__ void init(int M, int N, int G_, int c_) { nM = M / BM; nN = N / BM; nwg = nM * nN; G = G_; c = c_; }
    __host__ __device__ bool next(int i, Unit& u) const {
        const long L = (long)i * G + c; if (L >= nwg) return false;
        int wgid = (int)L; { const int q = nwg / NXCD, r = nwg % NXCD, xcd = wgid % NXCD, off = wgid / NXCD; wgid = (xcd < r ? xcd * (q + 1) : r * (q + 1) + (xcd - r) * q) + off; }
        const int nig = WGM * nN, gid = wgid / nig, fm = gid * WGM, gsz = (nM - fm) < WGM ? (nM - fm) : WGM;
        u.pm = fm + ((wgid % nig) % gsz); u.pn = (wgid % nig) / gsz; return true;
    }
    __device__ __forceinline__ void a_ready(const Unit&) const {}
    __device__ __forceinline__ void done(const Unit&) const {}
};

template <class Epi, class Sched, bool ALIGN_EPI = false, bool SP2 = false, class GemmT>
__device__ __forceinline__ void gemm_phase(PG8_LAS unsigned char* lds, const GemmT g, const Sched& S, const Epi& E) {
    int tid_ = threadIdx.x; asm volatile("" : "+v"(tid_));
    const int tid = tid_, wid = __builtin_amdgcn_readfirstlane(tid >> 6), lane = tid & 63, wr = wid >> 2, wc = wid & 3, fr = lane & 15, fq = lane >> 4;
    const int K = g.K; int nt = K / BK; asm volatile("" : "+s"(nt));
    unsigned voffA[2], voffB[2];
#pragma unroll
    for (int i = 0; i < 2; ++i) { int R, C; stage_rc(tid * 16 + i * 8192, R, C); const int Rb = Epi::PERM ? ((R & ~31) + perm32(R & 31)) : R;
        voffA[i] = (unsigned)(R * g.lda + C) * 2u; voffB[i] = (unsigned)(Rb * K + C) * 2u; }
    const size_t kstep = (size_t)(BK * 2);
    const size_t hstepA = (size_t)HALF * g.lda * 2, hstepB = (size_t)HALF * K * 2;
    const size_t tstepA = 2 * hstepA, tstepB = 2 * hstepB;
    const unsigned ldsw = (unsigned)wid * 1024u;
    const int aoff = lds_byte(wr * 64 + fr, fq * 8), boff = lds_byte(wc * 32 + fr, fq * 8);
#define PG8_SA(b, h) (((b) * 2 + (h)) * HTB)
#define PG8_SB(b, h) ((4 + (b) * 2 + (h)) * HTB)
#define PG8_STAGE(bufoff, gbase, voff) do { _Pragma("unroll") for (int _i = 0; _i < 2; ++_i) \
        __builtin_amdgcn_global_load_lds((const unsigned*)((const char*)(gbase) + (voff)[_i]), (PG8_LAS unsigned*)(lds + (bufoff) + ldsw + _i * 8192), 16, 0, 0); } while (0)
#define PG8_LDA(dst, b, h) do { _Pragma("unroll") for (int m = 0; m < 4; ++m) _Pragma("unroll") for (int k = 0; k < 2; ++k) dst[m][k] = *(const PG8_LAS bf16x8*)(lds + PG8_SA(b, h) + aoff + m * 2048 + k * 1024); } while (0)
#define PG8_LDB(dst, b, h) do { _Pragma("unroll") for (int n = 0; n < 2; ++n) _Pragma("unroll") for (int k = 0; k < 2; ++k) dst[n][k] = *(const PG8_LAS bf16x8*)(lds + PG8_SB(b, h) + boff + n * 2048 + k * 1024); } while (0)
#define PG8_MMA(ai, bj, At, Bt) do { __builtin_amdgcn_s_setprio(1); _Pragma("unroll") for (int m = 0; m < 4; ++m) _Pragma("unroll") for (int n = 0; n < 2; ++n) _Pragma("unroll") for (int k = 0; k < 2; ++k) \
        acc[ai][bj][m][n] = __builtin_amdgcn_mfma_f32_16x16x32_bf16(Bt[n][k], At[m][k], acc[ai][bj][m][n], 0, 0, 0); __builtin_amdgcn_s_setprio(0); } while (0)
#define PG8_WAIT_V(n) asm volatile("s_waitcnt vmcnt(" #n ")" ::: "memory")
#define PG8_WAIT_L(n) asm volatile("s_waitcnt lgkmcnt(" #n ")" ::: "memory")
#define PG8_BAR __builtin_amdgcn_s_barrier()
#define PG8_SCHED __builtin_amdgcn_sched_barrier(0)
    Unit cur, nxt; int ui = 0;
    if (!S.next(0, cur)) return;
    f32x4 acc[2][2][4][2];
#pragma unroll
    for (int a = 0; a < 2; ++a)
#pragma unroll
        for (int b = 0; b < 2; ++b)
#pragma unroll
            for (int m = 0; m < 4; ++m)
#pragma unroll
                for (int n = 0; n < 2; ++n) acc[a][b][m][n] = (f32x4){0.f, 0.f, 0.f, 0.f};
    bf16x8 At[4][2], B0[2][2], B1[2][2];
    const char* cA = (const char*)g.A + (size_t)cur.pm * tstepA; const char* cB = (const char*)g.Bt + (size_t)cur.pn * tstepB;
    S.a_ready(cur);
    if constexpr (SP2) {
        PG8_STAGE(PG8_SB(0, 0), cB, voffB); PG8_STAGE(PG8_SB(0, 1), cB + hstepB, voffB); PG8_STAGE(PG8_SA(0, 0), cA, voffA); PG8_STAGE(PG8_SA(0, 1), cA + hstepA, voffA);
        if (wr == 1) PG8_BAR;
        PG8_WAIT_V(2); PG8_BAR;
        PG8_STAGE(PG8_SB(1, 0), cB + kstep, voffB); PG8_STAGE(PG8_SA(1, 0), cA + kstep, voffA); PG8_STAGE(PG8_SB(1, 1), cB + hstepB + kstep, voffB);
        PG8_WAIT_V(6); PG8_BAR;
    } else {
        PG8_STAGE(PG8_SB(0, 0), cB, voffB); PG8_STAGE(PG8_SA(0, 0), cA, voffA); PG8_STAGE(PG8_SB(0, 1), cB + hstepB, voffB); PG8_STAGE(PG8_SA(0, 1), cA + hstepA, voffA);
        if (wr == 1) PG8_BAR;
        PG8_WAIT_V(4); PG8_BAR;
        PG8_STAGE(PG8_SB(1, 0), cB + kstep, voffB); PG8_STAGE(PG8_SA(1, 0), cA + kstep, voffA); PG8_STAGE(PG8_SB(1, 1), cB + hstepB + kstep, voffB);
        PG8_WAIT_V(6); PG8_BAR;
    }
    for (;;) {
        const bool has_next = S.next(ui + 1, nxt);
        const char* nA = has_next ? (const char*)g.A + (size_t)nxt.pm * tstepA : cA; const char* nB = has_next ? (const char*)g.Bt + (size_t)nxt.pn * tstepB : cB;
        for (int t = 0; t < nt; t += 2) {
            const bool last = (t == nt - 2);
            const char* a1 = cA + (size_t)(t + 1) * kstep;
            const char* a2 = last ? nA : cA + (size_t)(t + 2) * kstep; const char* b2 = last ? nB : cB + (size_t)(t + 2) * kstep;
            const char* a3 = a2 + kstep; const char* b3 = b2 + kstep;
            if (last && has_next) S.a_ready(nxt);
            if constexpr (SP2) {
            PG8_LDB(B0, 0, 0); PG8_LDB(B1, 0, 1); PG8_SCHED; PG8_LDA(At, 0, 0); PG8_STAGE(PG8_SA(1, 1), a1 + hstepA, voffA);
            PG8_WAIT_V(8); PG8_WAIT_L(0); PG8_BAR; PG8_MMA(0, 0, At, B0); PG8_MMA(0, 1, At, B1); PG8_BAR; PG8_SCHED;
            PG8_LDA(At, 0, 1); PG8_STAGE(PG8_SB(0, 0), b2, voffB); PG8_STAGE(PG8_SB(0, 1), b2 + hstepB, voffB); PG8_STAGE(PG8_SA(0, 0), a2, voffA);
            PG8_WAIT_V(8); PG8_WAIT_L(0); PG8_BAR; PG8_MMA(1, 0, At, B0); PG8_MMA(1, 1, At, B1); PG8_BAR; PG8_SCHED;
            PG8_LDB(B0, 1, 0); PG8_LDB(B1, 1, 1); PG8_SCHED; PG8_LDA(At, 1, 0); PG8_STAGE(PG8_SA(0, 1), a2 + hstepA, voffA);
            PG8_WAIT_V(8); PG8_WAIT_L(0); PG8_BAR; PG8_MMA(0, 0, At, B0); PG8_MMA(0, 1, At, B1); PG8_BAR; PG8_SCHED;
            PG8_LDA(At, 1, 1); PG8_STAGE(PG8_SB(1, 0), b3, voffB); PG8_STAGE(PG8_SB(1, 1), b3 + hstepB, voffB); PG8_STAGE(PG8_SA(1, 0), a3, voffA);
            PG8_WAIT_V(8); PG8_WAIT_L(0); PG8_BAR; PG8_MMA(1, 0, At, B0); PG8_MMA(1, 1, At, B1); PG8_BAR; PG8_SCHED;
            } else {
            PG8_LDB(B0, 0, 0); PG8_SCHED; PG8_LDA(At, 0, 0); PG8_STAGE(PG8_SA(1, 1), a1 + hstepA, voffA);
            PG8_WAIT_L(8); PG8_BAR; PG8_WAIT_L(0); PG8_MMA(0, 0, At, B0); PG8_BAR; PG8_SCHED;
            PG8_LDB(B1, 0, 1); PG8_STAGE(PG8_SB(0, 0), b2, voffB);
            PG8_BAR; PG8_WAIT_L(0); PG8_MMA(0, 1, At, B1); PG8_BAR;
            PG8_LDA(At, 0, 1); PG8_STAGE(PG8_SA(0, 0), a2, voffA);
            PG8_BAR; PG8_WAIT_L(0); PG8_MMA(1, 0, At, B0); PG8_BAR; PG8_SCHED;
            PG8_STAGE(PG8_SB(0, 1), b2 + hstepB, voffB);
            PG8_WAIT_V(6); PG8_BAR; PG8_MMA(1, 1, At, B1); PG8_BAR;
            PG8_LDB(B0, 1, 0); PG8_SCHED; PG8_LDA(At, 1, 0); PG8_STAGE(PG8_SA(0, 1), a2 + hstepA, voffA);
            PG8_WAIT_L(8); PG8_BAR; PG8_WAIT_L(0); PG8_MMA(0, 0, At, B0); PG8_BAR; PG8_SCHED;
            PG8_LDB(B1, 1, 1); PG8_STAGE(PG8_SB(1, 0), b3, voffB);
            PG8_BAR; PG8_WAIT_L(0); PG8_MMA(0, 1, At, B1); PG8_BAR;
            PG8_LDA(At, 1, 1); PG8_STAGE(PG8_SA(1, 0), a3, voffA);
            PG8_BAR; PG8_WAIT_L(0); PG8_MMA(1, 0, At, B0); PG8_BAR; PG8_SCHED;
            PG8_STAGE(PG8_SB(1, 1), b3 + hstepB, voffB);
            PG8_WAIT_V(6); PG8_BAR; PG8_MMA(1, 1, At, B1); PG8_BAR;
            }
        }
        if constexpr (ALIGN_EPI) { if (wr == 0) PG8_BAR; }
        if constexpr (!Epi::AFTER_DRAIN) { E(acc, cur, wr, wc, fr, fq); S.done(cur); }
        if (!has_next) break;
#pragma unroll
        for (int a = 0; a < 2; ++a)
#pragma unroll
            for (int b = 0; b < 2; ++b)
#pragma unroll
                for (int m = 0; m < 4; ++m)
#pragma unroll
                    for (int n = 0; n < 2; ++n) acc[a][b][m][n] = (f32x4){0.f, 0.f, 0.f, 0.f};
        cur = nxt; cA = nA; cB = nB; ++ui;
        if constexpr (ALIGN_EPI) { if (wr == 1) PG8_BAR; }
    }
    PG8_WAIT_V(0);
    if constexpr (!ALIGN_EPI) { if (wr == 0) PG8_BAR; }
    PG8_BAR;
    if constexpr (Epi::AFTER_DRAIN) { E.fused(acc, cur, wr, wc, fr, fq, lds, wid, lane); S.done(cur); }
#undef PG8_SA
#undef PG8_SB
#undef PG8_STAGE
#undef PG8_LDA
#undef PG8_LDB
#undef PG8_MMA
#undef PG8_WAIT_V
#undef PG8_WAIT_L
#undef PG8_BAR
#undef PG8_SCHED
}
}

DI void attnA_naive_item(bf16_t* __restrict__ proj, int item) {
    const int lane = olane();
    const int row = item >> 3, h = item & 7, b = row >> 11, s = row & (SEQ - 1);
    const float q = bf2f(proj[(size_t)row * PE + E_QA + h * 64 + lane]);
    float lse[3], o[3];
#pragma unroll
    for (int p = 0; p < 3; ++p) {
        const int dil = p == 0 ? 1 : (p == 1 ? 4 : 16);
        const int ls = s / dil, r = s % dil, j0 = ls - 128 < 0 ? 0 : ls - 128;
        float m = -INFINITY, l = 0.f, acc = 0.f;
        for (int j = j0; j <= ls; ++j) {
            const size_t kr = (size_t)(b * SEQ + j * dil + r) * PE;
            const float sc = wave_sum(q * bf2f(proj[kr + E_KA + h * 64 + lane]));
            const float vv = bf2f(proj[kr + E_VA + h * 64 + lane]);
            const float mn = fmaxf(m, sc), al = exp2f(m - mn), pp = exp2f(sc - mn);
            l = l * al + pp; acc = acc * al + pp * vv; m = mn;
        }
        lse[p] = m + log2f(l); o[p] = acc / l;
    }
    const float mx = fmaxf(lse[0], fmaxf(lse[1], lse[2]));
    const float w0 = exp2f(lse[0] - mx), w1 = exp2f(lse[1] - mx), w2 = exp2f(lse[2] - mx);
    const float out = (w0 * o[0] + w1 * o[1] + w2 * o[2]) / (w0 + w1 + w2);
    bf16_t* g = proj + (size_t)row * PE + E_G + h * 64 + lane;
    *g = f2bf(out * bf2f(*g));
}
DI void ret_naive_item(bf16_t* __restrict__ proj, int item) {
    const int lane = olane();
    const int row = item >> 2, h = item & 3, b = row >> 11, s = row & (SEQ - 1);
    const float q = bf2f(proj[(size_t)row * PE + E_QR + h * 64 + lane]);
    float o0 = 0.f, o1 = 0.f;
    for (int j = 0; j <= s; ++j) {
        const size_t kr = (size_t)(b * SEQ + j) * PE;
        const float sc = wave_sum(q * bf2f(proj[kr + E_KR + h * 64 + lane]));
        o0 += sc * bf2f(proj[kr + E_VR + h * 128 + lane]); o1 += sc * bf2f(proj[kr + E_VR + h * 128 + 64 + lane]);
    }
    const float rn = rsqrtf(wave_sum(o0 * o0 + o1 * o1) * (1.f / 128.f) + NORM_EPS);
    bf16_t* g = proj + (size_t)row * PE + E_G + 512 + h * 128 + lane;
    g[0] = f2bf(o0 * rn * bf2f(g[0])); g[64] = f2bf(o1 * rn * bf2f(g[64]));
}
DI void mem_naive_item(bf16_t* __restrict__ proj, int pitch, int qcol, int gcol, const bf16_t* __restrict__ memkv, int layer, int item) {
    const int lane = olane();
    const int row = item >> 2, h = item & 3, b = row >> 11;
    const float q = bf2f(proj[(size_t)row * pitch + qcol + h * 64 + lane]);
    float m = -INFINITY, l = 0.f, acc = 0.f;
    for (int j = 0; j < MEMT; ++j) {
        const bf16_t* kv = memkv + (size_t)(b * MEMT + j) * 2048 + layer * 512 + h * 64 + lane;
        const float sc = wave_sum(q * bf2f(kv[0])), vv = bf2f(kv[256]);
        const float mn = fmaxf(m, sc), al = exp2f(m - mn), pp = exp2f(sc - mn);
        l = l * al + pp; acc = acc * al + pp * vv; m = mn;
    }
    bf16_t* g = proj + (size_t)row * pitch + gcol + h * 64 + lane;
    *g = f2bf(acc / l * bf2f(*g));
}
DI void mla_naive_item(bf16_t* __restrict__ proj, const bf16_t* __restrict__ mq, const bf16_t* __restrict__ mkv, int item) {
    const int lane = olane();
    const int row = item >> 3, h = item & 7, b = row >> 11, s = row & (SEQ - 1);
    const float qn = bf2f(mq[(size_t)row * 1024 + h * 128 + lane]);
    const float qr = lane < 32 ? bf2f(mq[(size_t)row * 1024 + h * 128 + 64 + lane]) : 0.f;
    float m = -INFINITY, l = 0.f, acc = 0.f;
    for (int j = 0; j <= s; ++j) {
        const size_t kr = (size_t)(b * SEQ + j);
        float pr = qn * bf2f(mkv[kr * 1024 + h * 128 + lane]);
        if (lane < 32) pr += qr * bf2f(proj[kr * PO + O_KR + lane]);
        const float sc = wave_sum(pr), vv = bf2f(mkv[kr * 1024 + h * 128 + 64 + lane]);
        const float mn = fmaxf(m, sc), al = exp2f(m - mn), pp = exp2f(sc - mn);
        l = l * al + pp; acc = acc * al + pp * vv; m = mn;
    }
    bf16_t* g = proj + (size_t)row * PO + O_G + h * 64 + lane;
    *g = f2bf(acc / l * bf2f(*g));
}
DI void final_norm_rows(int gw, int ngw, float* __restrict__ x, const float* __restrict__ g, float pert) {
    const int lane = olane();
    const f32x4* gr = (const f32x4*)g + lane;
    f32x4 gg[4], v[4], vn[4];
#pragma unroll
    for (int j = 0; j < 4; ++j) gg[j] = gr[64 * j];
    int r = gw;
    if (r < MTOK) {
#pragma unroll
        for (int j = 0; j < 4; ++j) v[j] = ((const f32x4*)(x + (size_t)r * DM) + lane)[64 * j];
    }
    for (; r < MTOK; r += ngw) {
        const int rn_ = r + ngw < MTOK ? r + ngw : r;
#pragma unroll
        for (int j = 0; j < 4; ++j) vn[j] = __builtin_nontemporal_load((const f32x4*)(x + (size_t)rn_ * DM) + lane + 64 * j);
        asm volatile("" ::: "memory");
        float s = 0.f;
#pragma unroll
        for (int j = 0; j < 4; ++j) s += v[j].x * v[j].x + v[j].y * v[j].y + v[j].z * v[j].z + v[j].w * v[j].w;
        const float rn = rsqrtf(wave_sum(s) * (1.f / DM) + NORM_EPS) * pert;
        f32x4* xr = (f32x4*)(x + (size_t)r * DM) + lane;
#pragma unroll
        for (int j = 0; j < 4; ++j) __builtin_nontemporal_store((f32x4){v[j].x * rn * gg[j].x, v[j].y * rn * gg[j].y, v[j].z * rn * gg[j].z, v[j].w * rn * gg[j].w}, xr + 64 * j);
#pragma unroll
        for (int j = 0; j < 4; ++j) v[j] = vn[j];
    }
}

typedef short bf16x8 __attribute__((ext_vector_type(8)));
typedef short s16x4 __attribute__((ext_vector_type(4)));
typedef float f32x16 __attribute__((ext_vector_type(16)));
typedef float f32x2 __attribute__((ext_vector_type(2)));
#define LAS __attribute__((address_space(3)))
DI int crow(int r, int hi) { return (r & 3) + 8 * (r >> 2) + 4 * hi; }
DI s16x4 vtr(const LAS unsigned char* p) { return __builtin_bit_cast(s16x4, __builtin_amdgcn_ds_read_tr16_b64_v4i16((LAS s16x4*)p)); }

struct Ticket {
    unsigned* ctr; unsigned val; bool pending;
    DI void issue() { if (!pending) { if (threadIdx.x == 0) val = atomicAdd(ctr, 1u); pending = true; } }
    DI int take(__attribute__((address_space(3))) unsigned* slot) { issue(); __syncthreads(); if (threadIdx.x == 0) *slot = val; __syncthreads(); pending = false; return (int)*slot; }
};
DI float max3(float a, float b, float c) { float r; asm("v_max3_f32 %0, %1, %2, %3" : "=v"(r) : "v"(a), "v"(b), "v"(c)); return r; }
struct KVSrc {
    const bf16_t* k; const bf16_t* k2; const bf16_t* v; int ldk, ldk2, ldv, kstride, koff, jmax;
};
struct MaskBand { static constexpr bool FAR = false; DI float operator()(int qi, int kj) const { return ((unsigned)(qi - kj) <= 128u && kj >= 0) ? 0.f : -INFINITY; } };
struct MaskBandDil4 { static constexpr bool FAR = true;
    DI float operator()(int qi, int kj) const {
        const int d = qi - kj;
        const int m = ((unsigned)d <= 128u ? 1 : 0) + ((d >= 0 && (d & 3) == 0) ? 1 : 0);
        return m == 0 ? -INFINITY : (m == 1 ? 0.f : 1.f); } };
struct MaskCausal { static constexpr bool FAR = false; DI float operator()(int qi, int kj) const { return kj <= qi ? 0.f : -INFINITY; } };
struct MaskNone { static constexpr bool FAR = false; DI float operator()(int, int) const { return 0.f; } };

template <int NDQ, int NDB, bool SOFTMAX> struct AttnWave {
    bf16x8 qf[NDQ]; f32x16 o[NDB]; float m, l;
    DI void init() {
#pragma unroll
        for (int d = 0; d < NDB; ++d)
#pragma unroll
            for (int r = 0; r < 16; ++r) o[d][r] = 0.f;
        m = -INFINITY; l = 0.f;
    }
    template <int NDQ1, class Mask> DI void segment(LAS unsigned char* vbuf, const KVSrc& S, int k0, int t0, int t1, int tf0, int tf1, int qi, const Mask& mask, int lane) {
        if (t0 >= t1) return;
        const int r32 = lane & 31, hi = lane >> 5;
        constexpr int VCH = NDB * 4;
        constexpr int VLD = NDB * 2;
        const int vrow = lane / VCH, vch = lane % VCH;
        const int vdst = (vch >> 2) * 2048 + vrow * 64 + (vch & 3) * 16;
        const LAS unsigned char* vb = vbuf + (4 * hi + ((lane & 15) >> 2)) * 64 + ((lane >> 4) & 1) * 32 + (lane & 3) * 8;
        static_assert(NDQ == 4 && NDQ1 == 4, "per-wave K image: 128-byte key rows");
        constexpr int KP = NDQ * 32 + 16;
        LAS unsigned char* kimg = vbuf + NDB * 2048;
        const int krow = lane >> 3, kch = lane & 7;
        u32x4 kf0[NDQ], kf1[NDQ], kf2[NDQ]; u32x4 vr0[VLD], vr1[VLD], vr2[VLD];
        auto loadk = [&](u32x4 (&dst)[NDQ], int t) {
#pragma unroll
            for (int i = 0; i < NDQ; ++i) { int j = k0 + 32 * t + krow + 8 * i; j = j < 0 ? 0 : (j > S.jmax ? S.jmax : j);
                dst[i] = *(const u32x4*)(S.k + (size_t)(j * S.kstride + S.koff) * S.ldk + kch * 8); }
        };
        auto loadv = [&](u32x4 (&dst)[VLD], int t) {
#pragma unroll
            for (int i = 0; i < VLD; ++i) { int j = k0 + 32 * t + vrow + (64 / VCH) * i; j = j < 0 ? 0 : (j > S.jmax ? S.jmax : j);
                dst[i] = *(const u32x4*)(S.v + (size_t)(j * S.kstride + S.koff) * S.ldv + vch * 8); }
        };
        auto step = [&](u32x4 (&kf)[NDQ], u32x4 (&vr)[VLD], int t) {
#pragma unroll
            for (int i = 0; i < NDQ; ++i) *(LAS u32x4*)(kimg + (krow + 8 * i) * KP + kch * 16) = kf[i];
#pragma unroll
            for (int i = 0; i < VLD; ++i) *(LAS u32x4*)(vbuf + vdst + i * (64 / VCH) * 64) = vr[i];
            asm volatile("" ::: "memory");
            f32x16 s;
#pragma unroll
            for (int r = 0; r < 16; ++r) s[r] = 0.f;
#pragma unroll
            for (int d = 0; d < NDQ; ++d) s = __builtin_amdgcn_mfma_f32_32x32x16_bf16(*(const LAS bf16x8*)(kimg + r32 * KP + (2 * d + hi) * 16), qf[d], s, 0, 0, 0);
            asm volatile("" ::: "memory");
            if (t + 3 < t1) { loadk(kf, t + 3); loadv(vr, t + 3); }
            if (t < tf0 || t >= tf1) {
                const int kb = k0 + 32 * t + 4 * hi;
#pragma unroll
                for (int r = 0; r < 16; ++r) { const float bias = mask(qi, kb + (r & 3) + 8 * (r >> 2)); s[r] = SOFTMAX ? s[r] + bias : (bias < 0.f ? 0.f : s[r]); }
            }
            if (SOFTMAX) {
                float mx = max3(s[0], s[1], s[2]);
#pragma unroll
                for (int r = 3; r < 15; r += 2) mx = max3(mx, s[r], s[r + 1]);
                mx = max3(mx, s[15], s[15]);
                float mxa, mxb; xpair32(mx, mxa, mxb);
                const float mn = max3(m, mxa, mxb);
                if (__any(mn > m + 8.f)) {
                    const float al = __builtin_amdgcn_exp2f(m - (mn == -INFINITY ? 0.f : mn));
                    l *= al; m = mn;
#pragma unroll
                    for (int d = 0; d < NDB; ++d)
#pragma unroll
                        for (int r = 0; r < 16; ++r) o[d][r] *= al;
                }
                const float mu = m == -INFINITY ? 0.f : m;
                f32x2 ps2 = {0.f, 0.f};
#pragma unroll
                for (int r = 0; r < 16; r += 2) { s[r] = __builtin_amdgcn_exp2f(s[r] - mu); s[r + 1] = __builtin_amdgcn_exp2f(s[r + 1] - mu); ps2 += (f32x2){s[r], s[r + 1]}; }
                l += ps2[0] + ps2[1];
            }
            bf16x8 pb[2];
#pragma unroll
            for (int st = 0; st < 2; ++st) { u32x4 w; w.x = cvtpk(s[8 * st], s[8 * st + 1]); w.y = cvtpk(s[8 * st + 2], s[8 * st + 3]); w.z = cvtpk(s[8 * st + 4], s[8 * st + 5]); w.w = cvtpk(s[8 * st + 6], s[8 * st + 7]);
                pb[st] = __builtin_bit_cast(bf16x8, w); }
#pragma unroll
            for (int d = 0; d < NDB; ++d)
#pragma unroll
                for (int st = 0; st < 2; ++st) {
                    const s16x4 lo = vtr(vb + d * 2048 + st * 1024), hh = vtr(vb + d * 2048 + st * 1024 + 512);
                    const bf16x8 vf = {lo[0], lo[1], lo[2], lo[3], hh[0], hh[1], hh[2], hh[3]};
                    o[d] = __builtin_amdgcn_mfma_f32_32x32x16_bf16(vf, pb[st], o[d], 0, 0, 0);
                }
            asm volatile("" ::: "memory");
        };
        loadk(kf0, t0); loadv(vr0, t0);
        if (t0 + 1 < t1) { loadk(kf1, t0 + 1); loadv(vr1, t0 + 1); }
        if (t0 + 2 < t1) { loadk(kf2, t0 + 2); loadv(vr2, t0 + 2); }
        for (int t = t0; t < t1; t += 3) {
            step(kf0, vr0, t);
            if (t + 1 < t1) step(kf1, vr1, t + 1);
            if (t + 2 < t1) step(kf2, vr2, t + 2);
        }
    }
    unsigned long long gpre[NDB][4];
    DI void gate_prefetch(const bf16_t* yrow, int lane) {
        const int hi = lane >> 5;
#pragma unroll
        for (int d = 0; d < NDB; ++d)
#pragma unroll
            for (int gp = 0; gp < 2; ++gp) {
                const u32x4 w = *(const u32x4*)(yrow + 32 * d + 16 * gp + 8 * hi);
                const auto r0 = __builtin_amdgcn_permlane32_swap(w.x, w.z, false, false), r1 = __builtin_amdgcn_permlane32_swap(w.y, w.w, false, false);
                gpre[d][2 * gp] = (unsigned long long)r0[0] | ((unsigned long long)r1[0] << 32);
                gpre[d][2 * gp + 1] = (unsigned long long)r0[1] | ((unsigned long long)r1[1] << 32);
            }
    }
    DI void finish_store(bf16_t* yrow  , int lane, bool dry = false, bool = true) {
        const int hi = lane >> 5;
        float sc;
        if (SOFTMAX) { const float lt = xadd32(l); sc = 1.f / lt; }
        else { float ss = 0.f;
#pragma unroll
            for (int d = 0; d < NDB; ++d)
#pragma unroll
                for (int r = 0; r < 16; ++r) ss += o[d][r] * o[d][r];
            ss = xadd32(ss); sc = rsqrtf(ss * (1.f / (32 * NDB)) + NORM_EPS); }
#pragma unroll
        for (int d = 0; d < NDB; ++d)
#pragma unroll
            for (int gp = 0; gp < 2; ++gp) {
                unsigned pk[2][2];
#pragma unroll
                for (int q = 0; q < 2; ++q) {
                    const int g = 2 * gp + q;
                    const unsigned long long gv = gpre[d][g]; const unsigned g0 = (unsigned)gv, g1 = (unsigned)(gv >> 32);
                    const float a0 = o[d][4 * g] * sc * __uint_as_float(g0 << 16), a1 = o[d][4 * g + 1] * sc * __uint_as_float(g0 & 0xffff0000u);
                    const float a2 = o[d][4 * g + 2] * sc * __uint_as_float(g1 << 16), a3 = o[d][4 * g + 3] * sc * __uint_as_float(g1 & 0xffff0000u);
                    pk[q][0] = cvtpk(a0, a1); pk[q][1] = cvtpk(a2, a3);
                }
                const auto r0 = __builtin_amdgcn_permlane32_swap(pk[0][0], pk[1][0], false, false), r1 = __builtin_amdgcn_permlane32_swap(pk[0][1], pk[1][1], false, false);
                if (!dry) *(u32x4*)(yrow + 32 * d + 16 * gp + 8 * hi) = (u32x4){r0[0], r1[0], r0[1], r1[1]};
            }
    }
};

struct SharedSrc { const bf16_t* k; const bf16_t* k2; const bf16_t* v; int ldk, ldk2, ldv; };
template <int NDB> struct FirstTile { u32x4 k, v[NDB / 2]; };
template <int NDB> DI FirstTile<NDB> first_tile_load(const SharedSrc& S) {
    int tid_ = threadIdx.x; asm volatile("" : "+v"(tid_));
    const int tid = tid_; constexpr int VCH = NDB * 4, VPT = NDB / 2;
    FirstTile<NDB> f;
    f.k = *(const u32x4*)(S.k + (size_t)(tid >> 3) * S.ldk + (tid & 7) * 8);
#pragma unroll
    for (int i = 0; i < VPT; ++i) f.v[i] = *(const u32x4*)(S.v + (size_t)(tid / VCH + (512 / VCH) * i) * S.ldv + (tid % VCH) * 8);
    return f;
}
template <int NDQ, int NDQ1, int NDB, bool SOFTMAX, bool CAUSAL, bool ALLMASK = false, class Mask = MaskCausal>
DI void attn_shared(LAS unsigned char* lds, AttnWave<NDQ, NDB, SOFTMAX>& W, const SharedSrc& S, int ntiles, int qb  , int qi  , const Mask& mask = Mask{}, const FirstTile<NDB>* pre = nullptr) {
    constexpr int RBP = NDQ * 32 + 16, KB = 64 * RBP, VB = NDB * 4096, BUF = KB + VB;
    int tid_ = threadIdx.x; asm volatile("" : "+v"(tid_));
    const int tid = tid_, lane = tid & 63, r32 = lane & 31, hi = lane >> 5;
    const int krow = tid >> 3, kch = tid & 7;
    const int k2row = tid >> 2, k2ch = tid & 3;
    constexpr int VCH = NDB * 4, VPT = NDB / 2;
    const int vrow = tid / VCH, vch = tid % VCH;
    u32x4 rk, rk2, rv[VPT];
    auto gload = [&](int t) {
        const size_t j0 = (size_t)64 * t;
        rk = *(const u32x4*)(S.k + (j0 + krow) * S.ldk + kch * 8);
        if (NDQ > NDQ1) { if (tid < 256) rk2 = *(const u32x4*)(S.k2 + (j0 + k2row) * S.ldk2 + k2ch * 8); }
#pragma unroll
        for (int i = 0; i < VPT; ++i) rv[i] = *(const u32x4*)(S.v + (j0 + vrow + (512 / VCH) * i) * S.ldv + vch * 8);
    };
    auto lstore = [&](int buf) {
        LAS unsigned char* kb = lds + buf * BUF; LAS unsigned char* vbs = kb + KB;
        *(LAS u32x4*)(kb + krow * RBP + kch * 16) = rk;
        if (NDQ > NDQ1) { if (tid < 256) *(LAS u32x4*)(kb + k2row * RBP + NDQ1 * 32 + k2ch * 16) = rk2; }
#pragma unroll
        for (int i = 0; i < VPT; ++i) *(LAS u32x4*)(vbs + (vch >> 2) * 4096 + (vrow + (512 / VCH) * i) * 64 + (vch & 3) * 16) = rv[i];
    };
    const int tmax = CAUSAL ? (qb >> 1) : ntiles - 1;
    if (pre != nullptr && NDQ == NDQ1) { rk = pre->k;
#pragma unroll
        for (int i = 0; i < VPT; ++i) rv[i] = pre->v[i]; }
    else gload(0);
    lstore(0);
    __syncthreads();
    for (int t = 0; t < ntiles; ++t) {
        if (t + 1 < ntiles) gload(t + 1);
#if PROBE_DUP == 30
        f32x16 osave[NDB]; float msave = W.m, lsave = W.l;
#pragma unroll
        for (int d = 0; d < NDB; ++d) osave[d] = W.o[d];
#pragma unroll 1
        for (int rep_ = 0; rep_ < (NDB == 2 ? 2 : 1); ++rep_) {
        if (rep_ == 1) { W.m = msave; W.l = lsave;
#pragma unroll
            for (int d = 0; d < NDB; ++d) W.o[d] = osave[d];
            asm volatile("" ::: "memory"); }
#endif
        if (t <= tmax) {
            const LAS unsigned char* kb = lds + (t & 1) * BUF; const LAS unsigned char* vb = kb + KB + (4 * hi + ((lane & 15) >> 2)) * 64 + ((lane >> 4) & 1) * 32 + (lane & 3) * 8;
            f32x16 s0, s1;
#pragma unroll
            for (int r = 0; r < 16; ++r) { s0[r] = 0.f; s1[r] = 0.f; }
            if (NDB == 2) {
                bf16x8 ka[NDQ], kc[NDQ];
#pragma unroll
                for (int d = 0; d < NDQ; ++d) { ka[d] = *(const LAS bf16x8*)(kb + r32 * RBP + (2 * d + hi) * 16); kc[d] = *(const LAS bf16x8*)(kb + (32 + r32) * RBP + (2 * d + hi) * 16); }
                __builtin_amdgcn_sched_barrier(0);
#pragma unroll
                for (int d = 0; d < NDQ; ++d) {
                    s0 = __builtin_amdgcn_mfma_f32_32x32x16_bf16(ka[d], W.qf[d], s0, 0, 0, 0);
                    s1 = __builtin_amdgcn_mfma_f32_32x32x16_bf16(kc[d], W.qf[d], s1, 0, 0, 0);
                }
            } else {
#pragma unroll
                for (int d = 0; d < NDQ; ++d) {
                    const bf16x8 ka = *(const LAS bf16x8*)(kb + r32 * RBP + (2 * d + hi) * 16), kc = *(const LAS bf16x8*)(kb + (32 + r32) * RBP + (2 * d + hi) * 16);
                    s0 = __builtin_amdgcn_mfma_f32_32x32x16_bf16(ka, W.qf[d], s0, 0, 0, 0);
                    s1 = __builtin_amdgcn_mfma_f32_32x32x16_bf16(kc, W.qf[d], s1, 0, 0, 0);
                    if (d & 1) asm volatile("" ::: "memory");
                }
            }
            s16x4 vlo[4][NDB], vhh[4][NDB];
            if (NDB == 2) {
#pragma unroll
                for (int ks = 0; ks < 4; ++ks)
#pragma unroll
                    for (int d = 0; d < NDB; ++d) { vlo[ks][d] = vtr(vb + d * 4096 + ks * 1024); vhh[ks][d] = vtr(vb + d * 4096 + ks * 1024 + 512); }
                __builtin_amdgcn_sched_barrier(0);
            }
            if (ALLMASK) {
                const int kbase = 64 * t + 4 * hi;
                if (Mask::FAR && 64 * t + 63 + 129 <= __builtin_amdgcn_readfirstlane(qi)) {
                    float bf_[4];
#pragma unroll
                    for (int j = 0; j < 4; ++j) bf_[j] = ((qi - j) & 3) == 0 ? 0.f : -INFINITY;
#pragma unroll
                    for (int r = 0; r < 16; ++r) { s0[r] += bf_[r & 3]; s1[r] += bf_[r & 3]; }
                } else {
#pragma unroll
                    for (int r = 0; r < 16; ++r) { const int kj = kbase + (r & 3) + 8 * (r >> 2); s0[r] += mask(qi, kj); s1[r] += mask(qi, kj + 32); }
                }
            } else if (CAUSAL && t == tmax) {
                const int kbase = 64 * t + 4 * hi;
#pragma unroll
                for (int r = 0; r < 16; ++r) { const int kj = kbase + (r & 3) + 8 * (r >> 2);
                    if (kj > qi) s0[r] = SOFTMAX ? -INFINITY : 0.f;
                    if (kj + 32 > qi) s1[r] = SOFTMAX ? -INFINITY : 0.f; }
            }
            if (SOFTMAX) {
                float mx = max3(s0[0], s1[0], s0[1]);
                mx = max3(mx, s1[1], s0[2]);
#pragma unroll
                for (int r = 2; r < 15; ++r) mx = max3(mx, s1[r], s0[r + 1]);
                mx = max3(mx, s1[15], s1[15]);
                float mxa, mxb; xpair32(mx, mxa, mxb);
                const float mn = max3(W.m, mxa, mxb);
                if (__any(mn > W.m + 8.f)) {
                    const float al = __builtin_amdgcn_exp2f(W.m - (mn == -INFINITY ? 0.f : mn));
                    W.l *= al; W.m = mn;
#pragma unroll
                    for (int d = 0; d < NDB; ++d)
#pragma unroll
                        for (int r = 0; r < 16; ++r) W.o[d][r] *= al;
                }
                const float mu = W.m == -INFINITY ? 0.f : W.m;
                f32x2 ps2 = {0.f, 0.f};
#pragma unroll
                for (int r = 0; r < 16; ++r) { s0[r] = __builtin_amdgcn_exp2f(s0[r] - mu); s1[r] = __builtin_amdgcn_exp2f(s1[r] - mu); ps2 += (f32x2){s0[r], s1[r]}; }
                W.l += ps2[0] + ps2[1];
            }
            bf16x8 pb[4];
#pragma unroll
            for (int st = 0; st < 2; ++st) {
                u32x4 w; w.x = cvtpk(s0[8 * st], s0[8 * st + 1]); w.y = cvtpk(s0[8 * st + 2], s0[8 * st + 3]); w.z = cvtpk(s0[8 * st + 4], s0[8 * st + 5]); w.w = cvtpk(s0[8 * st + 6], s0[8 * st + 7]);
                pb[st] = __builtin_bit_cast(bf16x8, w);
                u32x4 x; x.x = cvtpk(s1[8 * st], s1[8 * st + 1]); x.y = cvtpk(s1[8 * st + 2], s1[8 * st + 3]); x.z = cvtpk(s1[8 * st + 4], s1[8 * st + 5]); x.w = cvtpk(s1[8 * st + 6], s1[8 * st + 7]);
                pb[2 + st] = __builtin_bit_cast(bf16x8, x);
            }
#pragma unroll
            for (int ks = 0; ks < 4; ++ks)
#pragma unroll
                for (int d = 0; d < NDB; ++d) {
                    s16x4 lo, hh;
                    if (NDB == 2) { lo = vlo[ks][d]; hh = vhh[ks][d]; } else { lo = vtr(vb + d * 4096 + ks * 1024); hh = vtr(vb + d * 4096 + ks * 1024 + 512); }
                    const bf16x8 vf = {lo[0], lo[1], lo[2], lo[3], hh[0], hh[1], hh[2], hh[3]};
                    W.o[d] = __builtin_amdgcn_mfma_f32_32x32x16_bf16(vf, pb[ks], W.o[d], 0, 0, 0);
                    if (NDB == 4 && (d & 1)) asm volatile("" ::: "memory");
                }
        }
#if PROBE_DUP == 30
        }
#endif
        if (t + 1 < ntiles) lstore((t + 1) & 1);
        __syncthreads();
    }
}
DI void unitAS(LAS unsigned char* lds, bf16_t* __restrict__ proj, int b, int h, int r4, int lb8, bool dry, Ticket& tk) {
    const int lane = olane(), r32 = lane & 31, hi = lane >> 5, wave = __builtin_amdgcn_readfirstlane(threadIdx.x >> 6);
    const int lb = 8 * lb8 + wave, l0 = 32 * lb, lq = l0 + r32, tq = 4 * lq + r4;
    const size_t rowq = (size_t)b * SEQ + tq;
    AttnWave<4, 2, true> W; W.init();
#pragma unroll
    for (int d = 0; d < 4; ++d) W.qf[d] = *(const bf16x8*)(proj + rowq * PE + E_QA + h * 64 + 16 * d + 8 * hi);
    const bf16_t* kb = proj + (size_t)b * SEQ * PE + E_KA + h * 64; const bf16_t* vb = proj + (size_t)b * SEQ * PE + E_VA + h * 64;
    const SharedSrc S23{kb + (size_t)r4 * PE, kb, vb + (size_t)r4 * PE, 4 * PE, 4 * PE, 4 * PE};
    const FirstTile<2> ft = first_tile_load<2>(S23);
    {
        KVSrc S{kb, kb, vb, PE, PE, PE, 1, 0, SEQ - 1}; const int k0 = 4 * l0 + r4 - 128;
        const int ts = k0 + 31 < 0 ? (-k0) >> 5 : 0;
#if PROBE_DUP == 33
        W.template segment<4>(lds + 65536 + wave * 10240, S, k0, ts, 8, 0, 0, tq, MaskBand{}, lane);
        if (!dry) W.init();
#endif
        W.template segment<4>(lds + 65536 + wave * 10240, S, k0, ts, 8, 0, 0, tq, MaskBand{}, lane);
    }
    {
        W.gate_prefetch(proj + rowq * PE + E_G + h * 64, lane);
        attn_shared<4, 4, 2, true, true, true, MaskBandDil4>(lds, W, S23, 4 * lb8 + 4, lb, lq, MaskBandDil4{}, &ft);
    }
    tk.issue();
    W.finish_store(proj + rowq * PE + E_G + h * 64, lane, dry, true);
}
DI void unitRetState(LAS unsigned char* lds, const bf16_t* __restrict__ proj, bf16_t* __restrict__ pt, int b, int h) {
    int tid_ = threadIdx.x; asm volatile("" : "+v"(tid_));
    const int tid = tid_, lane = tid & 63, r32 = lane & 31, hi = lane >> 5, wave = __builtin_amdgcn_readfirstlane(tid >> 6);
    const int dvb = wave >> 1, dkb = wave & 1;
    constexpr int KIMG = 8192, VIMG = 16384, BUF = KIMG + VIMG;
    const bf16_t* kg = proj + (size_t)b * SEQ * PE + E_KR + h * 64; const bf16_t* vg = proj + (size_t)b * SEQ * PE + E_VR + h * 128;
    const int krow = tid >> 3, kch = tid & 7, vrow = tid >> 4, vch = tid & 15;
    u32x4 rk, rv[2];
    auto gload = [&](int t) { const size_t j0 = (size_t)64 * t; rk = *(const u32x4*)(kg + (j0 + krow) * PE + kch * 8);
        rv[0] = *(const u32x4*)(vg + (j0 + vrow) * PE + vch * 8); rv[1] = *(const u32x4*)(vg + (j0 + vrow + 32) * PE + vch * 8); };
    auto lstore = [&](int buf) { LAS unsigned char* kb = lds + buf * BUF; LAS unsigned char* vbs = kb + KIMG;
        *(LAS u32x4*)(kb + (kch >> 2) * 4096 + krow * 64 + (kch & 3) * 16) = rk;
        *(LAS u32x4*)(vbs + (vch >> 2) * 4096 + vrow * 64 + (vch & 3) * 16) = rv[0]; *(LAS u32x4*)(vbs + (vch >> 2) * 4096 + (vrow + 32) * 64 + (vch & 3) * 16) = rv[1]; };
    const int troff = (8 * hi + ((lane & 15) >> 2)) * 64 + ((lane >> 4) & 1) * 32 + (lane & 3) * 8;
    f32x16 acc;
#pragma unroll
    for (int r = 0; r < 16; ++r) acc[r] = 0.f;
    gload(0); lstore(0);
    __syncthreads();
    constexpr int NT = 28;
    for (int t = 0; t < NT; ++t) {
        if (t + 1 < NT) gload(t + 1);
        const LAS unsigned char* kb = lds + (t & 1) * BUF + dkb * 4096 + troff; const LAS unsigned char* vb = lds + (t & 1) * BUF + KIMG + dvb * 4096 + troff;
#pragma unroll
        for (int st = 0; st < 4; ++st) {
            const s16x4 vlo = vtr(vb + st * 1024), vhi = vtr(vb + st * 1024 + 256), klo = vtr(kb + st * 1024), khi = vtr(kb + st * 1024 + 256);
            const bf16x8 vf = {vlo[0], vlo[1], vlo[2], vlo[3], vhi[0], vhi[1], vhi[2], vhi[3]}, kf = {klo[0], klo[1], klo[2], klo[3], khi[0], khi[1], khi[2], khi[3]};
            acc = __builtin_amdgcn_mfma_f32_32x32x16_bf16(vf, kf, acc, 0, 0, 0);
        }
        if ((t & 3) == 3) {
            bf16_t* dst = pt + ((size_t)((b * 4 + h) * 7 + (t >> 2))) * 8192 + (size_t)(32 * dvb) * 64 + 32 * dkb + r32;
#pragma unroll
            for (int r = 0; r < 16; ++r) dst[(size_t)crow(r, hi) * 64] = f2bf(acc[r]);
        }
        if (t + 1 < NT) lstore((t + 1) & 1);
        __syncthreads();
    }
}
DI void unitRetC(LAS unsigned char* lds, bf16_t* __restrict__ proj, const bf16_t* __restrict__ pt, int b, int h, int qb8, bool dry, Ticket& tk) {
    const int lane = olane(), r32 = lane & 31, hi = lane >> 5, wave = __builtin_amdgcn_readfirstlane(threadIdx.x >> 6);
    const int sq = 256 * qb8 + 32 * wave + r32; const size_t rowq = (size_t)b * SEQ + sq;
    AttnWave<4, 4, false> W; W.init();
#pragma unroll
    for (int d = 0; d < 4; ++d) W.qf[d] = *(const bf16x8*)(proj + rowq * PE + E_QR + h * 64 + 16 * d + 8 * hi);
    const bf16_t* kb = proj + ((size_t)b * SEQ + 256 * qb8) * PE + E_KR + h * 64;
    const SharedSrc S{kb, kb, proj + ((size_t)b * SEQ + 256 * qb8) * PE + E_VR + h * 128, PE, PE, PE};
    const FirstTile<4> ft = first_tile_load<4>(S);
    if (qb8 > 0) {
        const bf16_t* pb = pt + ((size_t)((b * 4 + h) * 7 + (qb8 - 1))) * 8192 + (size_t)r32 * 64 + 8 * hi;
#pragma unroll
        for (int db = 0; db < 4; ++db)
#pragma unroll
            for (int d = 0; d < 4; ++d) W.o[db] = __builtin_amdgcn_mfma_f32_32x32x16_bf16(*(const bf16x8*)(pb + (size_t)db * 32 * 64 + 16 * d), W.qf[d], W.o[db], 0, 0, 0);
    }
    W.gate_prefetch(proj + rowq * PE + E_G + 512 + h * 128, lane);
    attn_shared<4, 4, 4, false, true>(lds, W, S, 4, wave, 32 * wave + r32, MaskCausal{}, &ft);
    tk.issue();
    W.finish_store(proj + rowq * PE + E_G + 512 + h * 128, lane, dry, true);
}
DI void unitMemS(LAS unsigned char* lds, bf16_t* __restrict__ proj, int pitch, int qcol, int gcol, const bf16_t* __restrict__ memkv, int layer, int b, int h, int sb8, bool dry, Ticket& tk) {
    const int lane = olane(), r32 = lane & 31, hi = lane >> 5, wave = __builtin_amdgcn_readfirstlane(threadIdx.x >> 6);
    const size_t rowq = (size_t)b * SEQ + 256 * sb8 + 32 * wave + r32;
    AttnWave<4, 2, true> W; W.init();
#pragma unroll
    for (int d = 0; d < 4; ++d) W.qf[d] = *(const bf16x8*)(proj + rowq * pitch + qcol + h * 64 + 16 * d + 8 * hi);
    const bf16_t* kb = memkv + (size_t)b * MEMT * 2048 + layer * 512 + h * 64;
    const SharedSrc S{kb, kb, kb + 256, 2048, 2048, 2048};
    W.gate_prefetch(proj + rowq * pitch + gcol + h * 64, lane);
    attn_shared<4, 4, 2, true, false>(lds, W, S, MEMT / 64, 0, 0);
    tk.issue();
    W.finish_store(proj + rowq * pitch + gcol + h * 64, lane, dry, true);
}
DI void unitMlaS(LAS unsigned char* lds, bf16_t* __restrict__ proj, const bf16_t* __restrict__ mq, const bf16_t* __restrict__ mkv, int b, int h, int qb8, bool dry, Ticket& tk) {
    const int lane = olane(), r32 = lane & 31, hi = lane >> 5, wave = __builtin_amdgcn_readfirstlane(threadIdx.x >> 6);
    const int qb = 8 * qb8 + wave, sq = 32 * qb + r32; const size_t rowq = (size_t)b * SEQ + sq;
    AttnWave<6, 2, true> W; W.init();
#pragma unroll
    for (int d = 0; d < 6; ++d) W.qf[d] = *(const bf16x8*)(mq + rowq * 1024 + h * 128 + 16 * d + 8 * hi);
    const bf16_t* kb = mkv + (size_t)b * SEQ * 1024 + h * 128;
    const SharedSrc S{kb, proj + (size_t)b * SEQ * PO + O_KR, kb + 64, 1024, PO, 1024};
    W.gate_prefetch(proj + rowq * PO + O_G + h * 64, lane);
    attn_shared<6, 4, 2, true, true>(lds, W, S, 4 * qb8 + 4, qb, sq);
    tk.issue();
    W.finish_store(proj + rowq * PO + O_G + h * 64, lane, dry, true);
}

typedef float f32x4_t __attribute__((ext_vector_type(4)));
constexpr int RW_T = 32, RW_NCH = SEQ / RW_T;
constexpr int RW_BUF = 49152;
constexpr int RW_Y = 2 * RW_BUF, RW_BF = RW_Y + 16384, RW_STG = RW_BF + 20480, RW_CST = RW_STG + 4 * 2560;
static_assert(RW_CST + 14 * 256 <= 163840 - 64, "RWKV LDS map");
DI float dpp_add(float x, const int sel) {
    int t;
    if (sel == 0) t = __builtin_amdgcn_update_dpp(0, __float_as_int(x), 0xB1, 0xf, 0xf, true);
    else if (sel == 1) t = __builtin_amdgcn_update_dpp(0, __float_as_int(x), 0x4E, 0xf, 0xf, true);
    else if (sel == 2) t = __builtin_amdgcn_update_dpp(0, __float_as_int(x), 0x141, 0xf, 0xf, true);
    else t = __builtin_amdgcn_update_dpp(0, __float_as_int(x), 0x140, 0xf, 0xf, true);
    return x + __int_as_float(t);
}
DI float red8(float x) { return dpp_add(dpp_add(dpp_add(x, 0), 1), 2); }
DI float wsum64(float x) {
    x = dpp_add(dpp_add(dpp_add(dpp_add(x, 0), 1), 2), 3);
    const int xi = __float_as_int(x);
    const float s0 = __int_as_float(__builtin_amdgcn_readlane(xi, 0)), s1 = __int_as_float(__builtin_amdgcn_readlane(xi, 16));
    const float s2 = __int_as_float(__builtin_amdgcn_readlane(xi, 32)), s3 = __int_as_float(__builtin_amdgcn_readlane(xi, 48));
    return (s0 + s1) + (s2 + s3);
}
DI float fsigmoid(float x) { return __builtin_amdgcn_rcpf(1.f + __builtin_amdgcn_exp2f(-LOG2E * x)); }
struct RwkvW { const float *mu, *w0, *w2, *a0, *a2, *v0, *v2, *k_k, *k_a, *r_k, *lnx_w, *lnx_b; };

constexpr int RC_ARR = 0, RC_Y = 49152, RC_BON = 65536, RC_IMG = 81920, RC_IMGSZ = 19712, RC_PA = 68  , RC_PT = 20  , RC_BF = RC_IMG + 2 * RC_IMGSZ, RC_STG = RC_BF + 20480, RC_CST = RC_STG + 4 * 2560;
static_assert(RC_CST + 14 * 256 <= 163840 - 64, "chunked RWKV LDS map");
DI bf16_t bf1(float x) { return (bf16_t)(cvtpk(x, 0.f) & 0xffffu); }
DI bf16x8 cvt8(const f32x16& x, const int base) { u32x4 w; w.x = cvtpk(x[base], x[base + 1]); w.y = cvtpk(x[base + 2], x[base + 3]); w.z = cvtpk(x[base + 4], x[base + 5]); w.w = cvtpk(x[base + 6], x[base + 7]); return __builtin_bit_cast(bf16x8, w); }
DI bf16x8 afrag_k(const LAS bf16_t* rowp, int koff, int hi) {
    typedef unsigned long long u64; typedef u64 u64x2 __attribute__((ext_vector_type(2)));
    const u64x2 w = {*(const LAS u64*)(rowp + koff + 4 * hi), *(const LAS u64*)(rowp + koff + 8 + 4 * hi)};
    return __builtin_bit_cast(bf16x8, w);
}
DI bf16x8 nfrag(const LAS bf16_t* p) {
    typedef unsigned long long u64; typedef u64 u64x2 __attribute__((ext_vector_type(2)));
    const u64x2 w = {*(const LAS u64*)p, *(const LAS u64*)(p + 4)};
    return __builtin_bit_cast(bf16x8, w);
}
template <int T0> DI void rc_opnd8(const LAS float* arr  , LAS unsigned char* img, int k) {
    LAS bf16_t* AI2 = (LAS bf16_t*)img; LAS bf16_t* BK2 = (LAS bf16_t*)(img + 4352); LAS bf16_t* BPT = (LAS bf16_t*)(img + 8704); LAS bf16_t* KPT = (LAS bf16_t*)(img + 11264);
    LAS bf16_t* VVT = (LAS bf16_t*)(img + 17408); LAS float* PC = (LAS float*)(img + 19456);
    float Pr[16], av_[8], bv_[8], rv_[8], kv_[8], vv_[8];
#pragma unroll
    for (int tt = 0; tt < 16; ++tt) Pr[tt] = arr[2048 + tt * 64];
#pragma unroll
    for (int u = 0; u < 8; ++u) { const int tt = T0 + u; av_[u] = arr[6144 + tt * 64]; bv_[u] = arr[8192 + tt * 64]; rv_[u] = arr[tt * 64]; kv_[u] = arr[4096 + tt * 64]; vv_[u] = arr[10240 + tt * 64]; }
    __builtin_amdgcn_sched_barrier(0);
#pragma unroll
    for (int tt = 1; tt < 16; ++tt) Pr[tt] *= Pr[tt - 1];
    const float PCv = Pr[15];
    unsigned bpw[4], kpw[4]; float bprev = 0.f, kprev = 0.f;
#pragma unroll
    for (int u = 0; u < 8; ++u) {
        const int tt = T0 + u;
        const float Pm = tt ? Pr[tt - 1] : 1.f, inv = __builtin_amdgcn_rcpf(Pr[tt]), eC = PCv * inv;
        const float a = av_[u], bb_ = bv_[u], r = rv_[u], kx = kv_[u], v = vv_[u];
        AI2[tt * RC_PA + k] = bf1(a * Pm); AI2[(16 + tt) * RC_PA + k] = bf1(r * Pr[tt]); BK2[tt * RC_PA + k] = bf1(bb_ * inv); BK2[(16 + tt) * RC_PA + k] = bf1(kx * inv);
        VVT[(k >> 5) * 512 + tt * 32 + (k & 31)] = bf1(v);
        const float bpv = bb_ * eC, kpv = kx * eC;
        if (u & 1) { bpw[u >> 1] = cvtpk(bprev, bpv); kpw[u >> 1] = cvtpk(kprev, kpv); } else { bprev = bpv; kprev = kpv; }
    }
    { typedef unsigned u32x2 __attribute__((ext_vector_type(2)));
#pragma unroll
      for (int q = 0; q < 2; ++q) { *(LAS u32x2*)(BPT + k * RC_PT + T0 + 4 * q) = (u32x2){bpw[2 * q], bpw[2 * q + 1]}; *(LAS u32x2*)(KPT + k * RC_PT + T0 + 4 * q) = (u32x2){kpw[2 * q], kpw[2 * q + 1]}; } }
    if (T0 == 0) PC[k] = PCv;
}
constexpr int RC_FLAG = RC_CST + 14 * 256;
static_assert(RC_FLAG + 64 <= 163840 - 64, "chunked RWKV LDS map (flags)");
template <bool VRES>
DI void rwkv_unit_c(LAS unsigned char* lds, bf16_t* __restrict__ proj, bf16_t* __restrict__ vfirst, const bf16_t* __restrict__ loraT  ,
                  const RwkvW& W, int unit, const bf16_t* __restrict__ zrow  , bool dry = false) {
    const int lane = olane(), wave = __builtin_amdgcn_readfirstlane(threadIdx.x >> 6);
    const int b = unit >> 3, h = unit & 7, hc = h * 64 + lane;
    const size_t row0 = (size_t)b * SEQ;
    LAS bf16x8* bfr = (LAS bf16x8*)(lds + RC_BF);
#if PROBE_DUP == 26
    if (!dry) { const unsigned long long t0_ = __builtin_amdgcn_s_memrealtime(); while (__builtin_amdgcn_s_memrealtime() - t0_ < 5000ull) __builtin_amdgcn_s_sleep(32); }
#endif
    {
        const int cl = lane & 15, kg = lane >> 4;
        for (int f = wave; f < 20; f += 8) {
            bf16x8 v;
            if (f < 16) { const int ct = (f & 7) >> 1, ks = f & 1; v = *(const bf16x8*)(loraT + (f >= 8 ? 32768 : 0) + (size_t)(h * 64 + 16 * ct + cl) * 64 + 32 * ks + 8 * kg); }
            else v = VRES ? *(const bf16x8*)(loraT + 65536 + (size_t)(h * 64 + 16 * (f - 16) + cl) * 32 + 8 * kg) : bf16x8{0, 0, 0, 0, 0, 0, 0, 0};
            bfr[f * 64 + lane] = v;
        }
        if (threadIdx.x < 2) ((volatile LAS unsigned*)(lds + RC_FLAG))[threadIdx.x] = 0u;
    }
    __syncthreads();
    if (wave < 2) {
        const int vh = wave, r32 = lane & 31, hi = lane >> 5, rt = r32 & 15;
        f32x16 S0, S1;
#pragma unroll
        for (int r = 0; r < 16; ++r) { S0[r] = 0.f; S1[r] = 0.f; }
        __syncthreads();
        __syncthreads();
        for (int c = 0; c < RW_NCH; ++c) {
            rc_opnd8<8>((const LAS float*)(lds + RC_ARR) + (16 * vh) * 64 + lane, lds + RC_IMG + vh * RC_IMGSZ, lane);
            asm volatile("s_waitcnt lgkmcnt(0)" ::: "memory");
            if (lane == 0) ((volatile LAS unsigned*)(lds + RC_FLAG))[vh] = (unsigned)(c + 1);
            __syncthreads();
            LAS float* pY = (LAS float*)(lds + RC_Y + (c & 1) * 8192);
#if PROBE_DUP == 24
            f32x16 K0 = S0, K1 = S1;
#pragma unroll 1
            for (int half2 = 0; half2 < 4; ++half2) {
                const int half = half2 & 1;
                if (half2 == 2) { if (dry) { K0 = S0; K1 = S1; } S0 = K0; S1 = K1; }
#else
#pragma unroll 1
            for (int half = 0; half < 2; ++half) {
#endif
                const LAS unsigned char* img = lds + RC_IMG + half * RC_IMGSZ;
                const LAS bf16_t* AI2 = (const LAS bf16_t*)img; const LAS bf16_t* BPT = (const LAS bf16_t*)(img + 8704); const LAS bf16_t* KPT = (const LAS bf16_t*)(img + 11264);
                const LAS bf16_t* BTT = (const LAS bf16_t*)(img + 13824); const LAS bf16_t* MBT = (const LAS bf16_t*)(img + 14464); const LAS bf16_t* MKT = (const LAS bf16_t*)(img + 15104);
                const LAS bf16_t* TTm = (const LAS bf16_t*)(img + 15744); const LAS float* PC = (const LAS float*)(img + 19456);
                const LAS unsigned char* vvt = img + 17408 + vh * 1024 + (4 * hi + ((lane & 15) >> 2)) * 64 + ((lane >> 4) & 1) * 32 + (lane & 3) * 8;
                const LAS bf16_t* arow = AI2 + rt * RC_PA; const LAS bf16_t* rrow = AI2 + (16 + rt) * RC_PA;
                const bf16x8 fa0 = afrag_k(arow, 0, hi), fa1 = afrag_k(arow, 16, hi), fa2 = afrag_k(arow, 32, hi), fa3 = afrag_k(arow, 48, hi);
                const bf16x8 fr0 = afrag_k(rrow, 0, hi), fr1 = afrag_k(rrow, 16, hi), fr2 = afrag_k(rrow, 32, hi), fr3 = afrag_k(rrow, 48, hi);
                const bf16x8 fbt = afrag_k(BTT + rt * RC_PT, 0, hi), ftt = afrag_k(TTm + rt * RC_PT, 0, hi), fmb = afrag_k(MBT + rt * RC_PT, 0, hi), fmk = afrag_k(MKT + rt * RC_PT, 0, hi);
                const bf16x8 fbp0 = afrag_k(BPT + r32 * RC_PT, 0, hi), fkp0 = afrag_k(KPT + r32 * RC_PT, 0, hi), fbp1 = afrag_k(BPT + (32 + r32) * RC_PT, 0, hi), fkp1 = afrag_k(KPT + (32 + r32) * RC_PT, 0, hi);
                f32x4_t pc0[4], pc1[4];
#pragma unroll
                for (int g = 0; g < 4; ++g) { pc0[g] = *(const LAS f32x4_t*)(PC + 8 * g + 4 * hi); pc1[g] = *(const LAS f32x4_t*)(PC + 32 + 8 * g + 4 * hi); }
                const s16x4 vlo = vtr(vvt), vhi = vtr(vvt + 512);
                const bf16x8 vf = {vlo[0], vlo[1], vlo[2], vlo[3], vhi[0], vhi[1], vhi[2], vhi[3]};
                __builtin_amdgcn_sched_barrier(0);
                const bf16x8 sf0 = cvt8(S0, 0), sf1 = cvt8(S0, 8), sf2 = cvt8(S1, 0), sf3 = cvt8(S1, 8);
                f32x16 X;
#pragma unroll
                for (int r = 0; r < 16; ++r) X[r] = 0.f;
                X = __builtin_amdgcn_mfma_f32_32x32x16_bf16(fa0, sf0, X, 0, 0, 0);
                X = __builtin_amdgcn_mfma_f32_32x32x16_bf16(fa1, sf1, X, 0, 0, 0);
                X = __builtin_amdgcn_mfma_f32_32x32x16_bf16(fa2, sf2, X, 0, 0, 0);
                X = __builtin_amdgcn_mfma_f32_32x32x16_bf16(fa3, sf3, X, 0, 0, 0);
                X = __builtin_amdgcn_mfma_f32_32x32x16_bf16(fbt, vf, X, 0, 0, 0);
                f32x16 Yt;
#pragma unroll
                for (int r = 0; r < 16; ++r) Yt[r] = 0.f;
                Yt = __builtin_amdgcn_mfma_f32_32x32x16_bf16(fr0, sf0, Yt, 0, 0, 0);
                Yt = __builtin_amdgcn_mfma_f32_32x32x16_bf16(fr1, sf1, Yt, 0, 0, 0);
                Yt = __builtin_amdgcn_mfma_f32_32x32x16_bf16(fr2, sf2, Yt, 0, 0, 0);
                Yt = __builtin_amdgcn_mfma_f32_32x32x16_bf16(fr3, sf3, Yt, 0, 0, 0);
                Yt = __builtin_amdgcn_mfma_f32_32x32x16_bf16(fmk, vf, Yt, 0, 0, 0);
                const bf16x8 xf = cvt8(X, 0);
                f32x16 U;
#pragma unroll
                for (int r = 0; r < 16; ++r) U[r] = 0.f;
                U = __builtin_amdgcn_mfma_f32_32x32x16_bf16(ftt, xf, U, 0, 0, 0);
#pragma unroll
                for (int g = 0; g < 4; ++g) {
#pragma unroll
                    for (int e = 0; e < 4; ++e) { S0[4 * g + e] *= pc0[g][e]; S1[4 * g + e] *= pc1[g][e]; }
                }
                S0 = __builtin_amdgcn_mfma_f32_32x32x16_bf16(fkp0, vf, S0, 0, 0, 0);
                S1 = __builtin_amdgcn_mfma_f32_32x32x16_bf16(fkp1, vf, S1, 0, 0, 0);
                const bf16x8 uf = cvt8(U, 0);
                Yt = __builtin_amdgcn_mfma_f32_32x32x16_bf16(fmb, uf, Yt, 0, 0, 0);
                S0 = __builtin_amdgcn_mfma_f32_32x32x16_bf16(fbp0, uf, S0, 0, 0, 0);
                S1 = __builtin_amdgcn_mfma_f32_32x32x16_bf16(fbp1, uf, S1, 0, 0, 0);
#pragma unroll
                for (int r = 0; r < 8; ++r) pY[(16 * half + crow(r, hi)) * 64 + 32 * vh + r32] = Yt[r];
            }
            __syncthreads();
        }
        __syncthreads();
    } else if (wave < 4) {
        const int half = wave - 2, k = lane, r32 = lane & 31, hi = lane >> 5;
        LAS unsigned char* img = lds + RC_IMG + half * RC_IMGSZ;
        LAS bf16_t* AI2 = (LAS bf16_t*)img; LAS bf16_t* BK2 = (LAS bf16_t*)(img + 4352); LAS bf16_t* BPT = (LAS bf16_t*)(img + 8704); LAS bf16_t* KPT = (LAS bf16_t*)(img + 11264);
        LAS bf16_t* BTT = (LAS bf16_t*)(img + 13824); LAS bf16_t* MBT = (LAS bf16_t*)(img + 14464); LAS bf16_t* MKT = (LAS bf16_t*)(img + 15104); LAS bf16_t* TTm = (LAS bf16_t*)(img + 15744);
        LAS float* ATT = (LAS float*)(img + 16384); LAS bf16_t* VVT = (LAS bf16_t*)(img + 17408); LAS float* PC = (LAS float*)(img + 19456);
        const LAS float* arr = (const LAS float*)(lds + RC_ARR) + (16 * half) * 64 + k;
        __syncthreads();
        __syncthreads();
        for (int c = 0; c < RW_NCH; ++c) {
#if PROBE_DUP == 20
#pragma unroll 1
          for (int rep_ = 0; rep_ < (dry ? 1 : 2); ++rep_) {
#endif
            rc_opnd8<0>(arr, img, k);
            asm volatile("s_waitcnt lgkmcnt(0)" ::: "memory");
            { volatile LAS unsigned* fl = (volatile LAS unsigned*)(lds + RC_FLAG) + half; unsigned sp_ = 0u;
              while (*fl != (unsigned)(c + 1) && ++sp_ < (1u << 20)) __builtin_amdgcn_s_sleep(1); }
            asm volatile("" ::: "memory");
            f32x16 G;
#pragma unroll
            for (int r = 0; r < 16; ++r) G[r] = 0.f;
#pragma unroll
            for (int d = 0; d < 4; ++d)
                G = __builtin_amdgcn_mfma_f32_32x32x16_bf16(nfrag(BK2 + r32 * RC_PA + 16 * d + 8 * hi), nfrag(AI2 + r32 * RC_PA + 16 * d + 8 * hi), G, 0, 0, 0);
            {
                const int tcol = r32 & 15; const bool isR = r32 >= 16;
#pragma unroll
                for (int g2 = 0; g2 < 2; ++g2) {
                    const int i0 = 8 * g2 + 4 * hi;
                    float t0[4], t1[4];
#pragma unroll
                    for (int e = 0; e < 4; ++e) { const bool keep = isR ? (i0 + e <= tcol) : (i0 + e < tcol); t0[e] = keep ? G[4 * g2 + e] : 0.f; t1[e] = keep ? G[8 + 4 * g2 + e] : 0.f; }
                    const unsigned long long w1 = (unsigned long long)cvtpk(t1[0], t1[1]) | ((unsigned long long)cvtpk(t1[2], t1[3]) << 32);
                    if (isR) { *(LAS unsigned long long*)(MBT + tcol * RC_PT + i0) = (unsigned long long)cvtpk(t0[0], t0[1]) | ((unsigned long long)cvtpk(t0[2], t0[3]) << 32);
                               *(LAS unsigned long long*)(MKT + tcol * RC_PT + i0) = w1; }
                    else { *(LAS f32x4_t*)(ATT + tcol * 16 + i0) = (f32x4_t){t0[0], t0[1], t0[2], t0[3]}; *(LAS unsigned long long*)(BTT + tcol * RC_PT + i0) = w1; }
                }
            }
            asm volatile("s_waitcnt lgkmcnt(0)" ::: "memory");
            {
                const int jj = lane & 15; float tr[16];
                f32x4_t at[16][4];
#pragma unroll
                for (int t = 1; t < 16; ++t) {
#pragma unroll
                    for (int q4 = 0; q4 < (t + 3) / 4; ++q4) at[t][q4] = *(const LAS f32x4_t*)(ATT + t * 16 + 4 * q4);
                }
                __builtin_amdgcn_sched_barrier(0);
#pragma unroll
                for (int t = 0; t < 16; ++t) {
                    float x0 = jj == t ? 1.f : 0.f, x1 = 0.f, x2 = 0.f, x3 = 0.f;
#pragma unroll
                    for (int q4 = 0; q4 < (t + 3) / 4; ++q4) { const f32x4_t a4 = at[t][q4];
                        if (4 * q4 + 0 < t) x0 += a4[0] * tr[4 * q4 + 0]; if (4 * q4 + 1 < t) x1 += a4[1] * tr[4 * q4 + 1];
                        if (4 * q4 + 2 < t) x2 += a4[2] * tr[4 * q4 + 2]; if (4 * q4 + 3 < t) x3 += a4[3] * tr[4 * q4 + 3]; }
                    tr[t] = (x0 + x1) + (x2 + x3);
                }
#pragma unroll
                for (int t = 0; t < 16; ++t) TTm[t * RC_PT + jj] = bf1(tr[t]);
            }
#if PROBE_DUP == 20
            asm volatile("s_waitcnt lgkmcnt(0)" ::: "memory");
          }
#endif
            __syncthreads();
            __syncthreads();
        }
        __syncthreads();
    } else {
        const int hw = wave - 4, t8 = lane >> 3, ch = lane & 7;
        LAS bf16_t* stg = (LAS bf16_t*)(lds + RC_STG + hw * 2560);
        const LAS f32x4_t* cst = (const LAS f32x4_t*)(lds + RC_CST) + 2 * ch;
        {
            LAS float* cw = (LAS float*)(lds + RC_CST);
            for (int v = hw; v < 14; v += 4) {
                float x = 0.f;
                switch (v) { case 0: x = W.mu[hc]; break; case 1: x = W.mu[512 + hc]; break; case 2: x = W.mu[1024 + hc]; break; case 3: x = W.mu[1536 + lane]; break; case 4: x = W.mu[1600 + lane]; break;
                    case 5: x = (VRES && lane < 32) ? W.mu[1664 + lane] : 0.f; break; case 6: x = W.w0[hc]; break; case 7: x = W.a0[hc]; break; case 8: x = VRES ? W.v0[hc] : 0.f; break;
                    case 9: x = W.k_k[hc]; break; case 10: x = W.k_a[hc]; break; case 11: x = W.r_k[hc]; break; case 12: x = W.lnx_w[hc]; break; default: x = W.lnx_b[hc]; break; }
                cw[v * 64 + lane] = x;
            }
        }
        u32x4 cur[6], prv[6], vfr, gt;
        auto load_raw = [&](int c) {
            const int t = c * RW_T + 8 * hw + t8;
            const bf16_t* p = proj + (row0 + t) * PO; const bf16_t* q = t > 0 ? p - PO : zrow;
            cur[0] = *(const u32x4*)(p + O_R + h * 64 + 8 * ch); cur[1] = *(const u32x4*)(p + O_K + h * 64 + 8 * ch); cur[2] = *(const u32x4*)(p + O_V + h * 64 + 8 * ch);
            cur[3] = *(const u32x4*)(p + O_WD + 8 * ch); cur[4] = *(const u32x4*)(p + O_AD + 8 * ch); cur[5] = VRES ? *(const u32x4*)(p + O_MV + 8 * (ch & 3)) : (u32x4){0u, 0u, 0u, 0u};
            prv[0] = *(const u32x4*)(q + O_R + h * 64 + 8 * ch); prv[1] = *(const u32x4*)(q + O_K + h * 64 + 8 * ch); prv[2] = *(const u32x4*)(q + O_V + h * 64 + 8 * ch);
            prv[3] = *(const u32x4*)(q + O_WD + 8 * ch); prv[4] = *(const u32x4*)(q + O_AD + 8 * ch); prv[5] = VRES ? *(const u32x4*)(q + O_MV + 8 * (ch & 3)) : (u32x4){0u, 0u, 0u, 0u};
            if (VRES) vfr = *(const u32x4*)(vfirst + (row0 + t) * 512 + h * 64 + 8 * ch);
        };
        auto load_gate = [&](int c) { gt = *(const u32x4*)(proj + (row0 + c * RW_T + 8 * hw + t8) * PO + O_G + 512 + h * 64 + 8 * ch); };
#define UNPK8(dst, W_) do { const u32x4 w_ = (W_); dst[0] = __uint_as_float(w_[0] << 16); dst[1] = __uint_as_float(w_[0] & 0xffff0000u); dst[2] = __uint_as_float(w_[1] << 16); dst[3] = __uint_as_float(w_[1] & 0xffff0000u); \
        dst[4] = __uint_as_float(w_[2] << 16); dst[5] = __uint_as_float(w_[2] & 0xffff0000u); dst[6] = __uint_as_float(w_[3] << 16); dst[7] = __uint_as_float(w_[3] & 0xffff0000u); } while (0)
#define CST8(dst, v) do { const f32x4_t c0_ = cst[16 * (v)], c1_ = cst[16 * (v) + 1]; dst[0] = c0_[0]; dst[1] = c0_[1]; dst[2] = c0_[2]; dst[3] = c0_[3]; dst[4] = c1_[0]; dst[5] = c1_[1]; dst[6] = c1_[2]; dst[7] = c1_[3]; } while (0)
#define PK8(v) ((u32x4){cvtpk(v[0], v[1]), cvtpk(v[2], v[3]), cvtpk(v[4], v[5]), cvtpk(v[6], v[7])})
#define ST8(arr, o, v) do { *(LAS f32x4_t*)((arr) + (o)) = (f32x4_t){v[0], v[1], v[2], v[3]}; *(LAS f32x4_t*)((arr) + (o) + 4) = (f32x4_t){v[4], v[5], v[6], v[7]}; } while (0)
#define LD8(dst, arr, o) do { const f32x4_t l0_ = *(const LAS f32x4_t*)((arr) + (o)), l1_ = *(const LAS f32x4_t*)((arr) + (o) + 4); dst[0] = l0_[0]; dst[1] = l0_[1]; dst[2] = l0_[2]; dst[3] = l0_[3]; dst[4] = l1_[0]; dst[5] = l1_[1]; dst[6] = l1_[2]; dst[7] = l1_[3]; } while (0)
        float rs[8], ks[8], vs[8]; u32x4 vfr_s = (u32x4){0u, 0u, 0u, 0u};
        auto prep1 = [&]() {
            float x[8], p[8], m[8], y[8];
            vfr_s = vfr;
            UNPK8(x, cur[0]); UNPK8(p, prv[0]); CST8(m, 0);
#pragma unroll
            for (int e = 0; e < 8; ++e) rs[e] = x[e] + (p[e] - x[e]) * m[e];
            UNPK8(x, cur[1]); UNPK8(p, prv[1]); CST8(m, 1);
#pragma unroll
            for (int e = 0; e < 8; ++e) ks[e] = x[e] + (p[e] - x[e]) * m[e];
            UNPK8(x, cur[2]); UNPK8(p, prv[2]); CST8(m, 2);
#pragma unroll
            for (int e = 0; e < 8; ++e) vs[e] = x[e] + (p[e] - x[e]) * m[e];
            UNPK8(x, cur[3]); UNPK8(p, prv[3]); CST8(m, 3);
#pragma unroll
            for (int e = 0; e < 8; ++e) { const float wds = x[e] + (p[e] - x[e]) * m[e]; y[e] = 1.f - 2.f * __builtin_amdgcn_rcpf(1.f + __builtin_amdgcn_exp2f(2.f * LOG2E * wds)); }
            *(LAS u32x4*)(stg + t8 * 64 + 8 * ch) = PK8(y);
            UNPK8(x, cur[4]); UNPK8(p, prv[4]); CST8(m, 4);
#pragma unroll
            for (int e = 0; e < 8; ++e) y[e] = x[e] + (p[e] - x[e]) * m[e];
            *(LAS u32x4*)(stg + 512 + t8 * 64 + 8 * ch) = PK8(y);
            if (VRES) {
                UNPK8(x, cur[5]); UNPK8(p, prv[5]);
                { const LAS f32x4_t* cm = (const LAS f32x4_t*)(lds + RC_CST) + 16 * 5 + 2 * (ch & 3); const f32x4_t c0_ = cm[0], c1_ = cm[1]; m[0] = c0_[0]; m[1] = c0_[1]; m[2] = c0_[2]; m[3] = c0_[3]; m[4] = c1_[0]; m[5] = c1_[1]; m[6] = c1_[2]; m[7] = c1_[3]; }
#pragma unroll
                for (int e = 0; e < 8; ++e) y[e] = x[e] + (p[e] - x[e]) * m[e];
                if (ch < 4) *(LAS u32x4*)(stg + 1024 + t8 * 32 + 8 * ch) = PK8(y);
            }
            asm volatile("s_waitcnt lgkmcnt(0)" ::: "memory");
        };
        auto prep2 = [&](int c) {
            LAS float* bb = (LAS float*)(lds + RC_ARR); LAS float* bon = (LAS float*)(lds + RC_BON + (c & 1) * 8192);
            const int o = (8 * hw + t8) * 64 + 8 * ch;
            float x[8], p[8], m[8], y[8];
            {
                const int tokr = lane & 7, kg = lane >> 4, col16 = lane & 15, tb = 4 * (kg & 1);
                bf16x8 fw[2], fa[2], fv;
#pragma unroll
                for (int ks2 = 0; ks2 < 2; ++ks2) { fw[ks2] = *(const LAS bf16x8*)(stg + tokr * 64 + 32 * ks2 + 8 * kg); fa[ks2] = *(const LAS bf16x8*)(stg + 512 + tokr * 64 + 32 * ks2 + 8 * kg); }
                fv = *(const LAS bf16x8*)(stg + 1024 + tokr * 32 + 8 * kg);
#pragma unroll
                for (int ct = 0; ct < 4; ++ct) {
                    bf16x8 bw[2], ba[2], bv;
#pragma unroll
                    for (int ks2 = 0; ks2 < 2; ++ks2) { bw[ks2] = bfr[(2 * ct + ks2) * 64 + lane]; ba[ks2] = bfr[(8 + 2 * ct + ks2) * 64 + lane]; }
                    bv = VRES ? bfr[(16 + ct) * 64 + lane] : bf16x8{0, 0, 0, 0, 0, 0, 0, 0};
                    f32x4_t dw = (f32x4_t){0.f, 0.f, 0.f, 0.f}, da = dw, dv = dw;
#pragma unroll
                    for (int ks2 = 0; ks2 < 2; ++ks2) {
                        dw = __builtin_amdgcn_mfma_f32_16x16x32_bf16(fw[ks2], bw[ks2], dw, 0, 0, 0);
                        da = __builtin_amdgcn_mfma_f32_16x16x32_bf16(fa[ks2], ba[ks2], da, 0, 0, 0);
                    }
                    if (VRES) dv = __builtin_amdgcn_mfma_f32_16x16x32_bf16(fv, bv, dv, 0, 0, 0);
                    const int od = (8 * hw + tb) * 64 + 16 * ct + col16;
#pragma unroll
                    for (int r = 0; r < 4; ++r) { bb[2048 + od + 64 * r] = dw[r]; bb[6144 + od + 64 * r] = da[r]; if (VRES) bb[8192 + od + 64 * r] = dv[r]; }
                }
            }
            asm volatile("s_waitcnt lgkmcnt(0)" ::: "memory");
            float dec[8], av[8], kk[8];
            LD8(x, bb + 2048, o); CST8(m, 6);
#pragma unroll
            for (int e = 0; e < 8; ++e) dec[e] = __builtin_amdgcn_exp2f(-0.60653065971f * LOG2E * fsigmoid(m[e] + x[e]));
            LD8(x, bb + 6144, o); CST8(m, 7);
#pragma unroll
            for (int e = 0; e < 8; ++e) av[e] = fsigmoid(m[e] + x[e]);
            if (VRES) {
                LD8(x, bb + 8192, o); CST8(m, 8); UNPK8(p, vfr_s);
#pragma unroll
                for (int e = 0; e < 8; ++e) vs[e] = vs[e] + (p[e] - vs[e]) * fsigmoid(m[e] + x[e]);
            } else if (!dry) *(u32x4*)(vfirst + (row0 + c * RW_T + 8 * hw + t8) * 512 + h * 64 + 8 * ch) = PK8(vs);
            CST8(m, 9);
            float ss = 0.f;
#pragma unroll
            for (int e = 0; e < 8; ++e) { kk[e] = ks[e] * m[e]; ss += kk[e] * kk[e]; }
            const float inv = 1.f / fmaxf(sqrtf(red8(ss)), 1e-12f);
            CST8(m, 10);
#pragma unroll
            for (int e = 0; e < 8; ++e) { kk[e] *= inv; x[e] = ks[e] * (1.f + (av[e] - 1.f) * m[e]); p[e] = -kk[e]; y[e] = kk[e] * av[e]; }
            ST8(bb, o, rs); ST8(bb + 2048, o, dec); ST8(bb + 4096, o, x); ST8(bb + 6144, o, p); ST8(bb + 8192, o, y); ST8(bb + 10240, o, vs);
            CST8(m, 11);
            float s3 = 0.f;
#pragma unroll
            for (int e = 0; e < 8; ++e) s3 += rs[e] * x[e] * m[e];
            const float coef = red8(s3);
#pragma unroll
            for (int e = 0; e < 8; ++e) y[e] = coef * vs[e];
            ST8(bon, o, y);
        };
        auto finish = [&](int c) {
            const LAS float* pY = (const LAS float*)(lds + RC_Y + (c & 1) * 8192); const LAS float* bon = (const LAS float*)(lds + RC_BON + (c & 1) * 8192);
            const int o = (8 * hw + t8) * 64 + 8 * ch;
            float y[8], bo[8], m[8], q[8], g[8];
            LD8(y, pY, o); LD8(bo, bon, o);
            float s1 = 0.f;
#pragma unroll
            for (int e = 0; e < 8; ++e) s1 += y[e];
            const float mean = red8(s1) * (1.f / 64.f);
            float s2 = 0.f;
#pragma unroll
            for (int e = 0; e < 8; ++e) { y[e] -= mean; s2 += y[e] * y[e]; }
            const float rstd = rsqrtf(red8(s2) * (1.f / 64.f) + 64e-5f);
            CST8(m, 12); CST8(q, 13); UNPK8(g, gt);
#pragma unroll
            for (int e = 0; e < 8; ++e) y[e] = (y[e] * rstd * m[e] + q[e] + bo[e]) * g[e];
            if (!dry) *(u32x4*)(proj + (row0 + c * RW_T + 8 * hw + t8) * PO + O_G + 512 + h * 64 + 8 * ch) = PK8(y);
        };
        asm volatile("s_waitcnt lgkmcnt(0)" ::: "memory");
        load_raw(0);
        __syncthreads();
        prep1(); prep2(0);
        load_raw(1); load_gate(0);
        __syncthreads();
        for (int c = 0; c < RW_NCH; ++c) {
            if (c >= 1) { finish(c - 1); load_gate(c); }
            if (c + 1 < RW_NCH) { prep1(); if (c + 2 < RW_NCH) load_raw(c + 2); }
            __syncthreads();
            if (c + 1 < RW_NCH) prep2(c + 1);
            __syncthreads();
        }
        finish(RW_NCH - 1);
        __syncthreads();
#undef UNPK8
#undef CST8
#undef PK8
#undef ST8
#undef LD8
    }
}

typedef __attribute__((address_space(1))) unsigned gu32;
#define XB_TMO      128
#define XB_XCNT(j)  (256  + 64 * (j))
#define XB_XSUB(j)  (1280 + 64 * (j))
#define XB_XGEN(j)  (2304 + 64 * (j))
#define XB_TOP      3328
#define XB_TOPGEN   3392
#define XCD_BAR_WORDS 3456
#define XB_SPIN_CAP (1u << 18)

__device__ __forceinline__ unsigned xb_ld(unsigned* p)              { return __hip_atomic_load(p, __ATOMIC_RELAXED, __HIP_MEMORY_SCOPE_AGENT); }
__device__ __forceinline__ unsigned xb_add(unsigned* p, unsigned v) { return __hip_atomic_fetch_add(p, v, __ATOMIC_RELAXED, __HIP_MEMORY_SCOPE_AGENT); }
__device__ __forceinline__ unsigned xb_xcc_id() { return (unsigned)__builtin_amdgcn_s_getreg((3 << 11) | 20) & 0xFu; }
#define XB_SPIN(cond, bar) do { unsigned _sp = 0; while (cond) { __builtin_amdgcn_s_sleep(1); \
    if ((++_sp & 255u) == 0u) { if (xb_ld(&(bar)[XB_TMO])) break; if (_sp > XB_SPIN_CAP) { atomicAdd(&(bar)[XB_TMO], 1u); break; } } } } while (0)

struct XcdBarrier {
    unsigned* bar; unsigned x;
    volatile LAS unsigned* st;
};

__device__ __forceinline__ XcdBarrier xcd_barrier_post(unsigned* bar, volatile LAS unsigned* st) {
    XcdBarrier b; b.bar = bar; b.x = xb_xcc_id(); b.st = st;
    if (threadIdx.x == 0) (void)xb_add(&bar[XB_XCNT(b.x)], 1u);
    return b;
}
__device__ __forceinline__ void xcd_barrier_complete(unsigned* bar, unsigned x, unsigned& nloc, unsigned& nx) {
    const unsigned G = gridDim.x * gridDim.y * gridDim.z;
    unsigned sum, cnt, mine, sp = 0u;
    for (;;) {
        sum = 0u; cnt = 0u; mine = 0u;
#pragma unroll
        for (unsigned j = 0; j < 16; ++j) { const unsigned c = xb_ld(&bar[XB_XCNT(j)]); sum += c; cnt += (c > 0u) ? 1u : 0u; mine = (j == x) ? c : mine; }
        if (sum == G) break;
        __builtin_amdgcn_s_sleep(1);
        if ((++sp & 255u) == 0u) { if (xb_ld(&bar[XB_TMO])) break; if (sp > XB_SPIN_CAP) { atomicAdd(&bar[XB_TMO], 1u); break; } }
    }
    nloc = mine > 0u ? mine : 1u; nx = cnt > 0u ? cnt : 1u;
}

__device__ __forceinline__ void xcd_barrier(const XcdBarrier& b) {
    asm volatile("s_waitcnt vmcnt(0)" ::: "memory");
    __syncthreads();
    if (threadIdx.x == 0) {
        unsigned* bar = b.bar;
        __builtin_amdgcn_s_waitcnt(0);
        unsigned nloc = b.st[0], nx = b.st[1];
        if (nloc == 0u) { xcd_barrier_complete(bar, b.x, nloc, nx); b.st[0] = nloc; b.st[1] = nx; }
        const unsigned old = xb_add(&bar[XB_XSUB(b.x)], 1u);
        const unsigned gen = old / nloc;
        if (old + 1u == (gen + 1u) * nloc) {
            __builtin_amdgcn_fence(__ATOMIC_RELEASE, "agent");
            asm volatile("s_waitcnt vmcnt(0)" ::: "memory");
            const unsigned og = xb_add(&bar[XB_TOP], 1u);
            const unsigned tg = og / nx;
            if (og + 1u == (tg + 1u) * nx) xb_add(&bar[XB_TOPGEN], 1u);
            else XB_SPIN(xb_ld(&bar[XB_TOPGEN]) == tg, bar);
            __builtin_amdgcn_fence(__ATOMIC_ACQUIRE, "agent");
            xb_add(&bar[XB_XGEN(b.x)], 1u);
            asm volatile("s_waitcnt vmcnt(0)" ::: "memory");
        } else {
            XB_SPIN(xb_ld(&bar[XB_XGEN(b.x)]) == gen, bar);
            __builtin_amdgcn_fence(__ATOMIC_ACQUIRE, "agent");
            asm volatile("s_waitcnt vmcnt(0)" ::: "memory");
        }
    }
    __syncthreads();
}

constexpr int LDS_VBUF = 0, LDS_SLOT = 163840 - 64;
DI int next_chunk(unsigned* counter, LAS unsigned* slot) {
    __syncthreads();
    if (threadIdx.x == 0) *slot = atomicAdd(counter, 1u);
    __syncthreads();
    return (int)*slot;
}
constexpr int NWAVES = 8, LDS_BYTES = 163840, GRID = 256;
template <class E> struct PgEpi {
    static constexpr bool PERM = true, AFTER_DRAIN = false;
    E e; bool dry;
    template <int KIND> DI void rows(const pg8::f32x4 (&acc)[2][2][4][2], const pg8::Unit& u, int wr, int wc, int fr, int fq) const {
        const int row0 = u.pm * 256 + wr * 64 + fr, col0 = u.pn * 256 + wc * 32 + 8 * fq;
        constexpr int PD = sizeof(typename E::Pre) <= 16 ? (sizeof(typename E::Tab) >= 32 ? 4 : 8) : sizeof(typename E::Pre) <= 32 ? 4 : 2;
        constexpr int TD = sizeof(typename E::Tab) >= 32 ? 3 : 8;
        typename E::Pre pr[8]; typename E::Tab tb[8];
#pragma unroll
        for (int i = 0; i < PD; ++i) pr[i] = e.prefetch(row0 + (i >> 2) * 128 + (i & 3) * 16, col0);
#pragma unroll
        for (int i = 0; i < TD; ++i) tb[i] = e.template tab<KIND>(row0 + (i >> 2) * 128 + (i & 3) * 16, col0);
#pragma unroll
        for (int i = 0; i < 8; ++i) {
            const int ai = i >> 2, m = i & 3, row = row0 + ai * 128 + m * 16;
            if (i + PD < 8) pr[i + PD] = e.prefetch(row0 + ((i + PD) >> 2) * 128 + ((i + PD) & 3) * 16, col0);
            if (i + TD < 8) tb[i + TD] = e.template tab<KIND>(row0 + ((i + TD) >> 2) * 128 + ((i + TD) & 3) * 16, col0);
            asm volatile("" ::: "memory");
            const typename E::Pre& pre = pr[i];
            const float rs = e.rowscale(pre);
            float ss = 0.f;
#pragma unroll
            for (int bj = 0; bj < 2; ++bj) {
                const pg8::f32x4 a0 = acc[ai][bj][m][0], a1 = acc[ai][bj][m][1];
                float v[8] = {a0[0], a0[1], a0[2], a0[3], a1[0], a1[1], a1[2], a1[3]};
                if (!dry) ss += e.template apply<KIND>(row, col0 + bj * 128, v, rs, pre, bj, tb[i]); else ss += v[0] + v[7];
            }
            if (E::HAS_SSQ) { ss = xadd32(xadd16(ss)); if (fq == 0 && !dry) e.put_ssq(row, u.pn, wc, ss); }
            if (dry) asm volatile("" :: "v"(ss));
        }
    }
    DI void operator()(const pg8::f32x4 (&acc)[2][2][4][2], const pg8::Unit& u, int wr, int wc, int fr, int fq) const {
        const int k = e.kind(u.pn);
        if (E::NKIND == 1 || k == 0) rows<0>(acc, u, wr, wc, fr, fq);
        else if (k == 1) rows<1>(acc, u, wr, wc, fr, fq);
        else if (k == 2) rows<2>(acc, u, wr, wc, fr, fq);
        else if (k == 3) rows<3>(acc, u, wr, wc, fr, fq);
        else if (k == 4) rows<4>(acc, u, wr, wc, fr, fq);
        else if (k == 5) rows<(E::NKIND > 5 ? 5 : 0)>(acc, u, wr, wc, fr, fq);
        else rows<(E::NKIND > 6 ? 6 : 0)>(acc, u, wr, wc, fr, fq);
    }
};
template <int M, int N, int K, int LDA, class E, int G = GRID, int C0 = 0> DI void run_gemm(pg8::PG8_LAS_T* lds, const bf16_t* A, const bf16_t* Bt, const E& e, bool dry = false) {
    int bid = (int)blockIdx.x - C0; asm volatile("" : "+s"(bid));
    pg8::Gemm<M, N, K, LDA> g{A, Bt}; pg8::StaticOrder S; S.init(M, N, G, bid);
    PgEpi<E> pe{e, dry};
    pg8::gemm_phase<PgEpi<E>, pg8::StaticOrder, true, true>(lds, g, S, pe);
}

namespace cg = cooperative_groups;

struct Args { const void* in[51]; float* out; unsigned char* ws; long long probe; };
static_assert(sizeof(Args) == 54 * 8, "no padding");

__global__ void __launch_bounds__(NWAVES * 64, 2) mega(Args a) {
    extern __shared__ __attribute__((aligned(16))) unsigned char lds[];
    cg::grid_group grid = cg::this_grid();
    const int tid = threadIdx.x, wave = __builtin_amdgcn_readfirstlane(tid >> 6);
    const int G = gridDim.x, gw = blockIdx.x * NWAVES + wave, ngw = G * NWAVES;
    pg8::PG8_LAS_T* lds3 = (pg8::PG8_LAS_T*)lds;
#define GASP __attribute__((address_space(1)))
#define WSB() ({ GASP unsigned char* p_ = (GASP unsigned char*)a.ws; asm volatile("" : "+s"(p_)); (unsigned char*)p_; })
#define ws WSB()
#define out ({ GASP float* o_ = (GASP float*)a.out; asm volatile("" : "+s"(o_)); (float*)o_; })
#define ssq ((float*)(ws + WS_SSQ))
#define cqsq ((float*)(ws + WS_CQSQ))
#define ckvsq ((float*)(ws + WS_CKVSQ))
#define mrstd ((float*)(ws + WS_MRSTD))
#define tabA ((float2*)(ws + WS_TABA))
#define tabR ((float2*)(ws + WS_TABR))
#define tabM ((float2*)(ws + WS_TABM))
#define wmem ((bf16_t*)(ws + WS_WMEM))
#define memb ((bf16_t*)(ws + WS_MEMB))
#define memkv ((bf16_t*)(ws + WS_MEMKV))
#define vfirst ((bf16_t*)(ws + WS_VFIRST))
#define xb ((bf16_t*)(ws + WS_XB))
#define mlakv ((bf16_t*)out)
#define mlaq ((bf16_t*)(ws + WS_MLAQ))
#define proj ((bf16_t*)(ws + ((l & 1) ? WS_PROJ : WS_PROJ - 4 * MiB)))
    const void* const* kin = (const void* const*)__builtin_amdgcn_kernarg_segment_ptr();
#define FIN(i) ((const float*)(const GASP float*)kin[i])
#if PROBE_TS_A >= 0
    int n_stamp = 0;
#define STAMP() do { if (blockIdx.x == 0 && tid == 0) ((unsigned long long*)(ws + WS_CTL + 32768))[n_stamp] = __builtin_amdgcn_s_memrealtime(); ++n_stamp; } while (0)
#else
#define STAMP() do {} while (0)
#endif
    STAMP();
    const bool rt_true = (a.probe == 0), rt_false = (a.probe != 0);
    volatile LAS unsigned* xst = (volatile LAS unsigned*)((LAS unsigned char*)lds + LDS_SLOT + 16);
    if (tid < 2) xst[tid] = 0u;
    __syncthreads();
#define XBAR_WORDS ((unsigned*)(ws + WS_CTL) + 4096)
    (void)xcd_barrier_post(XBAR_WORDS, xst);
#if PROBE_DUP == 14
#define GSYNC() do { XcdBarrier b_; b_.bar = XBAR_WORDS; b_.x = xb_xcc_id(); b_.st = xst; xcd_barrier(b_); xcd_barrier(b_); xcd_barrier(b_); } while (0)
#else
#define GSYNC() do { XcdBarrier b_; b_.bar = XBAR_WORDS; b_.x = xb_xcc_id(); b_.st = xst; xcd_barrier(b_); } while (0)
#endif
#define WI(l) ((bf16_t*)(ws + ((l) == 0 ? WS_WI0 : (l) == 1 ? WS_WI1 : (l) == 2 ? WS_WI2 : WS_WI3)))
#define WO(l) ((bf16_t*)(ws + WS_WO + (size_t)(l) * 2560 * 1024))
#define WQB(o) ((bf16_t*)(ws + WS_WQB + (size_t)(o) * 512 * 1024))
#define WKVB(o) ((bf16_t*)(ws + WS_WKVB + (size_t)(o) * 256 * 1024))

#if PROBE_DUP == 10
    {
        float* scr = (float*)lds + wave * (64 * 33);
        int base = 0;
#pragma unroll 1
        for (int l = 0; l < 4; ++l) {
            const bool odd = l & 1; const int dcols = l == 3 ? 1696 : 1664;
            const int i_norm = l == 0 ? 5 : l == 1 ? 9 : l == 2 ? 27 : 31, i_win = i_norm + 1;
            const int i_wmem = l == 0 ? 7 : l == 1 ? 25 : l == 2 ? 29 : 49, i_wout = i_wmem + 1;
            wconv_job(scr, gw, ngw, base, FIN(i_win), 1024, odd ? 416 + dcols + 256 + 1280 : 4096, WI(l), odd ? PO : PEN, 0, odd ? 2 : 1, dcols, FIN(i_norm));
            wconv_job(scr, gw, ngw, base, FIN(i_wout), 1280, 1024, WO(l), 1024, 0, 0, 0, (const float*)nullptr);
            wconv_job(scr, gw, ngw, base, FIN(i_wmem), 1024, 512, wmem, 512, l * 512, 0, 0, FIN(3));
        }
#pragma unroll 1
        for (int o = 0; o < 2; ++o) {
            wconv_job(scr, gw, ngw, base, FIN(o ? 34 : 12), 256, 768, WQB(o), 1024, 0, 3, 0, FIN(o ? 33 : 11));
            wconv_job(scr, gw, ngw, base, FIN(o ? 36 : 14), 128, 1024, WKVB(o), 1024, 0, 0, 0, FIN(o ? 35 : 13));
        }
#pragma unroll 1
        for (int o = 0; o < 2; ++o) {
            bf16_t* lt = (bf16_t*)(ws + WS_LORA + (size_t)o * 262144);
            wconv_job(scr, gw, ngw, base, FIN(o ? 39 : 17), 64, 512, lt, 512, 0, 0, 0, (const float*)nullptr);
            wconv_job(scr, gw, ngw, base, FIN(o ? 41 : 19), 64, 512, lt + 32768, 512, 0, 0, 0, (const float*)nullptr);
            if (o) wconv_job(scr, gw, ngw, base, FIN(43), 32, 512, lt + 65536, 512, 0, 0, 0, (const float*)nullptr);
        }
        tables_rows(gw, ngw, (const int*)(const GASP int*)kin[2], tabA, tabR, tabM);
        rows_prep(gw, ngw, FIN(0), xb, ssq, MTOK, 0);
        rows_prep(gw, ngw, FIN(1), memb, mrstd, MROWS, 1);
    }
#endif
#if PROBE_DUP == 40
    {
        float* scr = (float*)lds + wave * (64 * 33);
        int base = 0;
#pragma unroll 1
        for (int l = 0; l < 4; ++l) {
            const bool odd = l & 1; const int dcols = l == 3 ? 1696 : 1664;
            const int i_norm = l == 0 ? 5 : l == 1 ? 9 : l == 2 ? 27 : 31, i_win = i_norm + 1;
            const int i_wmem = l == 0 ? 7 : l == 1 ? 25 : l == 2 ? 29 : 49, i_wout = i_wmem + 1;
            wconv_job(scr, gw, ngw, base, FIN(i_win), 1024, odd ? 416 + dcols + 256 + 1280 : 4096, WI(l), odd ? PO : PEN, 0, odd ? 2 : 1, dcols, FIN(i_norm));
            wconv_job(scr, gw, ngw, base, FIN(i_wout), 1280, 1024, WO(l), 1024, 0, 0, 0, (const float*)nullptr);
            wconv_job(scr, gw, ngw, base, FIN(i_wmem), 1024, 512, wmem, 512, l * 512, 0, 0, FIN(3));
        }
#pragma unroll 1
        for (int o = 0; o < 2; ++o) {
            wconv_job(scr, gw, ngw, base, FIN(o ? 34 : 12), 256, 768, WQB(o), 1024, 0, 3, 0, FIN(o ? 33 : 11));
            wconv_job(scr, gw, ngw, base, FIN(o ? 36 : 14), 128, 1024, WKVB(o), 1024, 0, 0, 0, FIN(o ? 35 : 13));
        }
#pragma unroll 1
        for (int o = 0; o < 2; ++o) {
            bf16_t* lt = (bf16_t*)(ws + WS_LORA + (size_t)o * 262144);
            wconv_job(scr, gw, ngw, base, FIN(o ? 39 : 17), 64, 512, lt, 512, 0, 0, 0, (const float*)nullptr);
            wconv_job(scr, gw, ngw, base, FIN(o ? 41 : 19), 64, 512, lt + 32768, 512, 0, 0, 0, (const float*)nullptr);
            if (o) wconv_job(scr, gw, ngw, base, FIN(43), 32, 512, lt + 65536, 512, 0, 0, 0, (const float*)nullptr);
        }
    }
#endif
#if PROBE_DUP == 41
    {
        tables_rows(gw, ngw, (const int*)(const GASP int*)kin[2], tabA, tabR, tabM);
        rows_prep(gw, ngw, FIN(0), xb, ssq, MTOK, 0);
        rows_prep(gw, ngw, FIN(1), memb, mrstd, MROWS, 1);
    }
#endif
    {
        float* scr = (float*)lds + wave * (64 * 33);
        int base = 0;
#pragma unroll 1
        for (int l = 0; l < 4; ++l) {
            const bool odd = l & 1; const int dcols = l == 3 ? 1696 : 1664;
            const int i_norm = l == 0 ? 5 : l == 1 ? 9 : l == 2 ? 27 : 31, i_win = i_norm + 1;
            const int i_wmem = l == 0 ? 7 : l == 1 ? 25 : l == 2 ? 29 : 49, i_wout = i_wmem + 1;
            wconv_job(scr, gw, ngw, base, FIN(i_win), 1024, odd ? 416 + dcols + 256 + 1280 : 4096, WI(l), odd ? PO : PEN, 0, odd ? 2 : 1, dcols, FIN(i_norm));
            wconv_job(scr, gw, ngw, base, FIN(i_wout), 1280, 1024, WO(l), 1024, 0, 0, 0, (const float*)nullptr);
            wconv_job(scr, gw, ngw, base, FIN(i_wmem), 1024, 512, wmem, 512, l * 512, 0, 0, FIN(3));
        }
#pragma unroll 1
        for (int o = 0; o < 2; ++o) {
            wconv_job(scr, gw, ngw, base, FIN(o ? 34 : 12), 256, 768, WQB(o), 1024, 0, 3, 0, FIN(o ? 33 : 11));
            wconv_job(scr, gw, ngw, base, FIN(o ? 36 : 14), 128, 1024, WKVB(o), 1024, 0, 0, 0, FIN(o ? 35 : 13));
        }
#pragma unroll 1
        for (int o = 0; o < 2; ++o) {
            bf16_t* lt = (bf16_t*)(ws + WS_LORA + (size_t)o * 262144);
            wconv_job(scr, gw, ngw, base, FIN(o ? 39 : 17), 64, 512, lt, 512, 0, 0, 0, (const float*)nullptr);
            wconv_job(scr, gw, ngw, base, FIN(o ? 41 : 19), 64, 512, lt + 32768, 512, 0, 0, 0, (const float*)nullptr);
            if (o) wconv_job(scr, gw, ngw, base, FIN(43), 32, 512, lt + 65536, 512, 0, 0, 0, (const float*)nullptr);
        }
        tables_rows(gw, ngw, (const int*)(const GASP int*)kin[2], tabA, tabR, tabM);
        rows_prep(gw, ngw, FIN(0), xb, ssq, MTOK, 0);
        rows_prep(gw, ngw, FIN(1), memb, mrstd, MROWS, 1);
    }
    grid.sync();
    STAMP();
#if PROBE_DUP == 13
    run_gemm<MROWS, 2048, DM, DM>(lds3, memb, wmem, EpiMemKV{memkv, mrstd}, rt_true);
#endif
    run_gemm<MROWS, 2048, DM, DM>(lds3, memb, wmem, EpiMemKV{memkv, mrstd});
#pragma unroll 1
    for (int l = 0; l < 4; ++l) {
        const int i_wmem = l == 0 ? 7 : l == 1 ? 25 : l == 2 ? 29 : 49;
        if ((l & 1) == 0) {
#if PROBE_DUP == 4
            run_gemm<MTOK, PEN, DM, DM>(lds3, xb, WI(l), EpiEvenIn{proj, ssq, tabA, tabR}, rt_true);
#elif PROBE_DUP == 16
            run_gemm<MTOK, PEN, DM, DM>(lds3, xb, WI(l), EpiEvenIn{proj, ssq, tabA, tabR}, rt_false);
#endif
            run_gemm<MTOK, PEN, DM, DM>(lds3, xb, WI(l), EpiEvenIn{proj, ssq, tabA, tabR}, rt_false);
            GSYNC(); STAMP();
#define EVEN_MIX(lo, hi, qi, dry) do { LAS unsigned* slot = (LAS unsigned*)((LAS unsigned char*)lds + LDS_SLOT); unsigned* ret_done = (unsigned*)(ws + WS_CTL) + 64 * (21 + l); bool ret_ready = false; Ticket tk{(unsigned*)(ws + WS_CTL) + 64 * (qi), 0u, false}; \
                for (;;) { const int c = tk.take(slot) + (lo); if (c >= (hi)) break; \
                    if (c < 64) { unitRetState((LAS unsigned char*)lds, proj, memb, c >> 2, c & 3); \
                        asm volatile("s_waitcnt vmcnt(0)" ::: "memory"); __syncthreads(); \
                        if (tid == 0) { __threadfence(); asm volatile("s_waitcnt vmcnt(0)" ::: "memory"); __hip_atomic_fetch_add(ret_done, 1u, __ATOMIC_RELAXED, __HIP_MEMORY_SCOPE_AGENT); } } \
                    else if (c < 1088) { const int c2 = c - 64; unitAS((LAS unsigned char*)lds, proj, (c2 >> 5) & 15, (c2 >> 2) & 7, c2 & 3, 1 - (c2 >> 9), dry, tk); } \
                    else if (c < 1600) { const int c3 = c - 1088; unitMemS((LAS unsigned char*)lds, proj, PE, E_QM, E_G + 1024, memkv, l, c3 >> 5, (c3 >> 3) & 3, c3 & 7, dry, tk); } \
                    else { const int c4 = c - 1600; \
                        if (!ret_ready) { if (tid == 0) { unsigned spins = 0; while (__hip_atomic_load(ret_done, __ATOMIC_RELAXED, __HIP_MEMORY_SCOPE_AGENT) < 64u && ++spins < (1u << 22)) __builtin_amdgcn_s_sleep(8); \
                                __threadfence(); asm volatile("s_waitcnt vmcnt(0)" ::: "memory"); } __syncthreads(); ret_ready = true; } \
                        unitRetC((LAS unsigned char*)lds, proj, memb, (c4 & 63) >> 2, c4 & 3, 7 - (c4 >> 6), dry, tk); } } } while (0)
#if PROBE_DUP == 1
            EVEN_MIX(0, 2048, 9 + l, rt_true);
#elif PROBE_DUP == 7
            EVEN_MIX(0, 512, 9 + l, rt_true);
#elif PROBE_DUP == 8
            EVEN_MIX(512, 1536, 9 + l, rt_true);
#elif PROBE_DUP == 9
            EVEN_MIX(1536, 2048, 9 + l, rt_true);
#endif
            EVEN_MIX(0, 2112, 1 + l, rt_false);
            GSYNC(); STAMP();
#if PROBE_DUP == 5
            run_gemm<MTOK, DM, 1280, PE>(lds3, proj + E_G, WO(l), EpiWOut<1>{nullptr, out, xb, ssq}, rt_true);
#endif
            if (l == 0) run_gemm<MTOK, DM, 1280, PE>(lds3, proj + E_G, WO(l), EpiWOut<0>{FIN(0), out, xb, ssq}, rt_false);
            else run_gemm<MTOK, DM, 1280, PE>(lds3, proj + E_G, WO(l), EpiWOut<1>{nullptr, out, xb, ssq}, rt_false);
            GSYNC(); STAMP();
        } else {
            const int o = l >> 1;
#if PROBE_DUP == 11
            run_gemm<MTOK, PO, DM, DM>(lds3, xb, WI(l), EpiOddIn{proj, ssq, tabM, cqsq, ckvsq}, rt_true);
#elif PROBE_DUP == 17
            run_gemm<MTOK, PO, DM, DM>(lds3, xb, WI(l), EpiOddIn{proj, ssq, tabM, cqsq, ckvsq}, rt_false);
#endif
            run_gemm<MTOK, PO, DM, DM>(lds3, xb, WI(l), EpiOddIn{proj, ssq, tabM, cqsq, ckvsq});
            GSYNC(); STAMP();
#if PROBE_DUP == 12
            run_gemm<MTOK, 1024, 256, PO>(lds3, proj + O_CQ, WQB(o), EpiMlaQ{mlaq, cqsq, tabM}, rt_true);
            run_gemm<MTOK, 1024, 128, PO>(lds3, proj + O_CKV, WKVB(o), EpiMlaKV{mlakv, ckvsq}, rt_true);
#endif
            unsigned* mla_done = (unsigned*)(ws + WS_CTL) + 64 * (17 + l);
            if (blockIdx.x >= 128) {
                run_gemm<MTOK, 1024, 256, PO, EpiMlaQ, 128, 128>(lds3, proj + O_CQ, WQB(o), EpiMlaQ{mlaq, cqsq, tabM});
                run_gemm<MTOK, 1024, 128, PO, EpiMlaKV, 128, 128>(lds3, proj + O_CKV, WKVB(o), EpiMlaKV{mlakv, ckvsq});
                asm volatile("s_waitcnt vmcnt(0)" ::: "memory");
                __syncthreads();
                if (tid == 0) { __threadfence(); asm volatile("s_waitcnt vmcnt(0)" ::: "memory"); __hip_atomic_fetch_add(mla_done, 1u, __ATOMIC_RELAXED, __HIP_MEMORY_SCOPE_AGENT); }
            } else {
                const bf16_t* lt = (const bf16_t*)(ws + WS_LORA + (size_t)o * 262144);
                if (l == 1) { const RwkvW W{FIN(15), FIN(16), FIN(17), FIN(18), FIN(19), nullptr, nullptr, FIN(20), FIN(21), FIN(22), FIN(23), FIN(24)}; rwkv_unit_c<false>((LAS unsigned char*)lds, proj, vfirst, lt, W, (int)blockIdx.x, (const bf16_t*)(ws + WS_CTL + 40960), rt_false); }
                else { const RwkvW W{FIN(37), FIN(38), FIN(39), FIN(40), FIN(41), FIN(42), FIN(43), FIN(44), FIN(45), FIN(46), FIN(47), FIN(48)}; rwkv_unit_c<true>((LAS unsigned char*)lds, proj, vfirst, lt, W, (int)blockIdx.x, (const bf16_t*)(ws + WS_CTL + 40960), rt_false); }
            }
            if (tid == 0) {
                unsigned spins = 0;
                while (__hip_atomic_load(mla_done, __ATOMIC_RELAXED, __HIP_MEMORY_SCOPE_AGENT) < 128u && ++spins < (1u << 22)) __builtin_amdgcn_s_sleep(8);
                __threadfence(); asm volatile("s_waitcnt vmcnt(0)" ::: "memory");
            }
            __syncthreads();
            STAMP();
#define ODD_MIX(lo, hi, qi, dry) do { LAS unsigned* slot = (LAS unsigned*)((LAS unsigned char*)lds + LDS_SLOT); Ticket tk{(unsigned*)(ws + WS_CTL) + 64 * (qi), 0u, false}; \
                for (;;) { const int c = tk.take(slot) + (lo); if (c >= (hi)) break; \
                    if (c < 1024) unitMlaS((LAS unsigned char*)lds, proj, mlaq, mlakv, (c & 127) >> 3, c & 7, 7 - (c >> 7), dry, tk); \
                    else { const int c3 = c - 1024; unitMemS((LAS unsigned char*)lds, proj, PO, O_QM, O_G + 1024, memkv, l, c3 >> 5, (c3 >> 3) & 3, c3 & 7, dry, tk); } } } while (0)
#if PROBE_DUP == 31
            ODD_MIX(0, 1024, 5 + l, rt_true);
#elif PROBE_DUP == 32
            ODD_MIX(1024, 1536, 5 + l, rt_true);
#endif
            ODD_MIX(0, 1536, 1 + l, rt_false);
            GSYNC(); STAMP();
#if PROBE_DUP == 15
            run_gemm<MTOK, DM, 1280, PO>(lds3, proj + O_G, WO(l), EpiWOut<1>{nullptr, out, xb, ssq}, rt_true);
#endif
            if (l == 1) run_gemm<MTOK, DM, 1280, PO>(lds3, proj + O_G, WO(l), EpiWOut<1>{nullptr, out, xb, ssq});
            else run_gemm<MTOK, DM, 1280, PO>(lds3, proj + O_G, WO(l), EpiWOut<2>{nullptr, out, xb, ssq});
            GSYNC(); STAMP();
        }
    }
#if PROBE_TS_A >= 0
    { const unsigned long long* tsp = (const unsigned long long*)(ws + WS_CTL + 32768);
      float T_us = (float)(tsp[PROBE_TS_B] - tsp[PROBE_TS_A]) * 0.01f;
      T_us = expf(floorf(logf(T_us) / logf(PROBE_TS_R) + PROBE_TS_PH) * logf(PROBE_TS_R));
      final_norm_rows(gw, ngw, out, FIN(4), 1.f + T_us * (1.f / 4000.f)); }
#else
    final_norm_rows(gw, ngw, out, FIN(4), 1.f);
#endif
}

#undef WSB
#undef STAMP
#undef GASP
#undef EVEN_MIX
#undef ODD_MIX
#undef XBAR_WORDS
#undef GSYNC
#undef ws
#undef out
#undef ssq
#undef cqsq
#undef ckvsq
#undef mrstd
#undef tabA
#undef tabR
#undef tabM
#undef wmem
#undef memb
#undef memkv
#undef vfirst
#undef xb
#undef mlakv
#undef mlaq
#undef proj
#undef FIN
#undef WI
#undef WO
#undef WQB
#undef WKVB
extern "C" void kernel_launch(void* const* d_in, const int* in_sizes, int n_in, void* d_out, int out_size, void* d_ws, size_t ws_size, hipStream_t stream) {
    static int grid = 0;
    if (grid == 0) {
        if (n_in != 51 || ws_size < WS_END) { fprintf(stderr, "kernel_launch: unexpected n_in %d / ws %zu\n", n_in, ws_size); grid = -1; return; }
        int dev = 0, cus = 0, per_cu = 0;
        hipGetDevice(&dev); hipDeviceGetAttribute(&cus, hipDeviceAttributeMultiprocessorCount, dev);
        hipFuncSetAttribute((const void*)mega, hipFuncAttributeMaxDynamicSharedMemorySize, LDS_BYTES);
        hipOccupancyMaxActiveBlocksPerMultiprocessor(&per_cu, (const void*)mega, NWAVES * 64, LDS_BYTES);
        if (per_cu < 1) { fprintf(stderr, "kernel_launch: occupancy query says %d blocks per CU\n", per_cu); per_cu = 1; }
        if (cus * per_cu < GRID) { fprintf(stderr, "kernel_launch: device holds %d x %d workgroups, kernel is built for %d\n", cus, per_cu, GRID); grid = -1; return; }
        grid = GRID;
    }
    if (grid < 0) return;
    if (hipMemsetAsync((char*)d_ws + WS_CTL, 0, 65536, stream) != hipSuccess) { fprintf(stderr, "kernel_launch: memset failed\n"); return; }
    Args a{};
    for (int i = 0; i < 51; ++i) a.in[i] = d_in[i];
    a.out = (float*)d_out; a.ws = (unsigned char*)d_ws;
    void* args[] = {&a};
    hipError_t e = hipLaunchCooperativeKernel((const void*)mega, dim3(grid), dim3(NWAVES * 64), args, LDS_BYTES, stream);
    if (e != hipSuccess) fprintf(stderr, "cooperative launch failed: %s (grid %d)\n", hipGetErrorString(e), grid);
}
```
